# Optimizing an MI355X kernel written in HIP

```python
import math
import jax, jax.numpy as jnp
from jax import lax
import numpy as np

D_MODEL = 2048
BATCH = 1
SEQ = 8192
DEPTH = 4

HEAD_DIM = 128
MOBA_HEADS = 6
DIFF_HEADS = 6
SGU_GROUPS = 4
SGU_GROUP_DIM = HEAD_DIM
MOBA_WIDTH = MOBA_HEADS * HEAD_DIM
DIFF_WIDTH = DIFF_HEADS * HEAD_DIM
SGU_WIDTH = SGU_GROUPS * SGU_GROUP_DIM
DIFF_QK_DIM = HEAD_DIM // 2
MOBA_BLOCK = 256
MOBA_TOPK = 3
MOBA_Q_CHUNK = 64
ATTN_Q_BLOCK = 128
SGU_CHUNK = 128
D_FF = 4 * D_MODEL
ROPE_THETA = 10000.0
EPS = 1e-6
IN_WIDTH = 3 * MOBA_WIDTH + 3 * DIFF_WIDTH + 2 * SGU_WIDTH
IN_SPLITS = [MOBA_WIDTH, 2 * MOBA_WIDTH, 3 * MOBA_WIDTH,
             3 * MOBA_WIDTH + DIFF_WIDTH, 3 * MOBA_WIDTH + 2 * DIFF_WIDTH,
             3 * MOBA_WIDTH + 3 * DIFF_WIDTH, 3 * MOBA_WIDTH + 3 * DIFF_WIDTH + SGU_WIDTH]

kernel_name = 'hybrid_moba_diffattn_gmlp_trunk'


def rms_norm(x, g):
    xf = x.astype(jnp.float32)
    y = xf * lax.rsqrt(jnp.mean(xf * xf, axis=-1, keepdims=True) + EPS)
    return (y * g.astype(jnp.float32)).astype(x.dtype)


def rope_tables(seq, dim):
    inv = 1.0 / (ROPE_THETA ** (jnp.arange(0, dim, 2, dtype=jnp.float32) / dim))
    ang = jnp.arange(seq, dtype=jnp.float32)[:, None] * inv[None, :]
    return jnp.cos(ang), jnp.sin(ang)


def apply_rope(x, cos, sin):
    half = x.shape[-1] // 2
    bshape = (1, x.shape[1]) + (1,) * (x.ndim - 3) + (half,)
    c = cos.reshape(bshape)
    s = sin.reshape(bshape)
    xf = x.astype(jnp.float32)
    x1, x2 = xf[..., :half], xf[..., half:]
    return jnp.concatenate([x1 * c - x2 * s, x2 * c + x1 * s], axis=-1).astype(x.dtype)


def moba_attention(q, k, v, cos, sin):
    B, S, H, Dh = q.shape
    q = apply_rope(q, cos, sin)
    k = apply_rope(k, cos, sin)
    n_blk = -(-S // MOBA_BLOCK)
    s_pad = n_blk * MOBA_BLOCK
    pad = ((0, 0), (0, 0), (0, s_pad - S), (0, 0))
    q = jnp.pad(q.transpose(0, 2, 1, 3), pad)
    k = jnp.pad(k.transpose(0, 2, 1, 3), pad)
    v = jnp.pad(v.transpose(0, 2, 1, 3), pad)
    kb = k.reshape(B, H, n_blk, MOBA_BLOCK, Dh)
    vb = v.reshape(B, H, n_blk, MOBA_BLOCK, Dh)
    k_mean = jnp.mean(kb.astype(jnp.float32), axis=3)
    scale = Dh ** -0.5
    k_sel = min(MOBA_TOPK, n_blk)
    n_chunks = s_pad // MOBA_Q_CHUNK
    qc = q.reshape(B, H, n_chunks, MOBA_Q_CHUNK, Dh).transpose(2, 0, 1, 3, 4)
    bi = jnp.arange(B)[:, None, None, None]
    hi = jnp.arange(H)[None, :, None, None]
    blk_ids = jnp.arange(n_blk)

    def chunk_fn(args):
        q_c, c = args
        q_start = c * MOBA_Q_CHUNK
        own = q_start // MOBA_BLOCK
        gate = jnp.einsum('bhqd,bhnd->bhqn', q_c.astype(jnp.float32), k_mean)
        gate = jnp.where(blk_ids[None, None, None, :] < own, gate, -jnp.inf)
        _, sel = lax.top_k(gate, k_sel)
        sel_valid = jnp.arange(k_sel) < own
        k_g = kb[bi, hi, sel]
        v_g = vb[bi, hi, sel]
        s_sel = jnp.einsum('bhqd,bhqkld->bhqkl', q_c, k_g).astype(jnp.float32) * scale
        s_sel = jnp.where(sel_valid[None, None, None, :, None], s_sel, -jnp.inf)
        s_sel = s_sel.reshape(B, H, MOBA_Q_CHUNK, k_sel * MOBA_BLOCK)
        k_own = lax.dynamic_slice_in_dim(kb, own, 1, axis=2)[:, :, 0]
        v_own = lax.dynamic_slice_in_dim(vb, own, 1, axis=2)[:, :, 0]
        s_own = jnp.einsum('bhqd,bhld->bhql', q_c, k_own).astype(jnp.float32) * scale
        q_pos = q_start + jnp.arange(MOBA_Q_CHUNK)
        k_pos = own * MOBA_BLOCK + jnp.arange(MOBA_BLOCK)
        s_own = jnp.where(k_pos[None, :] <= q_pos[:, None], s_own, -jnp.inf)
        p = jax.nn.softmax(jnp.concatenate([s_sel, s_own], axis=-1), axis=-1).astype(v.dtype)
        p_sel = p[..., :k_sel * MOBA_BLOCK].reshape(B, H, MOBA_Q_CHUNK, k_sel, MOBA_BLOCK)
        p_own = p[..., k_sel * MOBA_BLOCK:]
        return (jnp.einsum('bhqkl,bhqkld->bhqd', p_sel, v_g)
                + jnp.einsum('bhql,bhld->bhqd', p_own, v_own))

    out = lax.map(chunk_fn, (qc, jnp.arange(n_chunks)))
    out = out.transpose(1, 2, 0, 3, 4).reshape(B, H, s_pad, Dh)[:, :, :S]
    return out.transpose(0, 2, 1, 3)


def diff_attention(q, k, v, lam_params, subln_g, lambda_init, cos, sin):
    B, S, H, _, dq = q.shape
    q = apply_rope(q, cos, sin)
    k = apply_rope(k, cos, sin)
    lp = lam_params.astype(jnp.float32)
    lam = jnp.exp(jnp.sum(lp[0] * lp[1])) - jnp.exp(jnp.sum(lp[2] * lp[3])) + lambda_init
    scale = dq ** -0.5
    nqb = S // ATTN_Q_BLOCK
    qb = q.reshape(B, nqb, ATTN_Q_BLOCK, H, 2, dq).transpose(1, 0, 2, 3, 4, 5)
    k_pos = jnp.arange(S)

    def block_fn(args):
        q_blk, i = args
        s = jnp.einsum('bqhcd,bkhcd->bhcqk', q_blk, k).astype(jnp.float32) * scale
        q_pos = i * ATTN_Q_BLOCK + jnp.arange(ATTN_Q_BLOCK)
        s = jnp.where(k_pos[None, :] <= q_pos[:, None], s, -jnp.inf)
        p = jax.nn.softmax(s, axis=-1)
        a = p[:, :, 0] - lam * p[:, :, 1]
        return jnp.einsum('bhqk,bkhd->bqhd', a.astype(v.dtype), v)

    o = lax.map(block_fn, (qb, jnp.arange(nqb)))
    o = o.transpose(1, 0, 2, 3, 4).reshape(B, S, H, v.shape[-1])
    return rms_norm(o, subln_g) * (1.0 - lambda_init)


def spatial_gating(u, v, ln_g, ln_b, w_s, b_s):
    B, S, G, C = v.shape
    vf = v.astype(jnp.float32)
    mu = jnp.mean(vf, axis=-1, keepdims=True)
    var = jnp.mean(jnp.square(vf - mu), axis=-1, keepdims=True)
    vn = ((vf - mu) * lax.rsqrt(var + EPS) * ln_g.astype(jnp.float32) + ln_b.astype(jnp.float32)).astype(v.dtype)
    nc = S // SGU_CHUNK
    vn = vn.reshape(B, nc, SGU_CHUNK, G, C)
    tri = jnp.tril(jnp.ones((SGU_CHUNK, SGU_CHUNK), dtype=bool))
    w = jnp.where(tri[None], w_s, jnp.zeros_like(w_s))
    mixed = jnp.einsum('gts,bnsgc->bntgc', w, vn) + b_s.T[None, None, :, :, None]
    return u * mixed.reshape(B, S, G, C)


def setup_inputs(seed: int = 0) -> dict:
    key = jax.random.key(seed)
    ks = jax.random.split(key, 14)
    f32 = jnp.float32

    def nrm(k, shape, scale):
        return jax.random.normal(k, shape, f32) * scale

    return {
        'x': nrm(ks[0], (BATCH, SEQ, D_MODEL), 1.0),
        'attn_norm_g': 1.0 + nrm(ks[1], (DEPTH, D_MODEL), 0.02),
        'w_in': nrm(ks[2], (DEPTH, D_MODEL, IN_WIDTH), D_MODEL ** -0.5),
        'diff_lambda': nrm(ks[3], (DEPTH, 4, DIFF_QK_DIM), 0.1),
        'diff_subln_g': 1.0 + nrm(ks[4], (DEPTH, HEAD_DIM), 0.02),
        'sgu_ln_g': 1.0 + nrm(ks[5], (DEPTH, SGU_GROUPS, SGU_GROUP_DIM), 0.02),
        'sgu_ln_b': nrm(ks[6], (DEPTH, SGU_GROUPS, SGU_GROUP_DIM), 0.02),
        'sgu_w': nrm(ks[7], (DEPTH, SGU_GROUPS, SGU_CHUNK, SGU_CHUNK), SGU_CHUNK ** -0.5),
        'sgu_b': 1.0 + nrm(ks[8], (DEPTH, SGU_GROUPS, SGU_CHUNK), 0.1),
        'w_out': nrm(ks[9], (DEPTH, D_MODEL, D_MODEL), D_MODEL ** -0.5),
        'mlp_norm_g': 1.0 + nrm(ks[10], (DEPTH, D_MODEL), 0.02),
        'w_mlp_in': nrm(ks[11], (DEPTH, D_MODEL, D_FF), D_MODEL ** -0.5),
        'w_mlp_out': nrm(ks[12], (DEPTH, D_FF, D_MODEL), D_FF ** -0.5),
        'final_norm_g': 1.0 + nrm(ks[13], (D_MODEL,), 0.02),
    }


def reference(x, attn_norm_g, w_in, diff_lambda, diff_subln_g, sgu_ln_g, sgu_ln_b,
              sgu_w, sgu_b, w_out, mlp_norm_g, w_mlp_in, w_mlp_out, final_norm_g):
    B, S, _ = x.shape
    cos_m, sin_m = rope_tables(S, HEAD_DIM)
    cos_d, sin_d = rope_tables(S, DIFF_QK_DIM)
    for l in range(DEPTH):
        lambda_init = 0.8 - 0.6 * math.exp(-0.3 * l)
        h = rms_norm(x, attn_norm_g[l])
        proj = h @ w_in[l]
        mq, mk, mv, dq, dk, dv, su, sv = jnp.split(proj, IN_SPLITS, axis=-1)
        moba_o = moba_attention(mq.reshape(B, S, MOBA_HEADS, HEAD_DIM),
                                mk.reshape(B, S, MOBA_HEADS, HEAD_DIM),
                                mv.reshape(B, S, MOBA_HEADS, HEAD_DIM), cos_m, sin_m)
        diff_o = diff_attention(dq.reshape(B, S, DIFF_HEADS, 2, DIFF_QK_DIM),
                                dk.reshape(B, S, DIFF_HEADS, 2, DIFF_QK_DIM),
                                dv.reshape(B, S, DIFF_HEADS, HEAD_DIM),
                                diff_lambda[l], diff_subln_g[l], lambda_init, cos_d, sin_d)
        sgu_o = spatial_gating(jax.nn.gelu(su).reshape(B, S, SGU_GROUPS, SGU_GROUP_DIM),
                               jax.nn.gelu(sv).reshape(B, S, SGU_GROUPS, SGU_GROUP_DIM),
                               sgu_ln_g[l], sgu_ln_b[l], sgu_w[l], sgu_b[l])
        mix = jnp.concatenate([moba_o.reshape(B, S, MOBA_WIDTH),
                               diff_o.reshape(B, S, DIFF_WIDTH),
                               sgu_o.reshape(B, S, SGU_WIDTH)], axis=-1)
        x = x + mix @ w_out[l]
        h = rms_norm(x, mlp_norm_g[l])
        x = x + jnp.square(jax.nn.relu(h @ w_mlp_in[l])) @ w_mlp_out[l]
    return rms_norm(x, final_norm_g)
```

```cpp
#include <hip/hip_runtime.h>
#include <hip/hip_cooperative_groups.h>
#include <cstdio>
#include <cstdint>
namespace cg = cooperative_groups;

namespace pg8 {
#define PG8_LAS __attribute__((address_space(3)))
typedef unsigned short bf16_t;
typedef short bf16x8 __attribute__((ext_vector_type(8)));
typedef float f32x4 __attribute__((ext_vector_type(4)));
typedef unsigned u32x4 __attribute__((ext_vector_type(4)));
typedef unsigned u32x2 __attribute__((ext_vector_type(2)));
constexpr int BM = 256, BK = 64, HALF = 128, HTB = HALF * BK * 2  , STAGE_BYTES = 8 * HTB, NXCD = 8, WGM = 8;

__host__ __device__ __forceinline__ int lds_byte(int r, int c) { const int st = (r >> 4) * 2 + (c >> 5), rr = r & 15, cc = c & 31, ob = rr * 64 + cc * 2; return st * 1024 + (ob ^ (((ob >> 9) & 1) << 5)); }
__host__ __device__ __forceinline__ void stage_rc(int b, int& R, int& C) { const int st = b / 1024, sb = b % 1024, swz = sb ^ (((sb >> 9) & 1) << 5); R = (st >> 1) * 16 + swz / 64; C = (st & 1) * 32 + (swz % 64) / 2; }
__host__ __device__ __forceinline__ int perm32(int rho) { const int n = rho >> 4, i = rho & 15; return 8 * (i >> 2) + 4 * n + (i & 3); }

struct Unit { int pm, pn, ui; };
struct Gemm { const bf16_t* A; const bf16_t* Bt; int M, N, K; };

struct StaticOrder {
    int nM, nN, nwg, G, c;
    __host__ __device__ void init(int M, int N, int G_, int c_) { nM = M / BM; nN = N / BM; nwg = nM * nN; G = G_; c = c_; }
    __host__ __device__ bool next(int i, Unit& u) const {
        const long L = (long)i * G + c; if (L >= nwg) return false;
        int wgid = (int)L; { const int q = nwg / NXCD, r = nwg % NXCD, xcd = wgid % NXCD, off = wgid / NXCD; wgid = (xcd < r ? xcd * (q + 1) : r * (q + 1) + (xcd - r) * q) + off; }
        const int nig = WGM * nN, gid = wgid / nig, fm = gid * WGM, gsz = (nM - fm) < WGM ? (nM - fm) : WGM;
        u.pm = fm + ((wgid % nig) % gsz); u.pn = (wgid % nig) / gsz; u.ui = i; return true;
    }
    __device__ __forceinline__ void a_ready(const Unit&) const {}
    __device__ __forceinline__ void done(const Unit&) const {}
};

typedef float f32x2 __attribute__((ext_vector_type(2)));
typedef __bf16 bf16x2_t __attribute__((ext_vector_type(2)));
__device__ __forceinline__ float shx(float v, int k, int lane) { return __int_as_float(__builtin_amdgcn_ds_bpermute((lane ^ k) << 2, __float_as_int(v))); }
__device__ __forceinline__ unsigned cvt_pk_bf16(float lo, float hi) { f32x2 v = {lo, hi}; bf16x2_t b = __builtin_convertvector(v, bf16x2_t); return __builtin_bit_cast(unsigned, b); }

struct EpiResid {
    static constexpr bool PERM = true, NEEDS_PREP = false;
    bf16_t* XB; float* SS; int ldc;
    __device__ __forceinline__ void operator()(const f32x4 (&acc)[2][2][4][2], const Unit& u, int wr, int wc, int fr, int fq) const {
        const int row0 = u.pm * BM + wr * 64 + fr, col0 = u.pn * BM + wc * 32 + 8 * fq;
        u32x4 xin[2][4][2];
#pragma unroll
        for (int ai = 0; ai < 2; ++ai)
#pragma unroll
            for (int m = 0; m < 4; ++m)
#pragma unroll
                for (int bj = 0; bj < 2; ++bj) xin[ai][m][bj] = *(const u32x4*)(XB + (size_t)(row0 + ai * HALF + m * 16) * ldc + col0 + bj * HALF);
#pragma unroll
        for (int ai = 0; ai < 2; ++ai)
#pragma unroll
            for (int m = 0; m < 4; ++m) { const int row = row0 + ai * HALF + m * 16; const size_t off = (size_t)row * ldc + col0; float part = 0.f;
#pragma unroll
                for (int bj = 0; bj < 2; ++bj) { const u32x4 xi = xin[ai][m][bj]; const f32x4 a0 = acc[ai][bj][m][0], a1 = acc[ai][bj][m][1];
                    u32x4 w;
                    w.x = cvt_pk_bf16(a0[0] + __uint_as_float(xi.x << 16), a0[1] + __uint_as_float(xi.x & 0xffff0000u));
                    w.y = cvt_pk_bf16(a0[2] + __uint_as_float(xi.y << 16), a0[3] + __uint_as_float(xi.y & 0xffff0000u));
                    w.z = cvt_pk_bf16(a1[0] + __uint_as_float(xi.z << 16), a1[1] + __uint_as_float(xi.z & 0xffff0000u));
                    w.w = cvt_pk_bf16(a1[2] + __uint_as_float(xi.w << 16), a1[3] + __uint_as_float(xi.w & 0xffff0000u));
                    *(u32x4*)(XB + off + bj * HALF) = w;
#pragma unroll
                    for (int e = 0; e < 4; ++e) { const float lo = __uint_as_float(w[e] << 16), hi = __uint_as_float(w[e] & 0xffff0000u); part += lo * lo + hi * hi; } }
                part += shx(part, 16, fq * 16 + fr); part += shx(part, 32, fq * 16 + fr);
                if (fq == 0) SS[(size_t)row * 32 + u.pn * 4 + wc] = part; }
    }
};
template <int ACT> struct EpiBf16 {
    static constexpr bool PERM = true;
    static constexpr bool NEEDS_PREP = true;
    bf16_t* O; int ldc; const float* SS; float inv_k; const PG8_LAS float* rstab;
    template <class Sched> __device__ __forceinline__ void prep(const Sched& S, int tid) const {
        PG8_LAS float* tab = (PG8_LAS float*)rstab;
#pragma unroll
        for (int k = 0; k < 2; ++k) { const int ui = (tid >> 8) + 2 * k; Unit u;
            if (S.next(ui, u)) { const f32x4* sp = (const f32x4*)(SS + (size_t)(u.pm * BM + (tid & 255)) * 32); float tot = 0.f;
#pragma unroll
                for (int j = 0; j < 8; ++j) { const f32x4 a = sp[j]; tot += (a[0] + a[1]) + (a[2] + a[3]); }
                tab[ui * 256 + (tid & 255)] = rsqrtf(tot * inv_k + 1e-6f); } }
    }
    __device__ __forceinline__ void operator()(const f32x4 (&acc)[2][2][4][2], const Unit& u, int wr, int wc, int fr, int fq) const {
        const int row0 = u.pm * BM + wr * 64 + fr; const int col0 = u.pn * BM + wc * 32 + 8 * fq;
        float rsv[2][4];
#pragma unroll
        for (int ai = 0; ai < 2; ++ai)
#pragma unroll
            for (int m = 0; m < 4; ++m) rsv[ai][m] = rstab[(u.ui & 3) * 256 + wr * 64 + fr + ai * HALF + m * 16];
#pragma unroll
        for (int ai = 0; ai < 2; ++ai)
#pragma unroll
            for (int m = 0; m < 4; ++m) { const int row = row0 + ai * HALF + m * 16; bf16_t* rowp = O + (size_t)row * ldc + col0;
                const float rs = rsv[ai][m];
#pragma unroll
                for (int bj = 0; bj < 2; ++bj) { f32x4 v0 = acc[ai][bj][m][0] * rs, v1 = acc[ai][bj][m][1] * rs;
                    if (ACT == 1) {
#pragma unroll
                        for (int j = 0; j < 4; ++j) { const float a = fmaxf(v0[j], 0.f), b = fmaxf(v1[j], 0.f); v0[j] = a * a; v1[j] = b * b; } }
                    u32x4 w; w.x = cvt_pk_bf16(v0[0], v0[1]); w.y = cvt_pk_bf16(v0[2], v0[3]); w.z = cvt_pk_bf16(v1[0], v1[1]); w.w = cvt_pk_bf16(v1[2], v1[3]);
                    *(u32x4*)(rowp + bj * HALF) = w; } }
    }
};

template <class Epi, class Sched>
__device__ __forceinline__ void gemm_phase(PG8_LAS unsigned char* lds, const Gemm g, const Sched& S, const Epi& E) {
    int tid_ = threadIdx.x; asm volatile("" : "+v"(tid_));
    const int tid = tid_, wid = __builtin_amdgcn_readfirstlane(tid >> 6), lane = tid & 63, wr = wid >> 2, wc = wid & 3, fr = lane & 15, fq = lane >> 4;
    const int K = g.K, nt = K / BK;
    unsigned voffA[2], voffB[2];
#pragma unroll
    for (int i = 0; i < 2; ++i) { int R, C; stage_rc(tid * 16 + i * 8192, R, C); const int Rb = Epi::PERM ? ((R & ~31) + perm32(R & 31)) : R;
        voffA[i] = (unsigned)(R * K + C) * 2u; voffB[i] = (unsigned)(Rb * K + C) * 2u; }
    const size_t kstep = (size_t)(BK * 2);
    const size_t hstep = (size_t)HALF * K * 2;
    const size_t tstep = 2 * hstep;
    const unsigned ldsw = (unsigned)wid * 1024u;
    const int aoff = lds_byte(wr * 64 + fr, fq * 8), boff = lds_byte(wc * 32 + fr, fq * 8);
#define PG8_SA(b, h) (((b) * 2 + (h)) * HTB)
#define PG8_SB(b, h) ((4 + (b) * 2 + (h)) * HTB)
#define PG8_STAGE(bufoff, gbase, voff) do { _Pragma("unroll") for (int _i = 0; _i < 2; ++_i) \
        __builtin_amdgcn_global_load_lds((const unsigned*)((const char*)(gbase) + (voff)[_i]), (PG8_LAS unsigned*)(lds + (bufoff) + ldsw + _i * 8192), 16, 0, 0); } while (0)
#define PG8_LDA(dst, b, h) do { _Pragma("unroll") for (int m = 0; m < 4; ++m) _Pragma("unroll") for (int k = 0; k < 2; ++k) dst[m][k] = *(const PG8_LAS bf16x8*)(lds + PG8_SA(b, h) + aoff + m * 2048 + k * 1024); } while (0)
#define PG8_LDB(dst, b, h) do { _Pragma("unroll") for (int n = 0; n < 2; ++n) _Pragma("unroll") for (int k = 0; k < 2; ++k) dst[n][k] = *(const PG8_LAS bf16x8*)(lds + PG8_SB(b, h) + boff + n * 2048 + k * 1024); } while (0)
#define PG8_MMA(ai, bj, At, Bt) do { __builtin_amdgcn_s_setprio(1); _Pragma("unroll") for (int m = 0; m < 4; ++m) _Pragma("unroll") for (int n = 0; n < 2; ++n) _Pragma("unroll") for (int k = 0; k < 2; ++k) \
        acc[ai][bj][m][n] = __builtin_amdgcn_mfma_f32_16x16x32_bf16(Bt[n][k], At[m][k], acc[ai][bj][m][n], 0, 0, 0); __builtin_amdgcn_s_setprio(0); } while (0)
#define PG8_WAIT_V(n) asm volatile("s_waitcnt vmcnt(" #n ")" ::: "memory")
#define PG8_WAIT_L(n) asm volatile("s_waitcnt lgkmcnt(" #n ")" ::: "memory")
#define PG8_BAR __builtin_amdgcn_s_barrier()
#define PG8_SCHED __builtin_amdgcn_sched_barrier(0)
    Unit cur, nxt; int ui = 0;
    if (!S.next(0, cur)) return;
    f32x4 acc[2][2][4][2];
#pragma unroll
    for (int a = 0; a < 2; ++a)
#pragma unroll
        for (int b = 0; b < 2; ++b)
#pragma unroll
            for (int m = 0; m < 4; ++m)
#pragma unroll
                for (int n = 0; n < 2; ++n) acc[a][b][m][n] = (f32x4){0.f, 0.f, 0.f, 0.f};
    bf16x8 At[4][2], B0[2][2], B1[2][2];
    const char* cA = (const char*)g.A + (size_t)cur.pm * tstep; const char* cB = (const char*)g.Bt + (size_t)cur.pn * tstep;
    if constexpr (Epi::NEEDS_PREP) { E.prep(S, tid); asm volatile("s_waitcnt lgkmcnt(0)" ::: "memory"); __builtin_amdgcn_s_barrier(); }
    S.a_ready(cur);
    PG8_STAGE(PG8_SB(0, 0), cB, voffB); PG8_STAGE(PG8_SA(0, 0), cA, voffA); PG8_STAGE(PG8_SB(0, 1), cB + hstep, voffB); PG8_STAGE(PG8_SA(0, 1), cA + hstep, voffA);
    if (wr == 1) PG8_BAR;
    PG8_WAIT_V(4); PG8_BAR;
    PG8_STAGE(PG8_SB(1, 0), cB + kstep, voffB); PG8_STAGE(PG8_SA(1, 0), cA + kstep, voffA); PG8_STAGE(PG8_SB(1, 1), cB + hstep + kstep, voffB);
    PG8_WAIT_V(6); PG8_BAR;
    for (;;) {
        const bool has_next = S.next(ui + 1, nxt);
        const char* nA = has_next ? (const char*)g.A + (size_t)nxt.pm * tstep : cA; const char* nB = has_next ? (const char*)g.Bt + (size_t)nxt.pn * tstep : cB;
        for (int t = 0; t < nt; t += 2) {
            const bool last = (t == nt - 2);
            const char* a1 = cA + (size_t)(t + 1) * kstep;
            const char* a2 = last ? nA : cA + (size_t)(t + 2) * kstep; const char* b2 = last ? nB : cB + (size_t)(t + 2) * kstep;
            const char* a3 = a2 + kstep; const char* b3 = b2 + kstep;
            if (last && has_next) S.a_ready(nxt);
            PG8_LDB(B0, 0, 0); PG8_SCHED; PG8_LDA(At, 0, 0); PG8_STAGE(PG8_SA(1, 1), a1 + hstep, voffA);
            PG8_WAIT_L(8); PG8_BAR; PG8_WAIT_L(0); PG8_MMA(0, 0, At, B0); PG8_BAR; PG8_SCHED;
            PG8_LDB(B1, 0, 1); PG8_STAGE(PG8_SB(0, 0), b2, voffB);
            PG8_BAR; PG8_WAIT_L(0); PG8_MMA(0, 1, At, B1); PG8_BAR;
            PG8_LDA(At, 0, 1); PG8_STAGE(PG8_SA(0, 0), a2, voffA);
            PG8_BAR; PG8_WAIT_L(0); PG8_MMA(1, 0, At, B0); PG8_BAR; PG8_SCHED;
            PG8_STAGE(PG8_SB(0, 1), b2 + hstep, voffB);
            PG8_WAIT_V(6); PG8_BAR; PG8_MMA(1, 1, At, B1); PG8_BAR;
            PG8_LDB(B0, 1, 0); PG8_SCHED; PG8_LDA(At, 1, 0); PG8_STAGE(PG8_SA(0, 1), a2 + hstep, voffA);
            PG8_WAIT_L(8); PG8_BAR; PG8_WAIT_L(0); PG8_MMA(0, 0, At, B0); PG8_BAR; PG8_SCHED;
            PG8_LDB(B1, 1, 1); PG8_STAGE(PG8_SB(1, 0), b3, voffB);
            PG8_BAR; PG8_WAIT_L(0); PG8_MMA(0, 1, At, B1); PG8_BAR;
            PG8_LDA(At, 1, 1); PG8_STAGE(PG8_SA(1, 0), a3, voffA);
            PG8_BAR; PG8_WAIT_L(0); PG8_MMA(1, 0, At, B0); PG8_BAR; PG8_SCHED;
            PG8_STAGE(PG8_SB(1, 1), b3 + hstep, voffB);
            PG8_WAIT_V(6); PG8_BAR; PG8_MMA(1, 1, At, B1); PG8_BAR;
        }
        E(acc, cur, wr, wc, fr, fq); S.done(cur);
        if (!has_next) break;
#pragma unroll
        for (int a = 0; a < 2; ++a)
#pragma unroll
            for (int b = 0; b < 2; ++b)
#pragma unroll
                for (int m = 0; m < 4; ++m)
#pragma unroll
                    for (int n = 0; n < 2; ++n) acc[a][b][m][n] = (f32x4){0.f, 0.f, 0.f, 0.f};
        cur = nxt; cA = nA; cB = nB; ++ui;
    }
    PG8_WAIT_V(0);
    if (wr == 0) PG8_BAR;
    PG8_BAR;
#undef PG8_SA
#undef PG8_SB
#undef PG8_STAGE
#undef PG8_LDA
#undef PG8_LDB
#undef PG8_MMA
#undef PG8_WAIT_V
#undef PG8_WAIT_L
#undef PG8_BAR
#undef PG8_SCHED
}
}

constexpr int SEQ = 8192, DM = 2048, DEPTH = 4, INW = 5632, DFF = 8192;
constexpr int C_MQ = 0, C_MK = 768, C_MV = 1536, C_DQ = 2304, C_DK = 3072, C_DV = 3840, C_SU = 4608, C_SV = 5120;
constexpr int NWAVES = 8, NTHR = 512;
constexpr int LDS_BYTES = 147456;
constexpr int LDS_MISC = 139264;
constexpr float EPS = 1e-6f;

constexpr size_t WS_CTL = 0;
constexpr size_t WS_BAR = 16384;
constexpr size_t WS_ORDER = 4096;
constexpr size_t WS_WIN = 65536;
constexpr size_t WS_WOUT = WS_WIN + (size_t)DEPTH * INW * DM * 2;
constexpr size_t WS_W1 = WS_WOUT + (size_t)DEPTH * DM * DM * 2;
constexpr size_t WS_W2 = WS_W1 + (size_t)DEPTH * DFF * DM * 2;
constexpr size_t WS_XRES = WS_W2 + (size_t)DEPTH * DM * DFF * 2;
constexpr size_t WS_H = WS_XRES + (size_t)SEQ * DM * 4;
constexpr size_t WS_PROJ = WS_H + (size_t)SEQ * DM * 2;
constexpr size_t WS_VT = WS_PROJ + (size_t)SEQ * INW * 2;
constexpr size_t WS_VNT = WS_VT + (size_t)12 * 128 * SEQ * 2;
constexpr size_t WS_KM = WS_VNT + (size_t)SEQ * 512 * 2;
constexpr size_t WS_SEL = WS_KM + (size_t)6 * 32 * 128 * 4;
constexpr size_t WS_MIX = WS_SEL + (size_t)6 * SEQ * 4;
constexpr size_t WS_HID = WS_MIX + (size_t)SEQ * DM * 2;
constexpr size_t WS_SS = WS_HID + (size_t)SEQ * DFF * 2;
constexpr size_t WS_END = WS_SS + (size_t)9 * SEQ * 32 * 4;

#define LAS __attribute__((address_space(3)))
typedef unsigned short bf16;
typedef short bf16x8 __attribute__((ext_vector_type(8)));
typedef short s16x4 __attribute__((ext_vector_type(4)));
typedef float f32x4 __attribute__((ext_vector_type(4)));
typedef float f32x16 __attribute__((ext_vector_type(16)));
typedef unsigned u32x4 __attribute__((ext_vector_type(4)));
typedef unsigned u32x2 __attribute__((ext_vector_type(2)));
#define MFMA32(a, b, c) __builtin_amdgcn_mfma_f32_32x32x16_bf16((a), (b), (c), 0, 0, 0)

__device__ __forceinline__ unsigned pk2(float lo, float hi) { return pg8::cvt_pk_bf16(lo, hi); }
__device__ __forceinline__ float bf_lo(unsigned w) { return __uint_as_float(w << 16); }
__device__ __forceinline__ float bf_hi(unsigned w) { return __uint_as_float(w & 0xffff0000u); }
__device__ __forceinline__ float shx(float v, int k, int lane) { return __int_as_float(__builtin_amdgcn_ds_bpermute((lane ^ k) << 2, __float_as_int(v))); }
__device__ __forceinline__ int shxi(int v, int k, int lane) { return __builtin_amdgcn_ds_bpermute((lane ^ k) << 2, v); }
__device__ __forceinline__ float shx32(float v, int lane) { const unsigned u = __float_as_uint(v); const auto r = __builtin_amdgcn_permlane32_swap(u, u, false, false); return __uint_as_float((lane >> 5) ? r[0] : r[1]); }
__device__ __forceinline__ float wave_sum(float v, int lane) {
#pragma unroll
    for (int o = 1; o < 64; o <<= 1) v += shx(v, o, lane);
    return v;
}
__device__ __forceinline__ float gelu_t(float x) {
    const float u = 0.7978845608028654f * (x + 0.044715f * x * x * x);
    const float e = __expf(2.f * u);
    const float th = 1.f - 2.f / (e + 1.f);
    return 0.5f * x * (1.f + th);
}
__device__ __forceinline__ int tid_opaque() { int t = threadIdx.x; asm volatile("" : "+v"(t)); return t; }
__device__ __forceinline__ int crow(int reg, int h) { return (reg & 3) + 8 * (reg >> 2) + 4 * h; }

struct Params {
    const float* x; const float* attn_g; const float* w_in; const float* diff_lambda; const float* subln_g;
    const float* sgu_ln_g; const float* sgu_ln_b; const float* sgu_w; const float* sgu_b; const float* w_out;
    const float* mlp_g; const float* w1; const float* w2; const float* final_g;
    float* out; unsigned char* ws;
};

__device__ __forceinline__ void transpose_item(const float* W, int K, int N, bf16* WT, LAS float* scr, int item, int lane, const float* gk) {
    const int nblk = N / 32, kb = item / nblk, nb = item % nblk, k0 = 64 * kb, n0 = 32 * nb;
    float wv[32];
#pragma unroll
    for (int i = 0; i < 32; ++i) { const int kk = 2 * i + (lane >> 5); wv[i] = W[(size_t)(k0 + kk) * N + n0 + (lane & 31)]; }
    if (gk) {
#pragma unroll
        for (int i = 0; i < 32; ++i) wv[i] *= gk[k0 + 2 * i + (lane >> 5)];
    }
#pragma unroll
    for (int i = 0; i < 32; ++i) { const int kk = 2 * i + (lane >> 5); scr[kk * 33 + (lane & 31)] = wv[i]; }
    asm volatile("s_waitcnt lgkmcnt(0)" ::: "memory");
    const int c = lane & 7;
#pragma unroll
    for (int j = 0; j < 4; ++j) { const int n = (lane >> 3) + 8 * j; const LAS float* s = scr + (8 * c) * 33 + n;
        u32x4 o; o.x = pk2(s[0 * 33], s[1 * 33]); o.y = pk2(s[2 * 33], s[3 * 33]); o.z = pk2(s[4 * 33], s[5 * 33]); o.w = pk2(s[6 * 33], s[7 * 33]);
        *(u32x4*)(WT + (size_t)(n0 + n) * K + k0 + 8 * c) = o; }
    asm volatile("s_waitcnt lgkmcnt(0)" ::: "memory");
}

constexpr int NU_ATT = 192 + 384, NU_ALL = NU_ATT + 256;
__device__ __forceinline__ float unit_cost(int u) { return u < 192 ? 4.0f * (float)((u & 31) + 1) : (u < NU_ATT ? 1.7f * (float)(((u - 192) & 63) + 1) : 0.5f); }

constexpr int W_I_IN = (DM / 64) * (INW / 32), W_I_OUT = (DM / 64) * (DM / 32), W_I_1 = (DM / 64) * (DFF / 32), W_I_2 = (DFF / 64) * (DM / 32);
constexpr int W_PER_LAYER = W_I_IN + W_I_OUT + W_I_1 + W_I_2;
constexpr int FILL_UNITS = 256;
constexpr int W_REM = W_PER_LAYER - FILL_UNITS * 32;
__device__ __forceinline__ void convert_item(const Params& p, int l, int r, LAS float* scr, int lane) {
    if (r < W_I_IN) { transpose_item(p.w_in + (size_t)l * DM * INW, DM, INW, (bf16*)(p.ws + WS_WIN) + (size_t)l * INW * DM, scr, r, lane, p.attn_g + (size_t)l * DM); return; } r -= W_I_IN;
    if (r < W_I_OUT) { transpose_item(p.w_out + (size_t)l * DM * DM, DM, DM, (bf16*)(p.ws + WS_WOUT) + (size_t)l * DM * DM, scr, r, lane, nullptr); return; } r -= W_I_OUT;
    if (r < W_I_1) { transpose_item(p.w1 + (size_t)l * DM * DFF, DM, DFF, (bf16*)(p.ws + WS_W1) + (size_t)l * DFF * DM, scr, r, lane, p.mlp_g + (size_t)l * DM); return; } r -= W_I_1;
    transpose_item(p.w2 + (size_t)l * DFF * DM, DFF, DM, (bf16*)(p.ws + WS_W2) + (size_t)l * DM * DFF, scr, r, lane, nullptr);
}
__device__ __forceinline__ void fill_convert(const Params& p, int l, LAS unsigned char* lds, unsigned* ctr) {
    const int tid = tid_opaque(), lane = tid & 63, wave = tid >> 6;
    volatile LAS int* misc = (volatile LAS int*)(lds + LDS_MISC);
    LAS float* scr = (LAS float*)(lds + wave * 16384);
    for (;;) {
        if (tid == 0) misc[2] = (int)atomicAdd(ctr, 1u);
        __syncthreads();
        const int u = misc[2];
        __syncthreads();
        if (u >= FILL_UNITS) break;
        for (int k = 0; k < 4; ++k) convert_item(p, l, u * 32 + wave * 4 + k, scr, lane);
    }
}
__device__ __forceinline__ void phase_weights(const Params& p, LAS unsigned char* lds) {
    const int tid = tid_opaque(), lane = tid & 63, wave = tid >> 6;
    LAS float* scr = (LAS float*)(lds + wave * 16384);
    const int gw = blockIdx.x * NWAVES + wave, NGW = gridDim.x * NWAVES;
    for (int it = gw; it < W_PER_LAYER + (DEPTH - 1) * W_REM; it += NGW) {
        if (it < W_PER_LAYER) convert_item(p, 0, it, scr, lane);
        else { const int k = it - W_PER_LAYER; convert_item(p, 1 + k / W_REM, FILL_UNITS * 32 + k % W_REM, scr, lane); }
    }
    if (blockIdx.x == 0) {
        unsigned* ctl = (unsigned*)(p.ws + WS_CTL);
        if (tid < 64) ctl[tid] = 0u;
        int* order = (int*)(p.ws + WS_ORDER);
        for (int u = tid; u < NU_ALL; u += NTHR) {
            const float cu = unit_cost(u); int rank = 0;
            for (int j = 0; j < NU_ALL; ++j) { const float cj = unit_cost(j); rank += (cj > cu || (cj == cu && j < u)) ? 1 : 0; }
            order[rank] = u;
        }
    }
}

__device__ __forceinline__ void phase_x0(const float* X, bf16* XB, float* SS0) {
    const int tid = tid_opaque(), lane = tid & 63, wave = tid >> 6;
    const int gw = blockIdx.x * NWAVES + wave, NGW = gridDim.x * NWAVES;
    for (int m = gw; m < SEQ; m += NGW) {
        const f32x4* xr = (const f32x4*)(X + (size_t)m * DM) + lane;
        f32x4 v[8]; float s = 0.f;
#pragma unroll
        for (int j = 0; j < 8; ++j) { v[j] = xr[64 * j]; s += (v[j].x * v[j].x + v[j].y * v[j].y) + (v[j].z * v[j].z + v[j].w * v[j].w); }
        s = wave_sum(s, lane);
        if (lane < 32) SS0[(size_t)m * 32 + lane] = lane == 0 ? s : 0.f;
        u32x2* o8 = (u32x2*)(XB + (size_t)m * DM) + lane;
#pragma unroll
        for (int j = 0; j < 8; ++j) { u32x2 w; w.x = pk2(v[j].x, v[j].y); w.y = pk2(v[j].z, v[j].w); o8[64 * j] = w; }
    }
}
__device__ __forceinline__ void phase_norm_f32(const bf16* X, const float* g, const float* SS, float* O) {
    const int tid = tid_opaque(), lane = tid & 63, wave = tid >> 6;
    const int gw = blockIdx.x * NWAVES + wave, NGW = gridDim.x * NWAVES;
    for (int m = gw; m < SEQ; m += NGW) {
        const u32x4* xr = (const u32x4*)(X + (size_t)m * DM) + lane;
        const float rs = rsqrtf(wave_sum(lane < 32 ? SS[(size_t)m * 32 + lane] : 0.f, lane) * (1.f / DM) + EPS);
        f32x4* o = (f32x4*)(O + (size_t)m * DM) + 2 * lane;
#pragma unroll
        for (int j = 0; j < 4; ++j) { const u32x4 xv = xr[64 * j]; const f32x4 g0 = ((const f32x4*)g)[2 * lane + 128 * j], g1 = ((const f32x4*)g)[2 * lane + 128 * j + 1];
            o[128 * j] = (f32x4){bf_lo(xv.x), bf_hi(xv.x), bf_lo(xv.y), bf_hi(xv.y)} * rs * g0;
            o[128 * j + 1] = (f32x4){bf_lo(xv.z), bf_hi(xv.z), bf_lo(xv.w), bf_hi(xv.w)} * rs * g1; }
    }
}

constexpr int TP_STRIDE = 132;
__device__ __forceinline__ void post_unit(const Params& p, int layer, int unit, LAS unsigned char* lds) {
    const int tid = tid_opaque();
    const int rb = unit / 40, cbi = unit % 40, cb = cbi < 36 ? cbi : cbi + 4;
    const int col0 = cb * 128;
    const int r64 = tid >> 3, j = tid & 7;
    bf16* proj = (bf16*)(p.ws + WS_PROJ);
    int type;
    int hh = 0;
    if (cb < 6) type = 0; else if (cb < 12) type = 1; else if (cb < 18) { type = 2; hh = cb - 12; } else if (cb < 30) type = 3; else if (cb < 36) { type = 2; hh = 6 + cb - 30; } else { type = 4; hh = cb - 40; }
    int c0, c1;
    if (type <= 1) { c0 = 8 * j; c1 = c0 + 64; }
    else if (type == 3) { c0 = (j < 4) ? 8 * j : 64 + 8 * (j - 4); c1 = c0 + 32; }
    else { c0 = 16 * j; c1 = c0 + 8; }
    double inv2pi[8];
    if (type <= 1 || type == 3) {
        const float half = (type == 3) ? 32.f : 64.f; const int i0 = (type == 3) ? 8 * (j & 3) : 8 * j;
#pragma unroll
        for (int e = 0; e < 8; ++e) inv2pi[e] = (double)exp2f(-(float)(i0 + e) * (13.287712379549449f / half)) * 0.15915494309189535;
    } else {
#pragma unroll
        for (int e = 0; e < 8; ++e) inv2pi[e] = 0.0;
    }
    float csa[8], csb[8];
#pragma unroll
    for (int e = 0; e < 8; ++e) { csa[e] = 0.f; csb[e] = 0.f; }
    LAS bf16* tile = (LAS bf16*)lds;
    u32x4 na = *(const u32x4*)(proj + (size_t)(rb * 256 + r64) * INW + col0 + c0), nb = *(const u32x4*)(proj + (size_t)(rb * 256 + r64) * INW + col0 + c1);
    for (int sub = 0; sub < 4; ++sub) {
        const int row = rb * 256 + sub * 64 + r64;
        bf16* rp = proj + (size_t)row * INW + col0;
        const u32x4 ua = na, ub = nb;
        if (sub < 3) { na = *(const u32x4*)(rp + (size_t)64 * INW + c0); nb = *(const u32x4*)(rp + (size_t)64 * INW + c1); }
        float xa[8], xb[8];
#pragma unroll
        for (int e = 0; e < 4; ++e) { xa[2 * e] = bf_lo(ua[e]); xa[2 * e + 1] = bf_hi(ua[e]); xb[2 * e] = bf_lo(ub[e]); xb[2 * e + 1] = bf_hi(ub[e]); }
        if (type <= 1 || type == 3) {
            float ya[8], yb[8];
#pragma unroll
            for (int e = 0; e < 8; ++e) {
                double rev = (double)row * inv2pi[e]; rev -= floor(rev);
                const float fr = (float)rev;
                const float sn = __builtin_amdgcn_sinf(fr), cs = __builtin_amdgcn_cosf(fr);
                ya[e] = xa[e] * cs - xb[e] * sn; yb[e] = xb[e] * cs + xa[e] * sn;
                csa[e] += ya[e]; csb[e] += yb[e];
            }
            u32x4 oa, ob;
#pragma unroll
            for (int e = 0; e < 4; ++e) { oa[e] = pk2(ya[2 * e], ya[2 * e + 1]); ob[e] = pk2(yb[2 * e], yb[2 * e + 1]); }
            *(u32x4*)(rp + c0) = oa; *(u32x4*)(rp + c1) = ob;
        } else {
            u32x4 oa = ua, ob = ub;
            if (type == 4) {
                float s = 0.f;
#pragma unroll
                for (int e = 0; e < 8; ++e) { xa[e] = gelu_t(xa[e]); xb[e] = gelu_t(xb[e]); s += xa[e] + xb[e]; }
                s += shx(s, 1, tid & 63); s += shx(s, 2, tid & 63); s += shx(s, 4, tid & 63);
                const float mu = s * (1.f / 128.f); float s2 = 0.f;
#pragma unroll
                for (int e = 0; e < 8; ++e) { xa[e] -= mu; xb[e] -= mu; s2 += xa[e] * xa[e] + xb[e] * xb[e]; }
                s2 += shx(s2, 1, tid & 63); s2 += shx(s2, 2, tid & 63); s2 += shx(s2, 4, tid & 63);
                const float rstd = rsqrtf(s2 * (1.f / 128.f) + EPS);
                const float* lg = p.sgu_ln_g + ((size_t)layer * 4 + hh) * 128; const float* lb = p.sgu_ln_b + ((size_t)layer * 4 + hh) * 128;
#pragma unroll
                for (int e = 0; e < 8; ++e) { xa[e] = xa[e] * rstd * lg[c0 + e] + lb[c0 + e]; xb[e] = xb[e] * rstd * lg[c1 + e] + lb[c1 + e]; }
#pragma unroll
                for (int e = 0; e < 4; ++e) { oa[e] = pk2(xa[2 * e], xa[2 * e + 1]); ob[e] = pk2(xb[2 * e], xb[2 * e + 1]); }
            }
            __syncthreads();
            LAS u32x2* t0 = (LAS u32x2*)(tile + r64 * TP_STRIDE + c0);
            t0[0] = (u32x2){oa.x, oa.y}; t0[1] = (u32x2){oa.z, oa.w}; t0[2] = (u32x2){ob.x, ob.y}; t0[3] = (u32x2){ob.z, ob.w};
            __syncthreads();
            const int dv = tid >> 2, ch = tid & 3;
            unsigned w[8];
#pragma unroll
            for (int k = 0; k < 8; ++k) { const unsigned lo = tile[(16 * ch + 2 * k) * TP_STRIDE + dv], hi = tile[(16 * ch + 2 * k + 1) * TP_STRIDE + dv]; w[k] = lo | (hi << 16); }
            bf16* dst;
            if (type == 2) dst = (bf16*)(p.ws + WS_VT) + ((size_t)hh * 128 + dv) * SEQ + rb * 256 + sub * 64 + 16 * ch;
            else dst = (bf16*)(p.ws + WS_VNT) + ((size_t)((rb * 2 + (sub >> 1)) * 4 + hh) * 128 + dv) * 128 + (sub & 1) * 64 + 16 * ch;
            if (type == 2) { *(u32x4*)dst = (u32x4){w[0], w[1], w[4], w[5]}; *(u32x4*)(dst + 8) = (u32x4){w[2], w[3], w[6], w[7]}; }
            else { *(u32x4*)dst = (u32x4){w[0], w[1], w[2], w[3]}; *(u32x4*)(dst + 8) = (u32x4){w[4], w[5], w[6], w[7]}; }
        }
    }
    if (type == 1) {
        __syncthreads();
        LAS float* red = (LAS float*)lds;
#pragma unroll
        for (int e = 0; e < 8; ++e) { red[r64 * 128 + c0 + e] = csa[e]; red[r64 * 128 + c1 + e] = csb[e]; }
        __syncthreads();
        if (tid < 128) { float s = 0.f; for (int r = 0; r < 64; ++r) s += red[r * 128 + tid];
            ((float*)(p.ws + WS_KM))[((size_t)(cb - 6) * 32 + rb) * 128 + tid] = s * (1.f / 256.f); }
    }
    __syncthreads();
}

__device__ __forceinline__ void sgu_item(const Params& p, int layer, int item) {
    const int tid = tid_opaque(), lane = tid & 63, wave = tid >> 6, r = lane & 31, h = lane >> 5;
    const int nc = item >> 2, g = item & 3;
    const int tb = wave >> 1;
    const float* W = p.sgu_w + ((size_t)layer * 4 + g) * 128 * 128;
    const bf16* vnt = (const bf16*)(p.ws + WS_VNT) + (size_t)(nc * 4 + g) * 128 * 128;
    const bf16* proj = (const bf16*)(p.ws + WS_PROJ);
    bf16* mix = (bf16*)(p.ws + WS_MIX);
    const int t = 32 * tb + r;
    f32x4 wl[8][2];
#pragma unroll
    for (int ks = 0; ks < 8; ++ks) { const int s0 = 16 * ks + 8 * h; wl[ks][0] = *(const f32x4*)(W + t * 128 + s0); wl[ks][1] = *(const f32x4*)(W + t * 128 + s0 + 4); }
    bf16x8 bfr[2][8];
#pragma unroll
    for (int cc = 0; cc < 2; ++cc)
#pragma unroll
        for (int ks = 0; ks < 8; ++ks) bfr[cc][ks] = *(const bf16x8*)(vnt + (size_t)(32 * ((wave & 1) * 2 + cc) + r) * 128 + 16 * ks + 8 * h);
    bf16x8 af[8];
#pragma unroll
    for (int ks = 0; ks < 8; ++ks) { const int s0 = 16 * ks + 8 * h;
        float wv[8] = {wl[ks][0].x, wl[ks][0].y, wl[ks][0].z, wl[ks][0].w, wl[ks][1].x, wl[ks][1].y, wl[ks][1].z, wl[ks][1].w};
#pragma unroll
        for (int e = 0; e < 8; ++e) wv[e] = (s0 + e <= t) ? wv[e] : 0.f;
        u32x4 au; au.x = pk2(wv[0], wv[1]); au.y = pk2(wv[2], wv[3]); au.z = pk2(wv[4], wv[5]); au.w = pk2(wv[6], wv[7]);
        af[ks] = __builtin_bit_cast(bf16x8, au); }
#pragma unroll
    for (int cc = 0; cc < 2; ++cc) {
        const int cbk = (wave & 1) * 2 + cc;
        const int c = 32 * cbk + r;
        unsigned short ur[16]; float br[16];
#pragma unroll
        for (int i = 0; i < 16; ++i) { const int tt = 32 * tb + crow(i, h); ur[i] = proj[((size_t)nc * 128 + tt) * INW + C_SU + g * 128 + c]; br[i] = p.sgu_b[((size_t)layer * 4 + g) * 128 + tt]; }
        f32x16 acc;
#pragma unroll
        for (int i = 0; i < 16; ++i) acc[i] = 0.f;
#pragma unroll
        for (int ks = 0; ks < 8; ++ks) acc = MFMA32(af[ks], bfr[cc][ks], acc);
#pragma unroll
        for (int i = 0; i < 16; ++i) {
            const int tt = 32 * tb + crow(i, h);
            const size_t tok = (size_t)nc * 128 + tt;
            const float u = gelu_t(__uint_as_float(((unsigned)ur[i]) << 16));
            const float o = u * (acc[i] + br[i]);
            mix[tok * DM + 1536 + g * 128 + c] = (bf16)(pk2(o, 0.f) & 0xffffu);
        }
    }
}

constexpr int KT_BYTES = 16384, VT_BYTES = 16384;
constexpr int ABUF = KT_BYTES + VT_BYTES;
constexpr float LOG2E = 1.4426950408889634f;

__device__ __forceinline__ void tile_dma(LAS unsigned char* slot, const bf16* proj, const bf16* vt, int kcol, int hh, int kbase, int wave, int lane) {
#pragma unroll
    for (int i = 0; i < 2; ++i) { const int c = i * 8 + wave, row = 4 * c + (lane >> 4), g = (lane & 15) ^ (row & 15);
        __builtin_amdgcn_global_load_lds((const unsigned*)(proj + (size_t)(kbase + row) * INW + kcol + g * 8), (LAS unsigned*)(slot + c * 1024), 16, 0, 0); }
#pragma unroll
    for (int i = 0; i < 2; ++i) { const int c = i * 8 + wave, row = 8 * c + (lane >> 3), g = (lane & 7) ^ ((row >> 1) & 7);
        __builtin_amdgcn_global_load_lds((const unsigned*)(vt + ((size_t)hh * 128 + row) * SEQ + kbase + g * 8), (LAS unsigned*)(slot + KT_BYTES + c * 1024), 16, 0, 0); }
}

#define TOP3_INSERT(v, n) do { if ((v) > v0 || ((v) == v0 && (n) < i0)) { v2 = v1; i2 = i1; v1 = v0; i1 = i0; v0 = (v); i0 = (n); } \
    else if ((v) > v1 || ((v) == v1 && (n) < i1)) { v2 = v1; i2 = i1; v1 = (v); i1 = (n); } \
    else if ((v) > v2 || ((v) == v2 && (n) < i2)) { v2 = (v); i2 = (n); } } while (0)
template <int MODE>
__device__ __forceinline__ void attn_unit(const Params& p, int layer, int h, int qb, LAS unsigned char* lds, float lam, float lam_init) {
    constexpr int NKS = MODE == 0 ? 8 : 4;
    const int tid = tid_opaque(), lane = tid & 63, wave = __builtin_amdgcn_readfirstlane(tid >> 6), r = lane & 31, hf = lane >> 5;
    const int grp = wave >> 2;
    const bf16* proj = (const bf16*)(p.ws + WS_PROJ);
    const bf16* vt = (const bf16*)(p.ws + WS_VT);
    bf16* mix = (bf16*)(p.ws + WS_MIX);
    int wrow0, ntiles, qcol, kcol, kc0, hh; float scale;
    if (MODE == 0) { wrow0 = qb * 256 + 32 * wave; ntiles = 4 * (qb + 1); qcol = C_MQ + h * 128; kcol = C_MK + h * 128; kc0 = 0; hh = h; scale = 0.08838834764831845f * LOG2E; }
    else { wrow0 = qb * 128 + 32 * (wave & 3); ntiles = 2 * (qb + 1); qcol = C_DQ + h * 128 + grp * 64; kcol = C_DK + h * 128; kc0 = grp * 64; hh = 6 + h; scale = 0.125f * LOG2E; }
    const int q = wrow0 + r;
    bf16x8 qf[NKS];
#pragma unroll
    for (int ks = 0; ks < NKS; ++ks) qf[ks] = *(const bf16x8*)(proj + (size_t)q * INW + qcol + 16 * ks + 8 * hf);
    unsigned selmask = 0xffffffffu;
    if (MODE == 0) {
        const int own = qb;
        selmask = 1u << own;
        if (own > 0) {
            f32x16 gt;
#pragma unroll
            for (int i = 0; i < 16; ++i) gt[i] = 0.f;
            const float* kmg = (const float*)(p.ws + WS_KM) + ((size_t)h * 32 + r) * 128 + 8 * hf;
#pragma unroll
            for (int ks = 0; ks < 8; ++ks) {
                const f32x4 a0 = *(const f32x4*)(kmg + 16 * ks), a1 = *(const f32x4*)(kmg + 16 * ks + 4);
                u32x4 hi; hi.x = pk2(a0.x, a0.y); hi.y = pk2(a0.z, a0.w); hi.z = pk2(a1.x, a1.y); hi.w = pk2(a1.z, a1.w);
                u32x4 lo; lo.x = pk2(a0.x - bf_lo(hi.x), a0.y - bf_hi(hi.x)); lo.y = pk2(a0.z - bf_lo(hi.y), a0.w - bf_hi(hi.y));
                lo.z = pk2(a1.x - bf_lo(hi.z), a1.y - bf_hi(hi.z)); lo.w = pk2(a1.z - bf_lo(hi.w), a1.w - bf_hi(hi.w));
                gt = MFMA32(__builtin_bit_cast(bf16x8, hi), qf[ks], gt);
                gt = MFMA32(__builtin_bit_cast(bf16x8, lo), qf[ks], gt);
            }
            float v0 = -INFINITY, v1 = -INFINITY, v2 = -INFINITY; int i0 = 64, i1 = 64, i2 = 64;
#pragma unroll
            for (int i = 0; i < 16; ++i) { const int n = crow(i, hf); if (n < own) TOP3_INSERT(gt[i], n); }
            const float pv0 = shx(v0, 32, lane), pv1 = shx(v1, 32, lane), pv2 = shx(v2, 32, lane);
            const int pi0 = shxi(i0, 32, lane), pi1 = shxi(i1, 32, lane), pi2 = shxi(i2, 32, lane);
            if (pi0 < 64) TOP3_INSERT(pv0, pi0);
            if (pi1 < 64) TOP3_INSERT(pv1, pi1);
            if (pi2 < 64) TOP3_INSERT(pv2, pi2);
            if (i0 < 64) selmask |= 1u << i0;
            if (i1 < 64) selmask |= 1u << i1;
            if (i2 < 64) selmask |= 1u << i2;
        }
    }
    f32x16 o[4];
#pragma unroll
    for (int d = 0; d < 4; ++d)
#pragma unroll
        for (int i = 0; i < 16; ++i) o[d][i] = 0.f;
    float m = -1e30f, l = 0.f;
    bf16x8 pf[4];
#pragma unroll
    for (int k = 0; k < 4; ++k) pf[k] = (bf16x8){0, 0, 0, 0, 0, 0, 0, 0};
    bool prev_on = false;
    tile_dma(lds, proj, vt, kcol, hh, 0, wave, lane);
    const unsigned ck = (unsigned)(r * 256 + 16 * ((r & 15) ^ hf));
    const unsigned cv = (unsigned)(KT_BYTES + r * 128 + 16 * (((r >> 1) & 7) ^ hf));
    asm volatile("s_waitcnt vmcnt(0)" ::: "memory");
    __syncthreads();
#define ATTN_BACK(vbuf) do { _Pragma("unroll") for (int k2 = 0; k2 < 2; ++k2) { bf16x8 vf_[2][4]; \
        _Pragma("unroll") for (int kk = 0; kk < 2; ++kk) { _Pragma("unroll") for (int d = 0; d < 4; ++d) { \
            const unsigned x_ = ((vbuf) + cv) ^ (unsigned)(32 * (2 * k2 + kk)); \
            vf_[kk][d] = *(const LAS bf16x8*)(lds + x_ + 4096 * d); } } \
        __builtin_amdgcn_sched_barrier(0); \
        _Pragma("unroll") for (int kk = 0; kk < 2; ++kk) { _Pragma("unroll") for (int d = 0; d < 4; ++d) o[d] = MFMA32(vf_[kk][d], pf[2 * k2 + kk], o[d]); } } } while (0)
    int slot = 0;
    for (int t = 0; t < ntiles; ++t) {
        const int kbase = t * 64;
        const unsigned buf = (unsigned)(slot * ABUF);
        const unsigned bufp = (unsigned)((slot == 0 ? 2 : slot - 1) * ABUF);
        const int nslot = slot == 2 ? 0 : slot + 1;
        if (t + 1 < ntiles) tile_dma(lds + nslot * ABUF, proj, vt, kcol, hh, kbase + 64, wave, lane);
        if (grp == 1 && prev_on) ATTN_BACK(bufp);
        bool lane_on = true;
        if (MODE == 0) lane_on = (selmask >> (t >> 2)) & 1u;
        const bool wave_on = (kbase <= wrow0 + 31) && (__builtin_amdgcn_ballot_w64(lane_on) != 0ull);
        if (wave_on) {
            f32x16 s[2];
#pragma unroll
            for (int b = 0; b < 2; ++b) {
#pragma unroll
                for (int i = 0; i < 16; ++i) s[b][i] = 0.f;
                bf16x8 kf[NKS];
#pragma unroll
                for (int ks = 0; ks < NKS; ++ks) kf[ks] = *(const LAS bf16x8*)(lds + ((buf + 8192u * b + ck) ^ (unsigned)(2 * kc0 + 32 * ks)));
                __builtin_amdgcn_sched_barrier(0);
#pragma unroll
                for (int ks = 0; ks < NKS; ++ks) s[b] = MFMA32(kf[ks], qf[ks], s[b]);
            }
            const bool diag = (kbase + 63 > wrow0);
            float mx = -INFINITY;
            bool lane_off = false;
            if (diag) {
                asm volatile("" ::: "memory");
#pragma unroll
                for (int b = 0; b < 2; ++b)
#pragma unroll
                    for (int i = 0; i < 16; ++i) {
                        const int key = kbase + 32 * b + crow(i, hf);
                        const bool ok = lane_on && (key <= q);
                        s[b][i] = ok ? s[b][i] : -INFINITY;
                        mx = fmaxf(mx, s[b][i]);
                    }
            } else {
#pragma unroll
                for (int b = 0; b < 2; ++b)
#pragma unroll
                    for (int i = 0; i < 16; ++i) mx = fmaxf(mx, s[b][i]);
                if (MODE == 0) { lane_off = !lane_on; mx = lane_on ? mx : -INFINITY; }
            }
            mx = fmaxf(mx, shx32(mx, lane));
            const float mn = fmaxf(m, mx);
            const float alpha = __builtin_amdgcn_exp2f((m - mn) * scale);
            const float mns = lane_off ? INFINITY : mn * scale;
            float ls = 0.f;
#pragma unroll
            for (int b = 0; b < 2; ++b)
#pragma unroll
                for (int i = 0; i < 16; ++i) { const float pv = __builtin_amdgcn_exp2f(s[b][i] * scale - mns); s[b][i] = pv; ls += pv; }
            l = l * alpha + ls;
            if (__builtin_amdgcn_ballot_w64(mn != m) != 0ull) {
#pragma unroll
                for (int d = 0; d < 4; ++d)
#pragma unroll
                    for (int i = 0; i < 16; ++i) o[d][i] *= alpha;
            }
            m = mn;
#pragma unroll
            for (int b = 0; b < 2; ++b)
#pragma unroll
                for (int ss = 0; ss < 2; ++ss) {
                    u32x4 pu;
                    pu.x = pk2(s[b][8 * ss + 0], s[b][8 * ss + 1]); pu.y = pk2(s[b][8 * ss + 2], s[b][8 * ss + 3]);
                    pu.z = pk2(s[b][8 * ss + 4], s[b][8 * ss + 5]); pu.w = pk2(s[b][8 * ss + 6], s[b][8 * ss + 7]);
                    pf[2 * b + ss] = __builtin_bit_cast(bf16x8, pu);
                }
            if (grp == 0) ATTN_BACK(buf);
        }
        prev_on = wave_on;
        slot = nslot;
        asm volatile("s_waitcnt vmcnt(0)" ::: "memory");
        __syncthreads();
    }
    if (grp == 1 && prev_on) { const unsigned bufp = (unsigned)((slot == 0 ? 2 : slot - 1) * ABUF); ATTN_BACK(bufp); }
#undef ATTN_BACK
    const float lt = l + shx(l, 32, lane);
    const float inv = 1.f / lt;
    if (MODE == 0) {
#pragma unroll
        for (int d = 0; d < 4; ++d)
#pragma unroll
            for (int g4 = 0; g4 < 4; ++g4) {
                u32x2 w; w.x = pk2(o[d][4 * g4] * inv, o[d][4 * g4 + 1] * inv); w.y = pk2(o[d][4 * g4 + 2] * inv, o[d][4 * g4 + 3] * inv);
                *(u32x2*)(mix + (size_t)q * DM + h * 128 + 32 * d + 8 * g4 + 4 * hf) = w;
            }
    } else {
        __syncthreads();
        LAS float* ex = (LAS float*)lds;
        const int wi = wave & 3;
        if (wave >= 4) {
#pragma unroll
            for (int d = 0; d < 4; ++d)
#pragma unroll
                for (int i = 0; i < 16; ++i) ex[(wi * 64 + d * 16 + i) * 64 + lane] = o[d][i] * inv;
        }
        __syncthreads();
        if (wave < 4) {
            int ly = layer; asm volatile("" : "+s"(ly));
            float c08 = 0.8f, c06 = 0.6f; asm volatile("" : "+s"(c08), "+s"(c06));
            const float lin = c08 - c06 * __expf(-0.3f * (float)ly);
            const float* lp = p.diff_lambda + (size_t)ly * 256;
            const float la = wave_sum(lp[lane] * lp[64 + lane], lane), lb = wave_sum(lp[128 + lane] * lp[192 + lane], lane);
            const float lamv = __expf(la) - __expf(lb) + lin, oml = 1.f - lin;
            float ss = 0.f;
#pragma unroll
            for (int d = 0; d < 4; ++d) {
#pragma unroll
                for (int i = 0; i < 16; ++i) { const float v = o[d][i] * inv - lamv * ex[(wi * 64 + d * 16 + i) * 64 + lane]; o[d][i] = v; ss += v * v; }
                __builtin_amdgcn_sched_barrier(0);
            }
            ss += shx(ss, 32, lane);
            const float rs = rsqrtf(ss * (1.f / 128.f) + EPS) * oml;
            const float* sg = p.subln_g + (size_t)layer * 128;
#pragma unroll
            for (int d = 0; d < 4; ++d)
#pragma unroll
                for (int g4 = 0; g4 < 4; ++g4) {
                    const int dv = 32 * d + 8 * g4 + 4 * hf;
                    const f32x4 gg = *(const f32x4*)(sg + dv);
                    u32x2 w; w.x = pk2(o[d][4 * g4] * rs * gg.x, o[d][4 * g4 + 1] * rs * gg.y); w.y = pk2(o[d][4 * g4 + 2] * rs * gg.z, o[d][4 * g4 + 3] * rs * gg.w);
                    *(u32x2*)(mix + (size_t)q * DM + 768 + h * 128 + dv) = w;
                }
        }
        __syncthreads();
    }
}

__device__ __forceinline__ void phase_attn(const Params& p, int layer, LAS unsigned char* lds) {
    const int tid = tid_opaque();
    volatile LAS int* misc = (volatile LAS int*)(lds + LDS_MISC);
    const float lam = 0.f, lam_init = 0.f;
    unsigned* ctr = (unsigned*)(p.ws + WS_CTL) + layer;
    const int* order = (const int*)(p.ws + WS_ORDER);
    for (;;) {
        if (tid == 0) misc[0] = (int)atomicAdd(ctr, 1u);
        __syncthreads();
        const int idx = misc[0];
        __syncthreads();
        if (idx >= NU_ALL) break;
        const int u = order[idx];
        if (u < 192) attn_unit<0>(p, layer, u >> 5, u & 31, lds, lam, lam_init);
        else if (u < NU_ATT) { const int v = u - 192; attn_unit<1>(p, layer, v >> 6, v & 63, lds, lam, lam_init); }
        else sgu_item(p, layer, u - NU_ATT);
    }
}

#define XB_TMO      128
#define XB_XCNT(j)  (256  + 64 * (j))
#define XB_XSUB(j)  (1280 + 64 * (j))
#define XB_XGEN(j)  (2304 + 64 * (j))
#define XB_TOP      3328
#define XB_TOPGEN   3392
#define XCD_BAR_WORDS 3456
#define XB_SPIN_CAP (1u << 18)

__device__ __forceinline__ unsigned xb_ld(unsigned* p)              { return __hip_atomic_load(p, __ATOMIC_RELAXED, __HIP_MEMORY_SCOPE_AGENT); }
__device__ __forceinline__ unsigned xb_add(unsigned* p, unsigned v) { return __hip_atomic_fetch_add(p, v, __ATOMIC_RELAXED, __HIP_MEMORY_SCOPE_AGENT); }
__device__ __forceinline__ unsigned xb_xcc_id() { return (unsigned)__builtin_amdgcn_s_getreg((3 << 11) | 20) & 0xFu; }
#define XB_SPIN(cond, bar) do { unsigned _sp = 0; while (cond) { __builtin_amdgcn_s_sleep(1); \
    if ((++_sp & 255u) == 0u) { if (xb_ld(&(bar)[XB_TMO])) break; if (_sp > XB_SPIN_CAP) { atomicAdd(&(bar)[XB_TMO], 1u); break; } } } } while (0)

struct XcdBarrier {
    unsigned* bar; unsigned x;
    volatile LAS unsigned* st;
};

__device__ __forceinline__ XcdBarrier xcd_barrier_post(unsigned* bar, volatile LAS unsigned* st) {
    XcdBarrier b; b.bar = bar; b.x = xb_xcc_id(); b.st = st;
    if (threadIdx.x == 0) (void)xb_add(&bar[XB_XCNT(b.x)], 1u);
    return b;
}
__device__ __forceinline__ void xcd_barrier_complete(unsigned* bar, unsigned x, unsigned& nloc, unsigned& nx) {
    const unsigned G = gridDim.x * gridDim.y * gridDim.z;
    unsigned sum, cnt, mine, sp = 0u;
    for (;;) {
        sum = 0u; cnt = 0u; mine = 0u;
#pragma unroll
        for (unsigned j = 0; j < 16; ++j) { const unsigned c = xb_ld(&bar[XB_XCNT(j)]); sum += c; cnt += (c > 0u) ? 1u : 0u; mine = (j == x) ? c : mine; }
        if (sum == G) break;
        __builtin_amdgcn_s_sleep(1);
        if ((++sp & 255u) == 0u) { if (xb_ld(&bar[XB_TMO])) break; if (sp > XB_SPIN_CAP) { atomicAdd(&bar[XB_TMO], 1u); break; } }
    }
    nloc = mine > 0u ? mine : 1u; nx = cnt > 0u ? cnt : 1u;
}

__device__ __forceinline__ void xcd_barrier(const XcdBarrier& b) {
    asm volatile("s_waitcnt vmcnt(0)" ::: "memory");
    __syncthreads();
    if (threadIdx.x == 0) {
        unsigned* bar = b.bar;
        __builtin_amdgcn_s_waitcnt(0);
        unsigned nloc = b.st[0], nx = b.st[1];
        if (nloc == 0u) { xcd_barrier_complete(bar, b.x, nloc, nx); b.st[0] = nloc; b.st[1] = nx; }
        const unsigned old = xb_add(&bar[XB_XSUB(b.x)], 1u);
        const unsigned gen = old / nloc;
        if (old + 1u == (gen + 1u) * nloc) {
            __builtin_amdgcn_fence(__ATOMIC_RELEASE, "agent");
            asm volatile("s_waitcnt vmcnt(0)" ::: "memory");
            const unsigned og = xb_add(&bar[XB_TOP], 1u);
            const unsigned tg = og / nx;
            if (og + 1u == (tg + 1u) * nx) xb_add(&bar[XB_TOPGEN], 1u);
            else XB_SPIN(xb_ld(&bar[XB_TOPGEN]) == tg, bar);
            __builtin_amdgcn_fence(__ATOMIC_ACQUIRE, "agent");
            xb_add(&bar[XB_XGEN(b.x)], 1u);
            asm volatile("s_waitcnt vmcnt(0)" ::: "memory");
        } else {
            XB_SPIN(xb_ld(&bar[XB_XGEN(b.x)]) == gen, bar);
            __builtin_amdgcn_fence(__ATOMIC_ACQUIRE, "agent");
            asm volatile("s_waitcnt vmcnt(0)" ::: "memory");
        }
    }
    __syncthreads();
}


__global__ void __launch_bounds__(NTHR, 2) trunk_fwd(Params p) {
    extern __shared__ __attribute__((aligned(16))) unsigned char lds_raw[];
    LAS unsigned char* lds = (LAS unsigned char*)lds_raw;
    cg::grid_group grid = cg::this_grid();
    const int G = gridDim.x, bid = blockIdx.x;
    unsigned char* ws = p.ws;
    bf16* H = (bf16*)(ws + WS_H); bf16* PROJ = (bf16*)(ws + WS_PROJ); bf16* MIX = (bf16*)(ws + WS_MIX); bf16* HID = (bf16*)(ws + WS_HID);

    volatile LAS unsigned* xst = (volatile LAS unsigned*)(lds + LDS_MISC + 64);
    if (threadIdx.x < 4) xst[threadIdx.x] = 0u;
    if (bid == 0) { unsigned* bw = (unsigned*)(ws + WS_BAR); for (int i = threadIdx.x; i < XCD_BAR_WORDS; i += NTHR) bw[i] = 0u; }
    phase_weights(p, lds);
    float* SS = (float*)(ws + WS_SS);
    phase_x0(p.x, H, SS);
    grid.sync();
    const XcdBarrier xb = xcd_barrier_post((unsigned*)(ws + WS_BAR), xst);
#define GRID_BAR() xcd_barrier(xb)
    for (int layer = 0; layer < DEPTH; ++layer) {
        {
            pg8::Gemm g{H, (const bf16*)(ws + WS_WIN) + (size_t)layer * INW * DM, SEQ, INW, DM}; pg8::StaticOrder S; S.init(SEQ, INW, G, bid);
            pg8::EpiBf16<0> E{PROJ, INW, SS + (size_t)(2 * layer) * SEQ * 32, 1.f / DM, (const LAS float*)(lds + 131072)};
            pg8::gemm_phase(lds, g, S, E);
            pg8::Unit u3;
            if (layer + 1 < DEPTH && !S.next(2, u3)) fill_convert(p, layer + 1, lds, (unsigned*)(ws + WS_CTL) + 8 + layer);
        }
        GRID_BAR();
        for (int u = bid; u < 32 * 40; u += G) post_unit(p, layer, u, lds);
        GRID_BAR();
        phase_attn(p, layer, lds);
        GRID_BAR();
        {
            pg8::Gemm g{MIX, (const bf16*)(ws + WS_WOUT) + (size_t)layer * DM * DM, SEQ, DM, DM}; pg8::StaticOrder S; S.init(SEQ, DM, G, bid);
            pg8::EpiResid E{H, SS + (size_t)(2 * layer + 1) * SEQ * 32, DM};
            pg8::gemm_phase(lds, g, S, E);
        }
        GRID_BAR();
        {
            pg8::Gemm g{H, (const bf16*)(ws + WS_W1) + (size_t)layer * DFF * DM, SEQ, DFF, DM}; pg8::StaticOrder S; S.init(SEQ, DFF, G, bid);
            pg8::EpiBf16<1> E{HID, DFF, SS + (size_t)(2 * layer + 1) * SEQ * 32, 1.f / DM, (const LAS float*)(lds + 131072)};
            pg8::gemm_phase(lds, g, S, E);
        }
        GRID_BAR();
        {
            pg8::Gemm g{HID, (const bf16*)(ws + WS_W2) + (size_t)layer * DM * DFF, SEQ, DM, DFF}; pg8::StaticOrder S; S.init(SEQ, DM, G, bid);
            pg8::EpiResid E{H, SS + (size_t)(2 * layer + 2) * SEQ * 32, DM};
            pg8::gemm_phase(lds, g, S, E);
        }
        GRID_BAR();
    }
    phase_norm_f32(H, p.final_g, SS + (size_t)8 * SEQ * 32, p.out);
}

extern "C" void kernel_launch(void* const* d_in, const int* in_sizes, int n_in, void* d_out, int out_size, void* d_ws, size_t ws_size, hipStream_t stream) {
    static int grid_blocks = 0;
    if (grid_blocks == 0) {
        if (n_in != 14 || ws_size < WS_END) { fprintf(stderr, "kernel_launch: unexpected inputs (n_in %d, ws %zu, need %zu)\n", n_in, ws_size, (size_t)WS_END); grid_blocks = -1; return; }
        int dev = 0, cus = 0, per_cu = 0;
        hipGetDevice(&dev);
        hipDeviceGetAttribute(&cus, hipDeviceAttributeMultiprocessorCount, dev);
        hipFuncSetAttribute((const void*)trunk_fwd, hipFuncAttributeMaxDynamicSharedMemorySize, LDS_BYTES);
        hipOccupancyMaxActiveBlocksPerMultiprocessor(&per_cu, (const void*)trunk_fwd, NTHR, LDS_BYTES);
        if (per_cu < 1) per_cu = 1;
        grid_blocks = cus * per_cu;
        (void)hipGetLastError();
    }
    if (grid_blocks < 0) return;
    Params p{};
    p.x = (const float*)d_in[0]; p.attn_g = (const float*)d_in[1]; p.w_in = (const float*)d_in[2]; p.diff_lambda = (const float*)d_in[3]; p.subln_g = (const float*)d_in[4];
    p.sgu_ln_g = (const float*)d_in[5]; p.sgu_ln_b = (const float*)d_in[6]; p.sgu_w = (const float*)d_in[7]; p.sgu_b = (const float*)d_in[8]; p.w_out = (const float*)d_in[9];
    p.mlp_g = (const float*)d_in[10]; p.w1 = (const float*)d_in[11]; p.w2 = (const float*)d_in[12]; p.final_g = (const float*)d_in[13];
    p.out = (float*)d_out; p.ws = (unsigned char*)d_ws;
    void* args[] = {&p};
    hipError_t e = hipLaunchCooperativeKernel((const void*)trunk_fwd, dim3(grid_blocks), dim3(NTHR), args, LDS_BYTES, stream);
    if (e != hipSuccess) fprintf(stderr, "cooperative launch failed: %s (grid %d)\n", hipGetErrorString(e), grid_blocks);
}
```

```cpp
#include <hip/hip_runtime.h>
#include <hip/hip_cooperative_groups.h>
#include <cstdio>
#include <cstdint>
namespace cg = cooperative_groups;

namespace pg8 {
#define PG8_LAS __attribute__((address_space(3)))
typedef unsigned short bf16_t;
typedef short bf16x8 __attribute__((ext_vector_type(8)));
typedef float f32x4 __attribute__((ext_vector_type(4)));
typedef unsigned u32x4 __attribute__((ext_vector_type(4)));
typedef unsigned u32x2 __attribute__((ext_vector_type(2)));
constexpr int BM = 256, BK = 64, HALF = 128, HTB = HALF * BK * 2  , STAGE_BYTES = 8 * HTB, NXCD = 8, WGM = 8;

__host__ __device__ __forceinline__ int lds_byte(int r, int c) { const int st = (r >> 4) * 2 + (c >> 5), rr = r & 15, cc = c & 31, ob = rr * 64 + cc * 2; return st * 1024 + (ob ^ (((ob >> 9) & 1) << 5)); }
__host__ __device__ __forceinline__ void stage_rc(int b, int& R, int& C) { const int st = b / 1024, sb = b % 1024, swz = sb ^ (((sb >> 9) & 1) << 5); R = (st >> 1) * 16 + swz / 64; C = (st & 1) * 32 + (swz % 64) / 2; }
__host__ __device__ __forceinline__ int perm32(int rho) { const int n = rho >> 4, i = rho & 15; return 8 * (i >> 2) + 4 * n + (i & 3); }

struct Unit { int pm, pn, ui; };
struct Gemm { const bf16_t* A; const bf16_t* Bt; int M, N, K; };

struct StaticOrder {
    int nM, nN, nwg, G, c;
    __host__ __device__ void init(int M, int N, int G_, int c_) { nM = M / BM; nN = N / BM; nwg = nM * nN; G = G_; c = c_; }
    __host__ __device__ bool next(int i, Unit& u) const {
        const long L = (long)i * G + c; if (L >= nwg) return false;
        int wgid = (int)L; { const int q = nwg / NXCD, r = nwg % NXCD, xcd = wgid % NXCD, off = wgid / NXCD; wgid = (xcd < r ? xcd * (q + 1) : r * (q + 1) + (xcd - r) * q) + off; }
        const int nig = WGM * nN, gid = wgid / nig, fm = gid * WGM, gsz = (nM - fm) < WGM ? (nM - fm) : WGM;
        u.pm = fm + ((wgid % nig) % gsz); u.pn = (wgid % nig) / gsz; u.ui = i; return true;
    }
    __device__ __forceinline__ void a_ready(const Unit&) const {}
    __device__ __forceinline__ void done(const Unit&) const {}
};

typedef float f32x2 __attribute__((ext_vector_type(2)));
typedef __bf16 bf16x2_t __attribute__((ext_vector_type(2)));
__device__ __forceinline__ float shx(float v, int k, int lane) { return __int_as_float(__builtin_amdgcn_ds_bpermute((lane ^ k) << 2, __float_as_int(v))); }
__device__ __forceinline__ unsigned cvt_pk_bf16(float lo, float hi) { f32x2 v = {lo, hi}; bf16x2_t b = __builtin_convertvector(v, bf16x2_t); return __builtin_bit_cast(unsigned, b); }

struct EpiResid {
    static constexpr bool PERM = true, NEEDS_PREP = false;
    bf16_t* XB; float* SS; int ldc;
    __device__ __forceinline__ void operator()(const f32x4 (&acc)[2][2][4][2], const Unit& u, int wr, int wc, int fr, int fq) const {
        const int row0 = u.pm * BM + wr * 64 + fr, col0 = u.pn * BM + wc * 32 + 8 * fq;
        u32x4 xin[2][4][2];
#pragma unroll
        for (int ai = 0; ai < 2; ++ai)
#pragma unroll
            for (int m = 0; m < 4; ++m)
#pragma unroll
                for (int bj = 0; bj < 2; ++bj) xin[ai][m][bj] = *(const u32x4*)(XB + (size_t)(row0 + ai * HALF + m * 16) * ldc + col0 + bj * HALF);
#pragma unroll
        for (int ai = 0; ai < 2; ++ai)
#pragma unroll
            for (int m = 0; m < 4; ++m) { const int row = row0 + ai * HALF + m * 16; const size_t off = (size_t)row * ldc + col0; float part = 0.f;
#pragma unroll
                for (int bj = 0; bj < 2; ++bj) { const u32x4 xi = xin[ai][m][bj]; const f32x4 a0 = acc[ai][bj][m][0], a1 = acc[ai][bj][m][1];
                    u32x4 w;
                    w.x = cvt_pk_bf16(a0[0] + __uint_as_float(xi.x << 16), a0[1] + __uint_as_float(xi.x & 0xffff0000u));
                    w.y = cvt_pk_bf16(a0[2] + __uint_as_float(xi.y << 16), a0[3] + __uint_as_float(xi.y & 0xffff0000u));
                    w.z = cvt_pk_bf16(a1[0] + __uint_as_float(xi.z << 16), a1[1] + __uint_as_float(xi.z & 0xffff0000u));
                    w.w = cvt_pk_bf16(a1[2] + __uint_as_float(xi.w << 16), a1[3] + __uint_as_float(xi.w & 0xffff0000u));
                    *(u32x4*)(XB + off + bj * HALF) = w;
#pragma unroll
                    for (int e = 0; e < 4; ++e) { const float lo = __uint_as_float(w[e] << 16), hi = __uint_as_float(w[e] & 0xffff0000u); part += lo * lo + hi * hi; } }
                part += shx(part, 16, fq * 16 + fr); part += shx(part, 32, fq * 16 + fr);
                if (fq == 0) SS[(size_t)row * 32 + u.pn * 4 + wc] = part; }
    }
};
template <int ACT> struct EpiBf16 {
    static constexpr bool PERM = true;
    static constexpr bool NEEDS_PREP = true;
    bf16_t* O; int ldc; const float* SS; float inv_k; const PG8_LAS float* rstab;
    template <class Sched> __device__ __forceinline__ void prep(const Sched& S, int tid) const {
        PG8_LAS float* tab = (PG8_LAS float*)rstab;
#pragma unroll
        for (int k = 0; k < 2; ++k) { const int ui = (tid >> 8) + 2 * k; Unit u;
            if (S.next(ui, u)) { const f32x4* sp = (const f32x4*)(SS + (size_t)(u.pm * BM + (tid & 255)) * 32); float tot = 0.f;
#pragma unroll
                for (int j = 0; j < 8; ++j) { const f32x4 a = sp[j]; tot += (a[0] + a[1]) + (a[2] + a[3]); }
                tab[ui * 256 + (tid & 255)] = rsqrtf(tot * inv_k + 1e-6f); } }
    }
    __device__ __forceinline__ void operator()(const f32x4 (&acc)[2][2][4][2], const Unit& u, int wr, int wc, int fr, int fq) const {
        const int row0 = u.pm * BM + wr * 64 + fr; const int col0 = u.pn * BM + wc * 32 + 8 * fq;
        float rsv[2][4];
#pragma unroll
        for (int ai = 0; ai < 2; ++ai)
#pragma unroll
            for (int m = 0; m < 4; ++m) rsv[ai][m] = rstab[(u.ui & 3) * 256 + wr * 64 + fr + ai * HALF + m * 16];
#pragma unroll
        for (int ai = 0; ai < 2; ++ai)
#pragma unroll
            for (int m = 0; m < 4; ++m) { const int row = row0 + ai * HALF + m * 16; bf16_t* rowp = O + (size_t)row * ldc + col0;
                const float rs = rsv[ai][m];
#pragma unroll
                for (int bj = 0; bj < 2; ++bj) { f32x4 v0 = acc[ai][bj][m][0] * rs, v1 = acc[ai][bj][m][1] * rs;
                    if (ACT == 1) {
#pragma unroll
                        for (int j = 0; j < 4; ++j) { const float a = fmaxf(v0[j], 0.f), b = fmaxf(v1[j], 0.f); v0[j] = a * a; v1[j] = b * b; } }
                    u32x4 w; w.x = cvt_pk_bf16(v0[0], v0[1]); w.y = cvt_pk_bf16(v0[2], v0[3]); w.z = cvt_pk_bf16(v1[0], v1[1]); w.w = cvt_pk_bf16(v1[2], v1[3]);
                    *(u32x4*)(rowp + bj * HALF) = w; } }
    }
};

template <class Epi, class Sched>
__device__ __forceinline__ void gemm_phase(PG8_LAS unsigned char* lds, const Gemm g, const Sched& S, const Epi& E) {
    int tid_ = threadIdx.x; asm volatile("" : "+v"(tid_));
    const int tid = tid_, wid = __builtin_amdgcn_readfirstlane(tid >> 6), lane = tid & 63, wr = wid >> 2, wc = wid & 3, fr = lane & 15, fq = lane >> 4;
    const int K = g.K, nt = K / BK;
    unsigned voffA[2], voffB[2];
#pragma unroll
    for (int i = 0; i < 2; ++i) { int R, C; stage_rc(tid * 16 + i * 8192, R, C); const int Rb = Epi::PERM ? ((R & ~31) + perm32(R & 31)) : R;
        voffA[i] = (unsigned)(R * K + C) * 2u; voffB[i] = (unsigned)(Rb * K + C) * 2u; }
    const size_t kstep = (size_t)(BK * 2);
    const size_t hstep = (size_t)HALF * K * 2;
    const size_t tstep = 2 * hstep;
    const unsigned ldsw = (unsigned)wid * 1024u;
    const int aoff = lds_byte(wr * 64 + fr, fq * 8), boff = lds_byte(wc * 32 + fr, fq * 8);
#define PG8_SA(b, h) (((b) * 2 + (h)) * HTB)
#define PG8_SB(b, h) ((4 + (b) * 2 + (h)) * HTB)
#define PG8_STAGE(bufoff, gbase, voff) do { _Pragma("unroll") for (int _i = 0; _i < 2; ++_i) \
        __builtin_amdgcn_global_load_lds((const unsigned*)((const char*)(gbase) + (voff)[_i]), (PG8_LAS unsigned*)(lds + (bufoff) + ldsw + _i * 8192), 16, 0, 0); } while (0)
#define PG8_LDA(dst, b, h) do { _Pragma("unroll") for (int m = 0; m < 4; ++m) _Pragma("unroll") for (int k = 0; k < 2; ++k) dst[m][k] = *(const PG8_LAS bf16x8*)(lds + PG8_SA(b, h) + aoff + m * 2048 + k * 1024); } while (0)
#define PG8_LDB(dst, b, h) do { _Pragma("unroll") for (int n = 0; n < 2; ++n) _Pragma("unroll") for (int k = 0; k < 2; ++k) dst[n][k] = *(const PG8_LAS bf16x8*)(lds + PG8_SB(b, h) + boff + n * 2048 + k * 1024); } while (0)
#define PG8_MMA(ai, bj, At, Bt) do { __builtin_amdgcn_s_setprio(1); _Pragma("unroll") for (int m = 0; m < 4; ++m) _Pragma("unroll") for (int n = 0; n < 2; ++n) _Pragma("unroll") for (int k = 0; k < 2; ++k) \
        acc[ai][bj][m][n] = __builtin_amdgcn_mfma_f32_16x16x32_bf16(Bt[n][k], At[m][k], acc[ai][bj][m][n], 0, 0, 0); __builtin_amdgcn_s_setprio(0); } while (0)
#define PG8_WAIT_V(n) asm volatile("s_waitcnt vmcnt(" #n ")" ::: "memory")
#define PG8_WAIT_L(n) asm volatile("s_waitcnt lgkmcnt(" #n ")" ::: "memory")
#define PG8_BAR __builtin_amdgcn_s_barrier()
#define PG8_SCHED __builtin_amdgcn_sched_barrier(0)
    Unit cur, nxt; int ui = 0;
    if (!S.next(0, cur)) return;
    f32x4 acc[2][2][4][2];
#pragma unroll
    for (int a = 0; a < 2; ++a)
#pragma unroll
        for (int b = 0; b < 2; ++b)
#pragma unroll
            for (int m = 0; m < 4; ++m)
#pragma unroll
                for (int n = 0; n < 2; ++n) acc[a][b][m][n] = (f32x4){0.f, 0.f, 0.f, 0.f};
    bf16x8 At[4][2], B0[2][2], B1[2][2];
    const char* cA = (const char*)g.A + (size_t)cur.pm * tstep; const char* cB = (const char*)g.Bt + (size_t)cur.pn * tstep;
    if constexpr (Epi::NEEDS_PREP) { E.prep(S, tid); asm volatile("s_waitcnt lgkmcnt(0)" ::: "memory"); __builtin_amdgcn_s_barrier(); }
    S.a_ready(cur);
    PG8_STAGE(PG8_SB(0, 0), cB, voffB); PG8_STAGE(PG8_SA(0, 0), cA, voffA); PG8_STAGE(PG8_SB(0, 1), cB + hstep, voffB); PG8_STAGE(PG8_SA(0, 1), cA + hstep, voffA);
    if (wr == 1) PG8_BAR;
    PG8_WAIT_V(4); PG8_BAR;
    PG8_STAGE(PG8_SB(1, 0), cB + kstep, voffB); PG8_STAGE(PG8_SA(1, 0), cA + kstep, voffA); PG8_STAGE(PG8_SB(1, 1), cB + hstep + kstep, voffB);
    PG8_WAIT_V(6); PG8_BAR;
    for (;;) {
        const bool has_next = S.next(ui + 1, nxt);
        const char* nA = has_next ? (const char*)g.A + (size_t)nxt.pm * tstep : cA; const char* nB = has_next ? (const char*)g.Bt + (size_t)nxt.pn * tstep : cB;
        for (int t = 0; t < nt; t += 2) {
            const bool last = (t == nt - 2);
            const char* a1 = cA + (size_t)(t + 1) * kstep;
            const char* a2 = last ? nA : cA + (size_t)(t + 2) * kstep; const char* b2 = last ? nB : cB + (size_t)(t + 2) * kstep;
            const char* a3 = a2 + kstep; const char* b3 = b2 + kstep;
            if (last && has_next) S.a_ready(nxt);
            PG8_LDB(B0, 0, 0); PG8_SCHED; PG8_LDA(At, 0, 0); PG8_STAGE(PG8_SA(1, 1), a1 + hstep, voffA);
            PG8_WAIT_L(8); PG8_BAR; PG8_WAIT_L(0); PG8_MMA(0, 0, At, B0); PG8_BAR; PG8_SCHED;
            PG8_LDB(B1, 0, 1); PG8_STAGE(PG8_SB(0, 0), b2, voffB);
            PG8_BAR; PG8_WAIT_L(0); PG8_MMA(0, 1, At, B1); PG8_BAR;
            PG8_LDA(At, 0, 1); PG8_STAGE(PG8_SA(0, 0), a2, voffA);
            PG8_BAR; PG8_WAIT_L(0); PG8_MMA(1, 0, At, B0); PG8_BAR; PG8_SCHED;
            PG8_STAGE(PG8_SB(0, 1), b2 + hstep, voffB);
            PG8_WAIT_V(6); PG8_BAR; PG8_MMA(1, 1, At, B1); PG8_BAR;
            PG8_LDB(B0, 1, 0); PG8_SCHED; PG8_LDA(At, 1, 0); PG8_STAGE(PG8_SA(0, 1), a2 + hstep, voffA);
            PG8_WAIT_L(8); PG8_BAR; PG8_WAIT_L(0); PG8_MMA(0, 0, At, B0); PG8_BAR; PG8_SCHED;
            PG8_LDB(B1, 1, 1); PG8_STAGE(PG8_SB(1, 0), b3, voffB);
            PG8_BAR; PG8_WAIT_L(0); PG8_MMA(0, 1, At, B1); PG8_BAR;
            PG8_LDA(At, 1, 1); PG8_STAGE(PG8_SA(1, 0), a3, voffA);
            PG8_BAR; PG8_WAIT_L(0); PG8_MMA(1, 0, At, B0); PG8_BAR; PG8_SCHED;
            PG8_STAGE(PG8_SB(1, 1), b3 + hstep, voffB);
            PG8_WAIT_V(6); PG8_BAR; PG8_MMA(1, 1, At, B1); PG8_BAR;
        }
        E(acc, cur, wr, wc, fr, fq); S.done(cur);
        if (!has_next) break;
#pragma unroll
        for (int a = 0; a < 2; ++a)
#pragma unroll
            for (int b = 0; b < 2; ++b)
#pragma unroll
                for (int m = 0; m < 4; ++m)
#pragma unroll
                    for (int n = 0; n < 2; ++n) acc[a][b][m][n] = (f32x4){0.f, 0.f, 0.f, 0.f};
        cur = nxt; cA = nA; cB = nB; ++ui;
    }
    PG8_WAIT_V(0);
    if (wr == 0) PG8_BAR;
    PG8_BAR;
#undef PG8_SA
#undef PG8_SB
#undef PG8_STAGE
#undef PG8_LDA
#undef PG8_LDB
#undef PG8_MMA
#undef PG8_WAIT_V
#undef PG8_WAIT_L
#undef PG8_BAR
#undef PG8_SCHED
}
}

constexpr int SEQ = 8192, DM = 2048, DEPTH = 4, INW = 5632, DFF = 8192;
constexpr int C_MQ = 0, C_MK = 768, C_MV = 1536, C_DQ = 2304, C_DK = 3072, C_DV = 3840, C_SU = 4608, C_SV = 5120;
constexpr int NWAVES = 8, NTHR = 512;
constexpr int LDS_BYTES = 147456;
constexpr int LDS_MISC = 139264;
constexpr float EPS = 1e-6f;

constexpr size_t WS_CTL = 0;
constexpr size_t WS_BAR = 16384;
constexpr size_t WS_ORDER = 4096;
constexpr size_t WS_WIN = 65536;
constexpr size_t WS_WOUT = WS_WIN + (size_t)DEPTH * INW * DM * 2;
constexpr size_t WS_W1 = WS_WOUT + (size_t)DEPTH * DM * DM * 2;
constexpr size_t WS_W2 = WS_W1 + (size_t)DEPTH * DFF * DM * 2;
constexpr size_t WS_XRES = WS_W2 + (size_t)DEPTH * DM * DFF * 2;
constexpr size_t WS_H = WS_XRES + (size_t)SEQ * DM * 4;
constexpr size_t WS_PROJ = WS_H + (size_t)SEQ * DM * 2;
constexpr size_t WS_VT = WS_PROJ + (size_t)SEQ * INW * 2;
constexpr size_t WS_VNT = WS_VT + (size_t)12 * 128 * SEQ * 2;
constexpr size_t WS_KM = WS_VNT + (size_t)SEQ * 512 * 2;
constexpr size_t WS_SEL = WS_KM + (size_t)6 * 32 * 128 * 4;
constexpr size_t WS_MIX = WS_SEL + (size_t)6 * SEQ * 4;
constexpr size_t WS_HID = WS_MIX + (size_t)SEQ * DM * 2;
constexpr size_t WS_SS = WS_HID + (size_t)SEQ * DFF * 2;
constexpr size_t WS_END = WS_SS + (size_t)9 * SEQ * 32 * 4;

#define LAS __attribute__((address_space(3)))
typedef unsigned short bf16;
typedef short bf16x8 __attribute__((ext_vector_type(8)));
typedef short s16x4 __attribute__((ext_vector_type(4)));
typedef float f32x4 __attribute__((ext_vector_type(4)));
typedef float f32x16 __attribute__((ext_vector_type(16)));
typedef unsigned u32x4 __attribute__((ext_vector_type(4)));
typedef unsigned u32x2 __attribute__((ext_vector_type(2)));
#define MFMA32(a, b, c) __builtin_amdgcn_mfma_f32_32x32x16_bf16((a), (b), (c), 0, 0, 0)

__device__ __forceinline__ unsigned pk2(float lo, float hi) { return pg8::cvt_pk_bf16(lo, hi); }
__device__ __forceinline__ float bf_lo(unsigned w) { return __uint_as_float(w << 16); }
__device__ __forceinline__ float bf_hi(unsigned w) { return __uint_as_float(w & 0xffff0000u); }
__device__ __forceinline__ float shx(float v, int k, int lane) { return __int_as_float(__builtin_amdgcn_ds_bpermute((lane ^ k) << 2, __float_as_int(v))); }
__device__ __forceinline__ int shxi(int v, int k, int lane) { return __builtin_amdgcn_ds_bpermute((lane ^ k) << 2, v); }
__device__ __forceinline__ float shx32(float v, int lane) { const unsigned u = __float_as_uint(v); const auto r = __builtin_amdgcn_permlane32_swap(u, u, false, false); return __uint_as_float((lane >> 5) ? r[0] : r[1]); }
__device__ __forceinline__ float wave_sum(float v, int lane) {
#pragma unroll
    for (int o = 1; o < 64; o <<= 1) v += shx(v, o, lane);
    return v;
}
__device__ __forceinline__ float gelu_t(float x) {
    const float u = 0.7978845608028654f * (x + 0.044715f * x * x * x);
    const float e = __expf(2.f * u);
    const float th = 1.f - 2.f / (e + 1.f);
    return 0.5f * x * (1.f + th);
}
__device__ __forceinline__ int tid_opaque() { int t = threadIdx.x; asm volatile("" : "+v"(t)); return t; }
__device__ __forceinline__ int crow(int reg, int h) { return (reg & 3) + 8 * (reg >> 2) + 4 * h; }

struct Params {
    const float* x; const float* attn_g; const float* w_in; const float* diff_lambda; const float* subln_g;
    const float* sgu_ln_g; const float* sgu_ln_b; const float* sgu_w; const float* sgu_b; const float* w_out;
    const float* mlp_g; const float* w1; const float* w2; const float* final_g;
    float* out; unsigned char* ws;
};

__device__ __forceinline__ void transpose_item(const float* W, int K, int N, bf16* WT, LAS float* scr, int item, int lane, const float* gk) {
    const int nblk = N / 32, kb = item / nblk, nb = item % nblk, k0 = 64 * kb, n0 = 32 * nb;
    float wv[32];
#pragma unroll
    for (int i = 0; i < 32; ++i) { const int kk = 2 * i + (lane >> 5); wv[i] = W[(size_t)(k0 + kk) * N + n0 + (lane & 31)]; }
    if (gk) {
#pragma unroll
        for (int i = 0; i < 32; ++i) wv[i] *= gk[k0 + 2 * i + (lane >> 5)];
    }
#pragma unroll
    for (int i = 0; i < 32; ++i) { const int kk = 2 * i + (lane >> 5); scr[kk * 33 + (lane & 31)] = wv[i]; }
    asm volatile("s_waitcnt lgkmcnt(0)" ::: "memory");
    const int c = lane & 7;
#pragma unroll
    for (int j = 0; j < 4; ++j) { const int n = (lane >> 3) + 8 * j; const LAS float* s = scr + (8 * c) * 33 + n;
        u32x4 o; o.x = pk2(s[0 * 33], s[1 * 33]); o.y = pk2(s[2 * 33], s[3 * 33]); o.z = pk2(s[4 * 33], s[5 * 33]); o.w = pk2(s[6 * 33], s[7 * 33]);
        *(u32x4*)(WT + (size_t)(n0 + n) * K + k0 + 8 * c) = o; }
    asm volatile("s_waitcnt lgkmcnt(0)" ::: "memory");
}

constexpr int NU_OWN = 192, NU_GAT = 456, NU_DIF = 384, NU_SGU = 256;
constexpr int U_GAT = NU_OWN, U_DIF = U_GAT + NU_GAT, U_SGU = U_DIF + NU_DIF, NU_ALL = U_SGU + NU_SGU;
constexpr size_t WS_PART = WS_XRES;
__device__ __forceinline__ void gat_decode(int v, int& n, int& C) {
    if (v < 28) { n = v >> 2; C = v & 3; }
    else if (v < 52) { const int w = v - 28; n = 7 + w / 3; C = 1 + w % 3; }
    else if (v < 68) { const int w = v - 52; n = 15 + (w >> 1); C = 2 + (w & 1); }
    else { n = 23 + (v - 68); C = 3; }
}
__device__ __forceinline__ float unit_cost(int u) {
    if (u < U_GAT) return 3.0f;
    if (u < U_DIF) { int n, C; gat_decode((u - U_GAT) % 76, n, C); const int bs = (n + 1 > 8 * C) ? n + 1 : 8 * C; float cnt = 0.f;
        for (int b = bs; b < 8 * C + 8; ++b) cnt += 256.f * (b < 3 ? (float)b : 3.f) / (float)b;
        return 4.0f * (cnt * (1.f / 256.f) + 0.5f); }
    if (u < U_SGU) return 1.7f * (float)(((u - U_DIF) & 63) + 1);
    return 0.5f;
}

__device__ __forceinline__ void phase_weights(const Params& p, LAS unsigned char* lds) {
    const int tid = tid_opaque(), lane = tid & 63, wave = tid >> 6;
    LAS float* scr = (LAS float*)(lds + wave * 16384);
    const int gw = blockIdx.x * NWAVES + wave, NGW = gridDim.x * NWAVES;
    constexpr int I_IN = (DM / 64) * (INW / 32), I_OUT = (DM / 64) * (DM / 32), I_1 = (DM / 64) * (DFF / 32), I_2 = (DFF / 64) * (DM / 32);
    constexpr int PER_LAYER = I_IN + I_OUT + I_1 + I_2;
    for (int it = gw; it < DEPTH * PER_LAYER; it += NGW) {
        const int l = it / PER_LAYER; int r = it % PER_LAYER;
        if (r < I_IN) { transpose_item(p.w_in + (size_t)l * DM * INW, DM, INW, (bf16*)(p.ws + WS_WIN) + (size_t)l * INW * DM, scr, r, lane, p.attn_g + (size_t)l * DM); continue; } r -= I_IN;
        if (r < I_OUT) { transpose_item(p.w_out + (size_t)l * DM * DM, DM, DM, (bf16*)(p.ws + WS_WOUT) + (size_t)l * DM * DM, scr, r, lane, nullptr); continue; } r -= I_OUT;
        if (r < I_1) { transpose_item(p.w1 + (size_t)l * DM * DFF, DM, DFF, (bf16*)(p.ws + WS_W1) + (size_t)l * DFF * DM, scr, r, lane, p.mlp_g + (size_t)l * DM); continue; } r -= I_1;
        transpose_item(p.w2 + (size_t)l * DFF * DM, DFF, DM, (bf16*)(p.ws + WS_W2) + (size_t)l * DM * DFF, scr, r, lane, nullptr);
    }
    if (blockIdx.x == 0) {
        unsigned* ctl = (unsigned*)(p.ws + WS_CTL);
        if (tid < 64) ctl[tid] = 0u;
        int* order = (int*)(p.ws + WS_ORDER);
        LAS float* cst = (LAS float*)(lds + 65536);
        __syncthreads();
        for (int u = tid; u < NU_ALL; u += NTHR) cst[u] = unit_cost(u);
        __syncthreads();
        for (int u = tid; u < NU_ALL; u += NTHR) {
            const float cu = cst[u]; int rank = 0;
            for (int j = 0; j < NU_ALL; ++j) { const float cj = cst[j]; rank += (cj > cu || (cj == cu && j < u)) ? 1 : 0; }
            order[rank] = u;
        }
    }
}

__device__ __forceinline__ void phase_x0(const float* X, bf16* XB, float* SS0) {
    const int tid = tid_opaque(), lane = tid & 63, wave = tid >> 6;
    const int gw = blockIdx.x * NWAVES + wave, NGW = gridDim.x * NWAVES;
    for (int m = gw; m < SEQ; m += NGW) {
        const f32x4* xr = (const f32x4*)(X + (size_t)m * DM) + lane;
        f32x4 v[8]; float s = 0.f;
#pragma unroll
        for (int j = 0; j < 8; ++j) { v[j] = xr[64 * j]; s += (v[j].x * v[j].x + v[j].y * v[j].y) + (v[j].z * v[j].z + v[j].w * v[j].w); }
        s = wave_sum(s, lane);
        if (lane < 32) SS0[(size_t)m * 32 + lane] = lane == 0 ? s : 0.f;
        u32x2* o8 = (u32x2*)(XB + (size_t)m * DM) + lane;
#pragma unroll
        for (int j = 0; j < 8; ++j) { u32x2 w; w.x = pk2(v[j].x, v[j].y); w.y = pk2(v[j].z, v[j].w); o8[64 * j] = w; }
    }
}
__device__ __forceinline__ void phase_norm_f32(const bf16* X, const float* g, const float* SS, float* O) {
    const int tid = tid_opaque(), lane = tid & 63, wave = tid >> 6;
    const int gw = blockIdx.x * NWAVES + wave, NGW = gridDim.x * NWAVES;
    for (int m = gw; m < SEQ; m += NGW) {
        const u32x4* xr = (const u32x4*)(X + (size_t)m * DM) + lane;
        const float rs = rsqrtf(wave_sum(lane < 32 ? SS[(size_t)m * 32 + lane] : 0.f, lane) * (1.f / DM) + EPS);
        f32x4* o = (f32x4*)(O + (size_t)m * DM) + 2 * lane;
#pragma unroll
        for (int j = 0; j < 4; ++j) { const u32x4 xv = xr[64 * j]; const f32x4 g0 = ((const f32x4*)g)[2 * lane + 128 * j], g1 = ((const f32x4*)g)[2 * lane + 128 * j + 1];
            o[128 * j] = (f32x4){bf_lo(xv.x), bf_hi(xv.x), bf_lo(xv.y), bf_hi(xv.y)} * rs * g0;
            o[128 * j + 1] = (f32x4){bf_lo(xv.z), bf_hi(xv.z), bf_lo(xv.w), bf_hi(xv.w)} * rs * g1; }
    }
}

constexpr int TP_STRIDE = 132;
__device__ __forceinline__ void post_unit(const Params& p, int layer, int unit, LAS unsigned char* lds) {
    const int tid = tid_opaque();
    const int rb = unit / 40, cbi = unit % 40, cb = cbi < 36 ? cbi : cbi + 4;
    const int col0 = cb * 128;
    const int r64 = tid >> 3, j = tid & 7;
    bf16* proj = (bf16*)(p.ws + WS_PROJ);
    int type;
    int hh = 0;
    if (cb < 6) type = 0; else if (cb < 12) type = 1; else if (cb < 18) { type = 2; hh = cb - 12; } else if (cb < 30) type = 3; else if (cb < 36) { type = 2; hh = 6 + cb - 30; } else { type = 4; hh = cb - 40; }
    int c0, c1;
    if (type <= 1) { c0 = 8 * j; c1 = c0 + 64; }
    else if (type == 3) { c0 = (j < 4) ? 8 * j : 64 + 8 * (j - 4); c1 = c0 + 32; }
    else { c0 = 16 * j; c1 = c0 + 8; }
    double inv2pi[8];
    if (type <= 1 || type == 3) {
        const float half = (type == 3) ? 32.f : 64.f; const int i0 = (type == 3) ? 8 * (j & 3) : 8 * j;
#pragma unroll
        for (int e = 0; e < 8; ++e) inv2pi[e] = (double)exp2f(-(float)(i0 + e) * (13.287712379549449f / half)) * 0.15915494309189535;
    } else {
#pragma unroll
        for (int e = 0; e < 8; ++e) inv2pi[e] = 0.0;
    }
    float csa[8], csb[8];
#pragma unroll
    for (int e = 0; e < 8; ++e) { csa[e] = 0.f; csb[e] = 0.f; }
    LAS bf16* tile = (LAS bf16*)lds;
    u32x4 na = *(const u32x4*)(proj + (size_t)(rb * 256 + r64) * INW + col0 + c0), nb = *(const u32x4*)(proj + (size_t)(rb * 256 + r64) * INW + col0 + c1);
    for (int sub = 0; sub < 4; ++sub) {
        const int row = rb * 256 + sub * 64 + r64;
        bf16* rp = proj + (size_t)row * INW + col0;
        const u32x4 ua = na, ub = nb;
        if (sub < 3) { na = *(const u32x4*)(rp + (size_t)64 * INW + c0); nb = *(const u32x4*)(rp + (size_t)64 * INW + c1); }
        float xa[8], xb[8];
#pragma unroll
        for (int e = 0; e < 4; ++e) { xa[2 * e] = bf_lo(ua[e]); xa[2 * e + 1] = bf_hi(ua[e]); xb[2 * e] = bf_lo(ub[e]); xb[2 * e + 1] = bf_hi(ub[e]); }
        if (type <= 1 || type == 3) {
            float ya[8], yb[8];
#pragma unroll
            for (int e = 0; e < 8; ++e) {
                double rev = (double)row * inv2pi[e]; rev -= floor(rev);
                const float fr = (float)rev;
                const float sn = __builtin_amdgcn_sinf(fr), cs = __builtin_amdgcn_cosf(fr);
                ya[e] = xa[e] * cs - xb[e] * sn; yb[e] = xb[e] * cs + xa[e] * sn;
                csa[e] += ya[e]; csb[e] += yb[e];
            }
            u32x4 oa, ob;
#pragma unroll
            for (int e = 0; e < 4; ++e) { oa[e] = pk2(ya[2 * e], ya[2 * e + 1]); ob[e] = pk2(yb[2 * e], yb[2 * e + 1]); }
            *(u32x4*)(rp + c0) = oa; *(u32x4*)(rp + c1) = ob;
        } else {
            u32x4 oa = ua, ob = ub;
            if (type == 4) {
                float s = 0.f;
#pragma unroll
                for (int e = 0; e < 8; ++e) { xa[e] = gelu_t(xa[e]); xb[e] = gelu_t(xb[e]); s += xa[e] + xb[e]; }
                s += shx(s, 1, tid & 63); s += shx(s, 2, tid & 63); s += shx(s, 4, tid & 63);
                const float mu = s * (1.f / 128.f); float s2 = 0.f;
#pragma unroll
                for (int e = 0; e < 8; ++e) { xa[e] -= mu; xb[e] -= mu; s2 += xa[e] * xa[e] + xb[e] * xb[e]; }
                s2 += shx(s2, 1, tid & 63); s2 += shx(s2, 2, tid & 63); s2 += shx(s2, 4, tid & 63);
                const float rstd = rsqrtf(s2 * (1.f / 128.f) + EPS);
                const float* lg = p.sgu_ln_g + ((size_t)layer * 4 + hh) * 128; const float* lb = p.sgu_ln_b + ((size_t)layer * 4 + hh) * 128;
#pragma unroll
                for (int e = 0; e < 8; ++e) { xa[e] = xa[e] * rstd * lg[c0 + e] + lb[c0 + e]; xb[e] = xb[e] * rstd * lg[c1 + e] + lb[c1 + e]; }
#pragma unroll
                for (int e = 0; e < 4; ++e) { oa[e] = pk2(xa[2 * e], xa[2 * e + 1]); ob[e] = pk2(xb[2 * e], xb[2 * e + 1]); }
            }
            __syncthreads();
            LAS u32x2* t0 = (LAS u32x2*)(tile + r64 * TP_STRIDE + c0);
            t0[0] = (u32x2){oa.x, oa.y}; t0[1] = (u32x2){oa.z, oa.w}; t0[2] = (u32x2){ob.x, ob.y}; t0[3] = (u32x2){ob.z, ob.w};
            __syncthreads();
            const int dv = tid >> 2, ch = tid & 3;
            unsigned w[8];
#pragma unroll
            for (int k = 0; k < 8; ++k) { const unsigned lo = tile[(16 * ch + 2 * k) * TP_STRIDE + dv], hi = tile[(16 * ch + 2 * k + 1) * TP_STRIDE + dv]; w[k] = lo | (hi << 16); }
            bf16* dst;
            if (type == 2) dst = (bf16*)(p.ws + WS_VT) + ((size_t)hh * 128 + dv) * SEQ + rb * 256 + sub * 64 + 16 * ch;
            else dst = (bf16*)(p.ws + WS_VNT) + ((size_t)((rb * 2 + (sub >> 1)) * 4 + hh) * 128 + dv) * 128 + (sub & 1) * 64 + 16 * ch;
            if (type == 2) { *(u32x4*)dst = (u32x4){w[0], w[1], w[4], w[5]}; *(u32x4*)(dst + 8) = (u32x4){w[2], w[3], w[6], w[7]}; }
            else { *(u32x4*)dst = (u32x4){w[0], w[1], w[2], w[3]}; *(u32x4*)(dst + 8) = (u32x4){w[4], w[5], w[6], w[7]}; }
        }
    }
    if (type == 1) {
        __syncthreads();
        LAS float* red = (LAS float*)lds;
#pragma unroll
        for (int e = 0; e < 8; ++e) { red[r64 * 128 + c0 + e] = csa[e]; red[r64 * 128 + c1 + e] = csb[e]; }
        __syncthreads();
        if (tid < 128) { float s = 0.f; for (int r = 0; r < 64; ++r) s += red[r * 128 + tid];
            ((float*)(p.ws + WS_KM))[((size_t)(cb - 6) * 32 + rb) * 128 + tid] = s * (1.f / 256.f); }
    }
    __syncthreads();
}

__device__ __forceinline__ void sgu_item(const Params& p, int layer, int item) {
    const int tid = tid_opaque(), lane = tid & 63, wave = tid >> 6, r = lane & 31, h = lane >> 5;
    const int nc = item >> 2, g = item & 3;
    const int tb = wave >> 1;
    const float* W = p.sgu_w + ((size_t)layer * 4 + g) * 128 * 128;
    const bf16* vnt = (const bf16*)(p.ws + WS_VNT) + (size_t)(nc * 4 + g) * 128 * 128;
    const bf16* proj = (const bf16*)(p.ws + WS_PROJ);
    bf16* mix = (bf16*)(p.ws + WS_MIX);
    const int t = 32 * tb + r;
    f32x4 wl[8][2];
#pragma unroll
    for (int ks = 0; ks < 8; ++ks) { const int s0 = 16 * ks + 8 * h; wl[ks][0] = *(const f32x4*)(W + t * 128 + s0); wl[ks][1] = *(const f32x4*)(W + t * 128 + s0 + 4); }
    bf16x8 bfr[2][8];
#pragma unroll
    for (int cc = 0; cc < 2; ++cc)
#pragma unroll
        for (int ks = 0; ks < 8; ++ks) bfr[cc][ks] = *(const bf16x8*)(vnt + (size_t)(32 * ((wave & 1) * 2 + cc) + r) * 128 + 16 * ks + 8 * h);
    bf16x8 af[8];
#pragma unroll
    for (int ks = 0; ks < 8; ++ks) { const int s0 = 16 * ks + 8 * h;
        float wv[8] = {wl[ks][0].x, wl[ks][0].y, wl[ks][0].z, wl[ks][0].w, wl[ks][1].x, wl[ks][1].y, wl[ks][1].z, wl[ks][1].w};
#pragma unroll
        for (int e = 0; e < 8; ++e) wv[e] = (s0 + e <= t) ? wv[e] : 0.f;
        u32x4 au; au.x = pk2(wv[0], wv[1]); au.y = pk2(wv[2], wv[3]); au.z = pk2(wv[4], wv[5]); au.w = pk2(wv[6], wv[7]);
        af[ks] = __builtin_bit_cast(bf16x8, au); }
#pragma unroll
    for (int cc = 0; cc < 2; ++cc) {
        const int cbk = (wave & 1) * 2 + cc;
        const int c = 32 * cbk + r;
        unsigned short ur[16]; float br[16];
#pragma unroll
        for (int i = 0; i < 16; ++i) { const int tt = 32 * tb + crow(i, h); ur[i] = proj[((size_t)nc * 128 + tt) * INW + C_SU + g * 128 + c]; br[i] = p.sgu_b[((size_t)layer * 4 + g) * 128 + tt]; }
        f32x16 acc;
#pragma unroll
        for (int i = 0; i < 16; ++i) acc[i] = 0.f;
#pragma unroll
        for (int ks = 0; ks < 8; ++ks) acc = MFMA32(af[ks], bfr[cc][ks], acc);
#pragma unroll
        for (int i = 0; i < 16; ++i) {
            const int tt = 32 * tb + crow(i, h);
            const size_t tok = (size_t)nc * 128 + tt;
            const float u = gelu_t(__uint_as_float(((unsigned)ur[i]) << 16));
            const float o = u * (acc[i] + br[i]);
            mix[tok * DM + 1536 + g * 128 + c] = (bf16)(pk2(o, 0.f) & 0xffffu);
        }
    }
}

constexpr int KT_BYTES = 16384, VT_BYTES = 16384;
constexpr int ABUF = KT_BYTES + VT_BYTES;
constexpr float LOG2E = 1.4426950408889634f;

__device__ __forceinline__ void tile_dma(LAS unsigned char* slot, const bf16* proj, const bf16* vt, int kcol, int hh, int kbase, int wave, int lane) {
#pragma unroll
    for (int i = 0; i < 2; ++i) { const int c = i * 8 + wave, row = 4 * c + (lane >> 4), g = (lane & 15) ^ (row & 15);
        __builtin_amdgcn_global_load_lds((const unsigned*)(proj + (size_t)(kbase + row) * INW + kcol + g * 8), (LAS unsigned*)(slot + c * 1024), 16, 0, 0); }
#pragma unroll
    for (int i = 0; i < 2; ++i) { const int c = i * 8 + wave, row = 8 * c + (lane >> 3), g = (lane & 7) ^ ((row >> 1) & 7);
        __builtin_amdgcn_global_load_lds((const unsigned*)(vt + ((size_t)hh * 128 + row) * SEQ + kbase + g * 8), (LAS unsigned*)(slot + KT_BYTES + c * 1024), 16, 0, 0); }
}

#define TOP3_INSERT(v, n) do { if ((v) > v0 || ((v) == v0 && (n) < i0)) { v2 = v1; i2 = i1; v1 = v0; i1 = i0; v0 = (v); i0 = (n); } \
    else if ((v) > v1 || ((v) == v1 && (n) < i1)) { v2 = v1; i2 = i1; v1 = (v); i1 = (n); } \
    else if ((v) > v2 || ((v) == v2 && (n) < i2)) { v2 = (v); i2 = (n); } } while (0)
__device__ __forceinline__ unsigned moba_gate(const Params& p, int h, int own, const bf16x8 (&qf)[8], int lane) {
    const int r = lane & 31, hf = lane >> 5;
    unsigned selmask = 0u;
    if (own > 0) {
        f32x16 gt;
#pragma unroll
        for (int i = 0; i < 16; ++i) gt[i] = 0.f;
        const float* kmg = (const float*)(p.ws + WS_KM) + ((size_t)h * 32 + r) * 128 + 8 * hf;
#pragma unroll
        for (int ks = 0; ks < 8; ++ks) {
            const f32x4 a0 = *(const f32x4*)(kmg + 16 * ks), a1 = *(const f32x4*)(kmg + 16 * ks + 4);
            u32x4 hi; hi.x = pk2(a0.x, a0.y); hi.y = pk2(a0.z, a0.w); hi.z = pk2(a1.x, a1.y); hi.w = pk2(a1.z, a1.w);
            u32x4 lo; lo.x = pk2(a0.x - bf_lo(hi.x), a0.y - bf_hi(hi.x)); lo.y = pk2(a0.z - bf_lo(hi.y), a0.w - bf_hi(hi.y));
            lo.z = pk2(a1.x - bf_lo(hi.z), a1.y - bf_hi(hi.z)); lo.w = pk2(a1.z - bf_lo(hi.w), a1.w - bf_hi(hi.w));
            gt = MFMA32(__builtin_bit_cast(bf16x8, hi), qf[ks], gt);
            gt = MFMA32(__builtin_bit_cast(bf16x8, lo), qf[ks], gt);
        }
        float v0 = -INFINITY, v1 = -INFINITY, v2 = -INFINITY; int i0 = 64, i1 = 64, i2 = 64;
#pragma unroll
        for (int i = 0; i < 16; ++i) { const int n = crow(i, hf); if (n < own) TOP3_INSERT(gt[i], n); }
        const float pv0 = shx(v0, 32, lane), pv1 = shx(v1, 32, lane), pv2 = shx(v2, 32, lane);
        const int pi0 = shxi(i0, 32, lane), pi1 = shxi(i1, 32, lane), pi2 = shxi(i2, 32, lane);
        if (pi0 < 64) TOP3_INSERT(pv0, pi0);
        if (pi1 < 64) TOP3_INSERT(pv1, pi1);
        if (pi2 < 64) TOP3_INSERT(pv2, pi2);
        if (i0 < 64) selmask |= 1u << i0;
        if (i1 < 64) selmask |= 1u << i1;
        if (i2 < 64) selmask |= 1u << i2;
    }
    return selmask;
}
__device__ __forceinline__ void sel_item(const Params& p, int item) {
    const int tid = tid_opaque(), lane = tid & 63, wave = tid >> 6, r = lane & 31, hf = lane >> 5;
    const int h = item >> 5, qb = item & 31, q = qb * 256 + 32 * wave + r;
    const bf16* proj = (const bf16*)(p.ws + WS_PROJ);
    bf16x8 qf[8];
#pragma unroll
    for (int ks = 0; ks < 8; ++ks) qf[ks] = *(const bf16x8*)(proj + (size_t)q * INW + C_MQ + h * 128 + 16 * ks + 8 * hf);
    const unsigned mask = moba_gate(p, h, qb, qf, lane);
    if (hf == 0) ((unsigned*)(p.ws + WS_SEL))[(size_t)h * SEQ + q] = mask;
}
template <int MODE>
__device__ __forceinline__ void attn_unit(const Params& p, int layer, int h, int qb, LAS unsigned char* lds, int gq, bool gactive, int gj, int gtile0) {
    constexpr int NKS = MODE == 1 ? 4 : 8;
    const int tid = tid_opaque(), lane = tid & 63, wave = __builtin_amdgcn_readfirstlane(tid >> 6), r = lane & 31, hf = lane >> 5;
    const int grp = wave >> 2;
    const bf16* proj = (const bf16*)(p.ws + WS_PROJ);
    const bf16* vt = (const bf16*)(p.ws + WS_VT);
    bf16* mix = (bf16*)(p.ws + WS_MIX);
    int wrow0, ntiles, qcol, kcol, kc0, hh, tile0; float scale;
    if (MODE != 1) { wrow0 = MODE == 0 ? qb * 256 + 32 * wave : (1 << 20); tile0 = MODE == 0 ? 4 * qb : gtile0; ntiles = 4; qcol = C_MQ + h * 128; kcol = C_MK + h * 128; kc0 = 0; hh = h; scale = 0.08838834764831845f * LOG2E; }
    else { tile0 = 0; wrow0 = qb * 128 + 32 * (wave & 3); ntiles = 2 * (qb + 1); qcol = C_DQ + h * 128 + grp * 64; kcol = C_DK + h * 128; kc0 = grp * 64; hh = 6 + h; scale = 0.125f * LOG2E; }
    const LAS unsigned short* glist = (const LAS unsigned short*)(lds + 102400);
    int q;
    if (MODE == 2) { const int idx = gq + 32 * wave + r; q = glist[idx < gj ? idx : 0]; } else q = wrow0 + r;
    bf16x8 qf[NKS];
#pragma unroll
    for (int ks = 0; ks < NKS; ++ks) qf[ks] = *(const bf16x8*)(proj + (size_t)q * INW + qcol + 16 * ks + 8 * hf);
    f32x16 o[4];
#pragma unroll
    for (int d = 0; d < 4; ++d)
#pragma unroll
        for (int i = 0; i < 16; ++i) o[d][i] = 0.f;
    float m = -1e30f, l = 0.f;
    bf16x8 pf[4];
#pragma unroll
    for (int k = 0; k < 4; ++k) pf[k] = (bf16x8){0, 0, 0, 0, 0, 0, 0, 0};
    bool prev_on = false;
    tile_dma(lds, proj, vt, kcol, hh, tile0 * 64, wave, lane);
    const unsigned ck = (unsigned)(r * 256 + 16 * ((r & 15) ^ hf));
    const unsigned cv = (unsigned)(KT_BYTES + r * 128 + 16 * (((r >> 1) & 7) ^ hf));
    asm volatile("s_waitcnt vmcnt(0)" ::: "memory");
    __syncthreads();
#define ATTN_BACK(vbuf) do { _Pragma("unroll") for (int k4 = 0; k4 < 4; ++k4) { bf16x8 vf_[4]; \
        _Pragma("unroll") for (int d = 0; d < 4; ++d) { \
            const unsigned x_ = ((vbuf) + cv) ^ (unsigned)(32 * k4); \
            vf_[d] = *(const LAS bf16x8*)(lds + x_ + 4096 * d); } \
        __builtin_amdgcn_sched_barrier(0); \
        _Pragma("unroll") for (int d = 0; d < 4; ++d) o[d] = MFMA32(vf_[d], pf[k4], o[d]); \
        __builtin_amdgcn_sched_barrier(0); } } while (0)
    const bool defer = (MODE == 1) && (grp == 1);
    int slot = 0;
    for (int t = 0; t < ntiles; ++t) {
        const int kbase = (tile0 + t) * 64;
        const unsigned buf = (unsigned)(slot * ABUF);
        const unsigned bufp = (unsigned)((slot == 0 ? 2 : slot - 1) * ABUF);
        const int nslot = slot == 2 ? 0 : slot + 1;
        if (t + 1 < ntiles) tile_dma(lds + nslot * ABUF, proj, vt, kcol, hh, kbase + 64, wave, lane);
        if (defer && prev_on) ATTN_BACK(bufp);
        const bool lane_on = true;
        const bool wave_on = (MODE == 2) || (kbase <= wrow0 + 31);
        if (wave_on) {
            f32x16 s[2];
#pragma unroll
            for (int b = 0; b < 2; ++b) {
#pragma unroll
                for (int i = 0; i < 16; ++i) s[b][i] = 0.f;
#pragma unroll
                for (int k0 = 0; k0 < NKS; k0 += 4) {
                    bf16x8 kf[4];
#pragma unroll
                    for (int ks = 0; ks < 4; ++ks) kf[ks] = *(const LAS bf16x8*)(lds + ((buf + 8192u * b + ck) ^ (unsigned)(2 * kc0 + 32 * (k0 + ks))));
                    __builtin_amdgcn_sched_barrier(0);
#pragma unroll
                    for (int ks = 0; ks < 4; ++ks) s[b] = MFMA32(kf[ks], qf[k0 + ks], s[b]);
                    __builtin_amdgcn_sched_barrier(0);
                }
            }
            const bool diag = (MODE != 2) && (kbase + 63 > wrow0);
            float mx = -INFINITY;
            bool lane_off = false;
            if (diag) {
                asm volatile("" ::: "memory");
#pragma unroll
                for (int b = 0; b < 2; ++b)
#pragma unroll
                    for (int i = 0; i < 16; ++i) {
                        const int key = kbase + 32 * b + crow(i, hf);
                        const bool ok = lane_on && (key <= q);
                        s[b][i] = ok ? s[b][i] : -INFINITY;
                        mx = fmaxf(mx, s[b][i]);
                    }
            } else {
#pragma unroll
                for (int b = 0; b < 2; ++b)
#pragma unroll
                    for (int i = 0; i < 16; ++i) mx = fmaxf(mx, s[b][i]);
            }
            mx = fmaxf(mx, shx32(mx, lane));
            const float mn = fmaxf(m, mx);
            const float alpha = __builtin_amdgcn_exp2f((m - mn) * scale);
            const float mns = lane_off ? INFINITY : mn * scale;
            float ls = 0.f;
#pragma unroll
            for (int b = 0; b < 2; ++b)
#pragma unroll
                for (int i = 0; i < 16; ++i) { const float pv = __builtin_amdgcn_exp2f(s[b][i] * scale - mns); s[b][i] = pv; ls += pv; }
            l = l * alpha + ls;
            __builtin_amdgcn_sched_barrier(0);
            if (__builtin_amdgcn_ballot_w64(mn != m) != 0ull) {
#pragma unroll
                for (int d = 0; d < 4; ++d)
#pragma unroll
                    for (int i = 0; i < 16; ++i) o[d][i] *= alpha;
            }
            m = mn;
#pragma unroll
            for (int b = 0; b < 2; ++b)
#pragma unroll
                for (int ss = 0; ss < 2; ++ss) {
                    u32x4 pu;
                    pu.x = pk2(s[b][8 * ss + 0], s[b][8 * ss + 1]); pu.y = pk2(s[b][8 * ss + 2], s[b][8 * ss + 3]);
                    pu.z = pk2(s[b][8 * ss + 4], s[b][8 * ss + 5]); pu.w = pk2(s[b][8 * ss + 6], s[b][8 * ss + 7]);
                    pf[2 * b + ss] = __builtin_bit_cast(bf16x8, pu);
                }
            if (!defer) ATTN_BACK(buf);
        }
        prev_on = wave_on;
        slot = nslot;
        asm volatile("s_waitcnt vmcnt(0)" ::: "memory");
        __syncthreads();
    }
    if (defer && prev_on) { const unsigned bufp = (unsigned)((slot == 0 ? 2 : slot - 1) * ABUF); ATTN_BACK(bufp); }
#undef ATTN_BACK
    const float lt = l + shx(l, 32, lane);
    const float inv = 1.f / lt;
    if (MODE != 1) {
        int q2 = q, jj = 3; bool act = true;
        if (MODE == 2) {
            const int t2 = tid_opaque(), idx = gq + 32 * (t2 >> 6) + (t2 & 31); act = idx < gj; q2 = glist[act ? idx : 0];
            jj = __builtin_popcount(((const unsigned*)(p.ws + WS_SEL))[(size_t)h * SEQ + q2] & ((1u << (gtile0 >> 2)) - 1u)); }
        if (act) {
            unsigned* rec = (unsigned*)(p.ws + WS_PART) + (((size_t)h * SEQ + q2) * 4 + jj) * 68;
            if (hf == 0) { rec[0] = __float_as_uint(m * scale); rec[1] = __float_as_uint(lt); }
#pragma unroll
            for (int d = 0; d < 4; ++d)
#pragma unroll
                for (int g4 = 0; g4 < 4; ++g4) {
                    u32x2 w; w.x = pk2(o[d][4 * g4] * inv, o[d][4 * g4 + 1] * inv); w.y = pk2(o[d][4 * g4 + 2] * inv, o[d][4 * g4 + 3] * inv);
                    *(u32x2*)(rec + 4 + 16 * d + 4 * g4 + 2 * hf) = w;
                }
        }
    } else {
        __syncthreads();
        LAS float* ex = (LAS float*)lds;
        const int wi = wave & 3;
        if (wave >= 4) {
#pragma unroll
            for (int d = 0; d < 4; ++d)
#pragma unroll
                for (int i = 0; i < 16; ++i) ex[(wi * 64 + d * 16 + i) * 64 + lane] = o[d][i] * inv;
        }
        __syncthreads();
        if (wave < 4) {
            int ly = layer; asm volatile("" : "+s"(ly));
            float c08 = 0.8f, c06 = 0.6f; asm volatile("" : "+s"(c08), "+s"(c06));
            const float lin = c08 - c06 * __expf(-0.3f * (float)ly);
            const float* lp = p.diff_lambda + (size_t)ly * 256;
            const float la = wave_sum(lp[lane] * lp[64 + lane], lane), lb = wave_sum(lp[128 + lane] * lp[192 + lane], lane);
            const float lamv = __expf(la) - __expf(lb) + lin, oml = 1.f - lin;
            float ss = 0.f;
#pragma unroll
            for (int d = 0; d < 4; ++d) {
#pragma unroll
                for (int i = 0; i < 16; ++i) { const float v = o[d][i] * inv - lamv * ex[(wi * 64 + d * 16 + i) * 64 + lane]; o[d][i] = v; ss += v * v; }
                __builtin_amdgcn_sched_barrier(0);
            }
            ss += shx(ss, 32, lane);
            const float rs = rsqrtf(ss * (1.f / 128.f) + EPS) * oml;
            const float* sg = p.subln_g + (size_t)layer * 128;
#pragma unroll
            for (int d = 0; d < 4; ++d)
#pragma unroll
                for (int g4 = 0; g4 < 4; ++g4) {
                    const int dv = 32 * d + 8 * g4 + 4 * hf;
                    const f32x4 gg = *(const f32x4*)(sg + dv);
                    u32x2 w; w.x = pk2(o[d][4 * g4] * rs * gg.x, o[d][4 * g4 + 1] * rs * gg.y); w.y = pk2(o[d][4 * g4 + 2] * rs * gg.z, o[d][4 * g4 + 3] * rs * gg.w);
                    *(u32x2*)(mix + (size_t)q * DM + 768 + h * 128 + dv) = w;
                }
        }
        __syncthreads();
    }
}

__device__ __forceinline__ void gathered_unit(const Params& p, int layer, int h, int v, LAS unsigned char* lds) {
    const int tid = tid_opaque(), lane = tid & 63, wave = tid >> 6, r = lane & 31;
    int n, C; gat_decode(v, n, C);
    const int bs = (n + 1 > 8 * C) ? n + 1 : 8 * C, q0 = bs * 256, q1 = (8 * C + 8) * 256;
    LAS unsigned short* list = (LAS unsigned short*)(lds + 102400);
    LAS int* cnt = (LAS int*)(lds + LDS_MISC + 12);
    const unsigned* sel = (const unsigned*)(p.ws + WS_SEL) + (size_t)h * SEQ;
    if (tid == 0) *cnt = 0;
    __syncthreads();
    for (int q = q0 + tid; q < q1; q += NTHR)
        if ((sel[q] >> n) & 1u) { const int s = __hip_atomic_fetch_add(cnt, 1, __ATOMIC_RELAXED, __HIP_MEMORY_SCOPE_WORKGROUP); list[s] = (unsigned short)q; }
    __syncthreads();
    const int count = *(volatile LAS int*)cnt;
    for (int g0 = 0; g0 < count; g0 += 256) {
        attn_unit<2>(p, layer, h, 0, lds, g0, true, count, 4 * n);
        __syncthreads();
    }
}
__device__ __forceinline__ void phase_attn(const Params& p, int layer, LAS unsigned char* lds) {
    const int tid = tid_opaque();
    volatile LAS int* misc = (volatile LAS int*)(lds + LDS_MISC);
    unsigned* ctr = (unsigned*)(p.ws + WS_CTL) + layer;
    const int* order = (const int*)(p.ws + WS_ORDER);
    for (;;) {
        if (tid == 0) misc[0] = (int)atomicAdd(ctr, 1u);
        __syncthreads();
        const int idx = misc[0];
        __syncthreads();
        if (idx >= NU_ALL) break;
        const int u = order[idx];
        if (u < U_GAT) attn_unit<0>(p, layer, u >> 5, u & 31, lds, 0, true, 3, 0);
        else if (u < U_DIF) gathered_unit(p, layer, (u - U_GAT) / 76, (u - U_GAT) % 76, lds);
        else if (u < U_SGU) { const int w = u - U_DIF; attn_unit<1>(p, layer, w >> 6, w & 63, lds, 0, true, 0, 0); }
        else sgu_item(p, layer, u - U_SGU);
    }
}
__device__ __forceinline__ void phase_merge(const Params& p) {
    const int tid = tid_opaque(), lane = tid & 63, wave = tid >> 6;
    const int gw = blockIdx.x * NWAVES + wave, NGW = gridDim.x * NWAVES;
    bf16* mix = (bf16*)(p.ws + WS_MIX);
    for (int it = gw; it < 6 * SEQ; it += NGW) {
        const int h = it / SEQ, q = it % SEQ, cnt = (q >> 8) < 3 ? (q >> 8) : 3;
        const unsigned* rec = (const unsigned*)(p.ws + WS_PART) + ((size_t)h * SEQ + q) * 4 * 68;
        float mj[4], lj[4]; unsigned ow[4];
#pragma unroll
        for (int j = 0; j < 4; ++j) { const bool ok = (j == 3) || (j < cnt);
            mj[j] = ok ? __uint_as_float(rec[j * 68]) : -INFINITY; lj[j] = ok ? __uint_as_float(rec[j * 68 + 1]) : 0.f; ow[j] = ok ? rec[j * 68 + 4 + lane] : 0u; }
        const float M = fmaxf(fmaxf(mj[0], mj[1]), fmaxf(mj[2], mj[3]));
        float W = 0.f, a0 = 0.f, a1 = 0.f;
#pragma unroll
        for (int j = 0; j < 4; ++j) { const float w = lj[j] * __builtin_amdgcn_exp2f(mj[j] - M); W += w; a0 += w * bf_lo(ow[j]); a1 += w * bf_hi(ow[j]); }
        const float iw = 1.f / W;
        ((unsigned*)(mix + (size_t)q * DM + h * 128))[lane] = pk2(a0 * iw, a1 * iw);
    }
}

#define XB_TMO      128
#define XB_XCNT(j)  (256  + 64 * (j))
#define XB_XSUB(j)  (1280 + 64 * (j))
#define XB_XGEN(j)  (2304 + 64 * (j))
#define XB_TOP      3328
#define XB_TOPGEN   3392
#define XCD_BAR_WORDS 3456
#define XB_SPIN_CAP (1u << 18)

__device__ __forceinline__ unsigned xb_ld(unsigned* p)              { return __hip_atomic_load(p, __ATOMIC_RELAXED, __HIP_MEMORY_SCOPE_AGENT); }
__device__ __forceinline__ unsigned xb_add(unsigned* p, unsigned v) { return __hip_atomic_fetch_add(p, v, __ATOMIC_RELAXED, __HIP_MEMORY_SCOPE_AGENT); }
__device__ __forceinline__ unsigned xb_xcc_id() { return (unsigned)__builtin_amdgcn_s_getreg((3 << 11) | 20) & 0xFu; }
#define XB_SPIN(cond, bar) do { unsigned _sp = 0; while (cond) { __builtin_amdgcn_s_sleep(1); \
    if ((++_sp & 255u) == 0u) { if (xb_ld(&(bar)[XB_TMO])) break; if (_sp > XB_SPIN_CAP) { atomicAdd(&(bar)[XB_TMO], 1u); break; } } } } while (0)

struct XcdBarrier {
    unsigned* bar; unsigned x;
    volatile LAS unsigned* st;
};

__device__ __forceinline__ XcdBarrier xcd_barrier_post(unsigned* bar, volatile LAS unsigned* st) {
    XcdBarrier b; b.bar = bar; b.x = xb_xcc_id(); b.st = st;
    if (threadIdx.x == 0) (void)xb_add(&bar[XB_XCNT(b.x)], 1u);
    return b;
}
__device__ __forceinline__ void xcd_barrier_complete(unsigned* bar, unsigned x, unsigned& nloc, unsigned& nx) {
    const unsigned G = gridDim.x * gridDim.y * gridDim.z;
    unsigned sum, cnt, mine, sp = 0u;
    for (;;) {
        sum = 0u; cnt = 0u; mine = 0u;
#pragma unroll
        for (unsigned j = 0; j < 16; ++j) { const unsigned c = xb_ld(&bar[XB_XCNT(j)]); sum += c; cnt += (c > 0u) ? 1u : 0u; mine = (j == x) ? c : mine; }
        if (sum == G) break;
        __builtin_amdgcn_s_sleep(1);
        if ((++sp & 255u) == 0u) { if (xb_ld(&bar[XB_TMO])) break; if (sp > XB_SPIN_CAP) { atomicAdd(&bar[XB_TMO], 1u); break; } }
    }
    nloc = mine > 0u ? mine : 1u; nx = cnt > 0u ? cnt : 1u;
}

__device__ __forceinline__ void xcd_barrier(const XcdBarrier& b) {
    asm volatile("s_waitcnt vmcnt(0)" ::: "memory");
    __syncthreads();
    if (threadIdx.x == 0) {
        unsigned* bar = b.bar;
        __builtin_amdgcn_s_waitcnt(0);
        unsigned nloc = b.st[0], nx = b.st[1];
        if (nloc == 0u) { xcd_barrier_complete(bar, b.x, nloc, nx); b.st[0] = nloc; b.st[1] = nx; }
        const unsigned old = xb_add(&bar[XB_XSUB(b.x)], 1u);
        const unsigned gen = old / nloc;
        if (old + 1u == (gen + 1u) * nloc) {
            __builtin_amdgcn_fence(__ATOMIC_RELEASE, "agent");
            asm volatile("s_waitcnt vmcnt(0)" ::: "memory");
            const unsigned og = xb_add(&bar[XB_TOP], 1u);
            const unsigned tg = og / nx;
            if (og + 1u == (tg + 1u) * nx) xb_add(&bar[XB_TOPGEN], 1u);
            else XB_SPIN(xb_ld(&bar[XB_TOPGEN]) == tg, bar);
            __builtin_amdgcn_fence(__ATOMIC_ACQUIRE, "agent");
            xb_add(&bar[XB_XGEN(b.x)], 1u);
            asm volatile("s_waitcnt vmcnt(0)" ::: "memory");
        } else {
            XB_SPIN(xb_ld(&bar[XB_XGEN(b.x)]) == gen, bar);
            __builtin_amdgcn_fence(__ATOMIC_ACQUIRE, "agent");
            asm volatile("s_waitcnt vmcnt(0)" ::: "memory");
        }
    }
    __syncthreads();
}


__global__ void __launch_bounds__(NTHR, 2) trunk_fwd(Params p) {
    extern __shared__ __attribute__((aligned(16))) unsigned char lds_raw[];
    LAS unsigned char* lds = (LAS unsigned char*)lds_raw;
    cg::grid_group grid = cg::this_grid();
    const int G = gridDim.x, bid = blockIdx.x;
    unsigned char* ws = p.ws;
    bf16* H = (bf16*)(ws + WS_H); bf16* PROJ = (bf16*)(ws + WS_PROJ); bf16* MIX = (bf16*)(ws + WS_MIX); bf16* HID = (bf16*)(ws + WS_HID);

    volatile LAS unsigned* xst = (volatile LAS unsigned*)(lds + LDS_MISC + 64);
    if (threadIdx.x < 4) xst[threadIdx.x] = 0u;
    if (bid == 0) { unsigned* bw = (unsigned*)(ws + WS_BAR); for (int i = threadIdx.x; i < XCD_BAR_WORDS; i += NTHR) bw[i] = 0u; }
    phase_weights(p, lds);
    float* SS = (float*)(ws + WS_SS);
    phase_x0(p.x, H, SS);
    grid.sync();
    const XcdBarrier xb = xcd_barrier_post((unsigned*)(ws + WS_BAR), xst);
#define GRID_BAR() xcd_barrier(xb)
    for (int layer = 0; layer < DEPTH; ++layer) {
        {
            pg8::Gemm g{H, (const bf16*)(ws + WS_WIN) + (size_t)layer * INW * DM, SEQ, INW, DM}; pg8::StaticOrder S; S.init(SEQ, INW, G, bid);
            pg8::EpiBf16<0> E{PROJ, INW, SS + (size_t)(2 * layer) * SEQ * 32, 1.f / DM, (const LAS float*)(lds + 131072)};
            pg8::gemm_phase(lds, g, S, E);
        }
        GRID_BAR();
        for (int u = bid; u < 32 * 40; u += G) post_unit(p, layer, u, lds);
        GRID_BAR();
        for (int it = bid; it < 192; it += G) sel_item(p, it);
        GRID_BAR();
        phase_attn(p, layer, lds);
        GRID_BAR();
        phase_merge(p);
        GRID_BAR();
        {
            pg8::Gemm g{MIX, (const bf16*)(ws + WS_WOUT) + (size_t)layer * DM * DM, SEQ, DM, DM}; pg8::StaticOrder S; S.init(SEQ, DM, G, bid);
            pg8::EpiResid E{H, SS + (size_t)(2 * layer + 1) * SEQ * 32, DM};
            pg8::gemm_phase(lds, g, S, E);
        }
        GRID_BAR();
        {
            pg8::Gemm g{H, (const bf16*)(ws + WS_W1) + (size_t)layer * DFF * DM, SEQ, DFF, DM}; pg8::StaticOrder S; S.init(SEQ, DFF, G, bid);
            pg8::EpiBf16<1> E{HID, DFF, SS + (size_t)(2 * layer + 1) * SEQ * 32, 1.f / DM, (const LAS float*)(lds + 131072)};
            pg8::gemm_phase(lds, g, S, E);
        }
        GRID_BAR();
        {
            pg8::Gemm g{HID, (const bf16*)(ws + WS_W2) + (size_t)layer * DM * DFF, SEQ, DM, DFF}; pg8::StaticOrder S; S.init(SEQ, DM, G, bid);
            pg8::EpiResid E{H, SS + (size_t)(2 * layer + 2) * SEQ * 32, DM};
            pg8::gemm_phase(lds, g, S, E);
        }
        GRID_BAR();
    }
    phase_norm_f32(H, p.final_g, SS + (size_t)8 * SEQ * 32, p.out);
}

extern "C" void kernel_launch(void* const* d_in, const int* in_sizes, int n_in, void* d_out, int out_size, void* d_ws, size_t ws_size, hipStream_t stream) {
    static int grid_blocks = 0;
    if (grid_blocks == 0) {
        if (n_in != 14 || ws_size < WS_END) { fprintf(stderr, "kernel_launch: unexpected inputs (n_in %d, ws %zu, need %zu)\n", n_in, ws_size, (size_t)WS_END); grid_blocks = -1; return; }
        int dev = 0, cus = 0, per_cu = 0;
        hipGetDevice(&dev);
        hipDeviceGetAttribute(&cus, hipDeviceAttributeMultiprocessorCount, dev);
        hipFuncSetAttribute((const void*)trunk_fwd, hipFuncAttributeMaxDynamicSharedMemorySize, LDS_BYTES);
        hipOccupancyMaxActiveBlocksPerMultiprocessor(&per_cu, (const void*)trunk_fwd, NTHR, LDS_BYTES);
        if (per_cu < 1) per_cu = 1;
        grid_blocks = cus * per_cu;
        (void)hipGetLastError();
    }
    if (grid_blocks < 0) return;
    Params p{};
    p.x = (const float*)d_in[0]; p.attn_g = (const float*)d_in[1]; p.w_in = (const float*)d_in[2]; p.diff_lambda = (const float*)d_in[3]; p.subln_g = (const float*)d_in[4];
    p.sgu_ln_g = (const float*)d_in[5]; p.sgu_ln_b = (const float*)d_in[6]; p.sgu_w = (const float*)d_in[7]; p.sgu_b = (const float*)d_in[8]; p.w_out = (const float*)d_in[9];
    p.mlp_g = (const float*)d_in[10]; p.w1 = (const float*)d_in[11]; p.w2 = (const float*)d_in[12]; p.final_g = (const float*)d_in[13];
    p.out = (float*)d_out; p.ws = (unsigned char*)d_ws;
    void* args[] = {&p};
    hipError_t e = hipLaunchCooperativeKernel((const void*)trunk_fwd, dim3(grid_blocks), dim3(NTHR), args, LDS_BYTES, stream);
    if (e != hipSuccess) fprintf(stderr, "cooperative launch failed: %s (grid %d)\n", hipGetErrorString(e), grid_blocks);
}
```

```cpp
#include <hip/hip_runtime.h>
#include <hip/hip_cooperative_groups.h>
#include <cstdio>
#include <cstdint>
namespace cg = cooperative_groups;

namespace pg8 {
#define PG8_LAS __attribute__((address_space(3)))
typedef unsigned short bf16_t;
typedef short bf16x8 __attribute__((ext_vector_type(8)));
typedef float f32x4 __attribute__((ext_vector_type(4)));
typedef unsigned u32x4 __attribute__((ext_vector_type(4)));
typedef unsigned u32x2 __attribute__((ext_vector_type(2)));
constexpr int BM = 256, BK = 64, HALF = 128, HTB = HALF * BK * 2  , STAGE_BYTES = 8 * HTB, NXCD = 8, WGM = 8;

__host__ __device__ __forceinline__ int lds_byte(int r, int c) { const int st = (r >> 4) * 2 + (c >> 5), rr = r & 15, cc = c & 31, ob = rr * 64 + cc * 2; return st * 1024 + (ob ^ (((ob >> 9) & 1) << 5)); }
__host__ __device__ __forceinline__ void stage_rc(int b, int& R, int& C) { const int st = b / 1024, sb = b % 1024, swz = sb ^ (((sb >> 9) & 1) << 5); R = (st >> 1) * 16 + swz / 64; C = (st & 1) * 32 + (swz % 64) / 2; }
__host__ __device__ __forceinline__ int perm32(int rho) { const int n = rho >> 4, i = rho & 15; return 8 * (i >> 2) + 4 * n + (i & 3); }

struct Unit { int pm, pn, ui; };
struct Gemm { const bf16_t* A; const bf16_t* Bt; int M, N, K; };

struct StaticOrder {
    int nM, nN, nwg, G, c;
    __host__ __device__ void init(int M, int N, int G_, int c_) { nM = M / BM; nN = N / BM; nwg = nM * nN; G = G_; c = c_; }
    __host__ __device__ bool next(int i, Unit& u) const {
        const long L = (long)i * G + c; if (L >= nwg) return false;
        int wgid = (int)L; { const int q = nwg / NXCD, r = nwg % NXCD, xcd = wgid % NXCD, off = wgid / NXCD; wgid = (xcd < r ? xcd * (q + 1) : r * (q + 1) + (xcd - r) * q) + off; }
        const int nig = WGM * nN, gid = wgid / nig, fm = gid * WGM, gsz = (nM - fm) < WGM ? (nM - fm) : WGM;
        u.pm = fm + ((wgid % nig) % gsz); u.pn = (wgid % nig) / gsz; u.ui = i; return true;
    }
    __device__ __forceinline__ void a_ready(const Unit&) const {}
    __device__ __forceinline__ void done(const Unit&) const {}
};

typedef float f32x2 __attribute__((ext_vector_type(2)));
typedef __bf16 bf16x2_t __attribute__((ext_vector_type(2)));
__device__ __forceinline__ float shx(float v, int k, int lane) { return __int_as_float(__builtin_amdgcn_ds_bpermute((lane ^ k) << 2, __float_as_int(v))); }
__device__ __forceinline__ unsigned cvt_pk_bf16(float lo, float hi) { f32x2 v = {lo, hi}; bf16x2_t b = __builtin_convertvector(v, bf16x2_t); return __builtin_bit_cast(unsigned, b); }

struct EpiResid {
    static constexpr bool PERM = true, NEEDS_PREP = false;
    bf16_t* XB; float* SS; int ldc;
    __device__ __forceinline__ void operator()(const f32x4 (&acc)[2][2][4][2], const Unit& u, int wr, int wc, int fr, int fq) const {
        const int row0 = u.pm * BM + wr * 64 + fr, col0 = u.pn * BM + wc * 32 + 8 * fq;
        u32x4 xin[2][4][2];
#pragma unroll
        for (int ai = 0; ai < 2; ++ai)
#pragma unroll
            for (int m = 0; m < 4; ++m)
#pragma unroll
                for (int bj = 0; bj < 2; ++bj) xin[ai][m][bj] = *(const u32x4*)(XB + (size_t)(row0 + ai * HALF + m * 16) * ldc + col0 + bj * HALF);
#pragma unroll
        for (int ai = 0; ai < 2; ++ai)
#pragma unroll
            for (int m = 0; m < 4; ++m) { const int row = row0 + ai * HALF + m * 16; const size_t off = (size_t)row * ldc + col0; float part = 0.f;
#pragma unroll
                for (int bj = 0; bj < 2; ++bj) { const u32x4 xi = xin[ai][m][bj]; const f32x4 a0 = acc[ai][bj][m][0], a1 = acc[ai][bj][m][1];
                    u32x4 w;
                    w.x = cvt_pk_bf16(a0[0] + __uint_as_float(xi.x << 16), a0[1] + __uint_as_float(xi.x & 0xffff0000u));
                    w.y = cvt_pk_bf16(a0[2] + __uint_as_float(xi.y << 16), a0[3] + __uint_as_float(xi.y & 0xffff0000u));
                    w.z = cvt_pk_bf16(a1[0] + __uint_as_float(xi.z << 16), a1[1] + __uint_as_float(xi.z & 0xffff0000u));
                    w.w = cvt_pk_bf16(a1[2] + __uint_as_float(xi.w << 16), a1[3] + __uint_as_float(xi.w & 0xffff0000u));
                    *(u32x4*)(XB + off + bj * HALF) = w;
#pragma unroll
                    for (int e = 0; e < 4; ++e) { const float lo = __uint_as_float(w[e] << 16), hi = __uint_as_float(w[e] & 0xffff0000u); part += lo * lo + hi * hi; } }
                part += shx(part, 16, fq * 16 + fr); part += shx(part, 32, fq * 16 + fr);
                if (fq == 0) SS[(size_t)row * 32 + u.pn * 4 + wc] = part; }
    }
};
template <int ACT> struct EpiBf16 {
    static constexpr bool PERM = true;
    static constexpr bool NEEDS_PREP = true;
    bf16_t* O; int ldc; const float* SS; float inv_k; const PG8_LAS float* rstab;
    template <class Sched> __device__ __forceinline__ void prep(const Sched& S, int tid) const {
        PG8_LAS float* tab = (PG8_LAS float*)rstab;
#pragma unroll
        for (int k = 0; k < 2; ++k) { const int ui = (tid >> 8) + 2 * k; Unit u;
            if (S.next(ui, u)) { const f32x4* sp = (const f32x4*)(SS + (size_t)(u.pm * BM + (tid & 255)) * 32); float tot = 0.f;
#pragma unroll
                for (int j = 0; j < 8; ++j) { const f32x4 a = sp[j]; tot += (a[0] + a[1]) + (a[2] + a[3]); }
                tab[ui * 256 + (tid & 255)] = rsqrtf(tot * inv_k + 1e-6f); } }
    }
    __device__ __forceinline__ void operator()(const f32x4 (&acc)[2][2][4][2], const Unit& u, int wr, int wc, int fr, int fq) const {
        const int row0 = u.pm * BM + wr * 64 + fr; const int col0 = u.pn * BM + wc * 32 + 8 * fq;
        float rsv[2][4];
#pragma unroll
        for (int ai = 0; ai < 2; ++ai)
#pragma unroll
            for (int m = 0; m < 4; ++m) rsv[ai][m] = rstab[(u.ui & 3) * 256 + wr * 64 + fr + ai * HALF + m * 16];
#pragma unroll
        for (int ai = 0; ai < 2; ++ai)
#pragma unroll
            for (int m = 0; m < 4; ++m) { const int row = row0 + ai * HALF + m * 16; bf16_t* rowp = O + (size_t)row * ldc + col0;
                const float rs = rsv[ai][m];
#pragma unroll
                for (int bj = 0; bj < 2; ++bj) { f32x4 v0 = acc[ai][bj][m][0] * rs, v1 = acc[ai][bj][m][1] * rs;
                    if (ACT == 1) {
#pragma unroll
                        for (int j = 0; j < 4; ++j) { const float a = fmaxf(v0[j], 0.f), b = fmaxf(v1[j], 0.f); v0[j] = a * a; v1[j] = b * b; } }
                    u32x4 w; w.x = cvt_pk_bf16(v0[0], v0[1]); w.y = cvt_pk_bf16(v0[2], v0[3]); w.z = cvt_pk_bf16(v1[0], v1[1]); w.w = cvt_pk_bf16(v1[2], v1[3]);
                    *(u32x4*)(rowp + bj * HALF) = w; } }
    }
};

template <class Epi, class Sched>
__device__ __forceinline__ void gemm_phase(PG8_LAS unsigned char* lds, const Gemm g, const Sched& S, const Epi& E) {
    int tid_ = threadIdx.x; asm volatile("" : "+v"(tid_));
    const int tid = tid_, wid = __builtin_amdgcn_readfirstlane(tid >> 6), lane = tid & 63, wr = wid >> 2, wc = wid & 3, fr = lane & 15, fq = lane >> 4;
    const int K = g.K, nt = K / BK;
    unsigned voffA[2], voffB[2];
#pragma unroll
    for (int i = 0; i < 2; ++i) { int R, C; stage_rc(tid * 16 + i * 8192, R, C); const int Rb = Epi::PERM ? ((R & ~31) + perm32(R & 31)) : R;
        voffA[i] = (unsigned)(R * K + C) * 2u; voffB[i] = (unsigned)(Rb * K + C) * 2u; }
    const size_t kstep = (size_t)(BK * 2);
    const size_t hstep = (size_t)HALF * K * 2;
    const size_t tstep = 2 * hstep;
    const unsigned ldsw = (unsigned)wid * 1024u;
    const int aoff = lds_byte(wr * 64 + fr, fq * 8), boff = lds_byte(wc * 32 + fr, fq * 8);
#define PG8_SA(b, h) (((b) * 2 + (h)) * HTB)
#define PG8_SB(b, h) ((4 + (b) * 2 + (h)) * HTB)
#define PG8_STAGE(bufoff, gbase, voff) do { _Pragma("unroll") for (int _i = 0; _i < 2; ++_i) \
        __builtin_amdgcn_global_load_lds((const unsigned*)((const char*)(gbase) + (voff)[_i]), (PG8_LAS unsigned*)(lds + (bufoff) + ldsw + _i * 8192), 16, 0, 0); } while (0)
#define PG8_LDA(dst, b, h) do { _Pragma("unroll") for (int m = 0; m < 4; ++m) _Pragma("unroll") for (int k = 0; k < 2; ++k) dst[m][k] = *(const PG8_LAS bf16x8*)(lds + PG8_SA(b, h) + aoff + m * 2048 + k * 1024); } while (0)
#define PG8_LDB(dst, b, h) do { _Pragma("unroll") for (int n = 0; n < 2; ++n) _Pragma("unroll") for (int k = 0; k < 2; ++k) dst[n][k] = *(const PG8_LAS bf16x8*)(lds + PG8_SB(b, h) + boff + n * 2048 + k * 1024); } while (0)
#define PG8_MMA(ai, bj, At, Bt) do { __builtin_amdgcn_s_setprio(1); _Pragma("unroll") for (int m = 0; m < 4; ++m) _Pragma("unroll") for (int n = 0; n < 2; ++n) _Pragma("unroll") for (int k = 0; k < 2; ++k) \
        acc[ai][bj][m][n] = __builtin_amdgcn_mfma_f32_16x16x32_bf16(Bt[n][k], At[m][k], acc[ai][bj][m][n], 0, 0, 0); __builtin_amdgcn_s_setprio(0); } while (0)
#define PG8_WAIT_V(n) asm volatile("s_waitcnt vmcnt(" #n ")" ::: "memory")
#define PG8_WAIT_L(n) asm volatile("s_waitcnt lgkmcnt(" #n ")" ::: "memory")
#define PG8_BAR __builtin_amdgcn_s_barrier()
#define PG8_SCHED __builtin_amdgcn_sched_barrier(0)
    Unit cur, nxt; int ui = 0;
    if (!S.next(0, cur)) return;
    f32x4 acc[2][2][4][2];
#pragma unroll
    for (int a = 0; a < 2; ++a)
#pragma unroll
        for (int b = 0; b < 2; ++b)
#pragma unroll
            for (int m = 0; m < 4; ++m)
#pragma unroll
                for (int n = 0; n < 2; ++n) acc[a][b][m][n] = (f32x4){0.f, 0.f, 0.f, 0.f};
    bf16x8 At[4][2], B0[2][2], B1[2][2];
    const char* cA = (const char*)g.A + (size_t)cur.pm * tstep; const char* cB = (const char*)g.Bt + (size_t)cur.pn * tstep;
    if constexpr (Epi::NEEDS_PREP) { E.prep(S, tid); asm volatile("s_waitcnt lgkmcnt(0)" ::: "memory"); __builtin_amdgcn_s_barrier(); }
    S.a_ready(cur);
    PG8_STAGE(PG8_SB(0, 0), cB, voffB); PG8_STAGE(PG8_SB(0, 1), cB + hstep, voffB); PG8_STAGE(PG8_SA(0, 0), cA, voffA); PG8_STAGE(PG8_SA(0, 1), cA + hstep, voffA);
    if (wr == 1) PG8_BAR;
    PG8_WAIT_V(2); PG8_BAR;
    PG8_STAGE(PG8_SB(1, 0), cB + kstep, voffB); PG8_STAGE(PG8_SA(1, 0), cA + kstep, voffA); PG8_STAGE(PG8_SB(1, 1), cB + hstep + kstep, voffB);
    PG8_WAIT_V(6); PG8_BAR;
    for (;;) {
        const bool has_next = S.next(ui + 1, nxt);
        const char* nA = has_next ? (const char*)g.A + (size_t)nxt.pm * tstep : cA; const char* nB = has_next ? (const char*)g.Bt + (size_t)nxt.pn * tstep : cB;
        for (int t = 0; t < nt; t += 2) {
            const bool last = (t == nt - 2);
            const char* a1 = cA + (size_t)(t + 1) * kstep;
            const char* a2 = last ? nA : cA + (size_t)(t + 2) * kstep; const char* b2 = last ? nB : cB + (size_t)(t + 2) * kstep;
            const char* a3 = a2 + kstep; const char* b3 = b2 + kstep;
            if (last && has_next) S.a_ready(nxt);
            PG8_LDB(B0, 0, 0); PG8_LDB(B1, 0, 1); PG8_SCHED; PG8_LDA(At, 0, 0); PG8_STAGE(PG8_SA(1, 1), a1 + hstep, voffA);
            PG8_WAIT_V(8); PG8_WAIT_L(0); PG8_BAR; PG8_MMA(0, 0, At, B0); PG8_MMA(0, 1, At, B1); PG8_BAR; PG8_SCHED;
            PG8_LDA(At, 0, 1); PG8_STAGE(PG8_SB(0, 0), b2, voffB); PG8_STAGE(PG8_SB(0, 1), b2 + hstep, voffB); PG8_STAGE(PG8_SA(0, 0), a2, voffA);
            PG8_WAIT_V(8); PG8_WAIT_L(0); PG8_BAR; PG8_MMA(1, 0, At, B0); PG8_MMA(1, 1, At, B1); PG8_BAR; PG8_SCHED;
            PG8_LDB(B0, 1, 0); PG8_LDB(B1, 1, 1); PG8_SCHED; PG8_LDA(At, 1, 0); PG8_STAGE(PG8_SA(0, 1), a2 + hstep, voffA);
            PG8_WAIT_V(8); PG8_WAIT_L(0); PG8_BAR; PG8_MMA(0, 0, At, B0); PG8_MMA(0, 1, At, B1); PG8_BAR; PG8_SCHED;
            PG8_LDA(At, 1, 1); PG8_STAGE(PG8_SB(1, 0), b3, voffB); PG8_STAGE(PG8_SB(1, 1), b3 + hstep, voffB); PG8_STAGE(PG8_SA(1, 0), a3, voffA);
            PG8_WAIT_V(8); PG8_WAIT_L(0); PG8_BAR; PG8_MMA(1, 0, At, B0); PG8_MMA(1, 1, At, B1); PG8_BAR; PG8_SCHED;
        }
        if (wr == 0) PG8_BAR;
        E(acc, cur, wr, wc, fr, fq); S.done(cur);
        if (!has_next) break;
#pragma unroll
        for (int a = 0; a < 2; ++a)
#pragma unroll
            for (int b = 0; b < 2; ++b)
#pragma unroll
                for (int m = 0; m < 4; ++m)
#pragma unroll
                    for (int n = 0; n < 2; ++n) acc[a][b][m][n] = (f32x4){0.f, 0.f, 0.f, 0.f};
        cur = nxt; cA = nA; cB = nB; ++ui;
        if (wr == 1) PG8_BAR;
    }
    PG8_WAIT_V(0);
    PG8_BAR;
#undef PG8_SA
#undef PG8_SB
#undef PG8_STAGE
#undef PG8_LDA
#undef PG8_LDB
#undef PG8_MMA
#undef PG8_WAIT_V
#undef PG8_WAIT_L
#undef PG8_BAR
#undef PG8_SCHED
}
}

constexpr int SEQ = 8192, DM = 2048, DEPTH = 4, INW = 5632, DFF = 8192;
constexpr int C_MQ = 0, C_MK = 768, C_MV = 1536, C_DQ = 2304, C_DK = 3072, C_DV = 3840, C_SU = 4608, C_SV = 5120;
constexpr int NWAVES = 8, NTHR = 512;
constexpr int LDS_BYTES = 147456;
constexpr int LDS_MISC = 139264;
constexpr float EPS = 1e-6f;

constexpr size_t WS_CTL = 0;
constexpr size_t WS_BAR = 16384;
constexpr size_t WS_ORDER = 4096;
constexpr size_t WS_WIN = 65536;
constexpr size_t WS_WOUT = WS_WIN + (size_t)DEPTH * INW * DM * 2;
constexpr size_t WS_W1 = WS_WOUT + (size_t)DEPTH * DM * DM * 2;
constexpr size_t WS_W2 = WS_W1 + (size_t)DEPTH * DFF * DM * 2;
constexpr size_t WS_XRES = WS_W2 + (size_t)DEPTH * DM * DFF * 2;
constexpr size_t WS_H = WS_XRES + (size_t)SEQ * DM * 4;
constexpr size_t WS_PROJ = WS_H + (size_t)SEQ * DM * 2;
constexpr size_t WS_VT = WS_PROJ + (size_t)SEQ * INW * 2;
constexpr size_t WS_VNT = WS_VT + (size_t)12 * 128 * SEQ * 2;
constexpr size_t WS_KM = WS_VNT + (size_t)SEQ * 512 * 2;
constexpr size_t WS_SEL = WS_KM + (size_t)6 * 32 * 128 * 4;
constexpr size_t WS_MIX = WS_SEL + (size_t)6 * SEQ * 4;
constexpr size_t WS_HID = WS_MIX + (size_t)SEQ * DM * 2;
constexpr size_t WS_SS = WS_HID + (size_t)SEQ * DFF * 2;
constexpr size_t WS_END = WS_SS + (size_t)9 * SEQ * 32 * 4;

#define LAS __attribute__((address_space(3)))
typedef unsigned short bf16;
typedef short bf16x8 __attribute__((ext_vector_type(8)));
typedef short s16x4 __attribute__((ext_vector_type(4)));
typedef float f32x4 __attribute__((ext_vector_type(4)));
typedef float f32x16 __attribute__((ext_vector_type(16)));
typedef unsigned u32x4 __attribute__((ext_vector_type(4)));
typedef unsigned u32x2 __attribute__((ext_vector_type(2)));
#define MFMA32(a, b, c) __builtin_amdgcn_mfma_f32_32x32x16_bf16((a), (b), (c), 0, 0, 0)

__device__ __forceinline__ unsigned pk2(float lo, float hi) { return pg8::cvt_pk_bf16(lo, hi); }
__device__ __forceinline__ float bf_lo(unsigned w) { return __uint_as_float(w << 16); }
__device__ __forceinline__ float bf_hi(unsigned w) { return __uint_as_float(w & 0xffff0000u); }
__device__ __forceinline__ float shx(float v, int k, int lane) { return __int_as_float(__builtin_amdgcn_ds_bpermute((lane ^ k) << 2, __float_as_int(v))); }
__device__ __forceinline__ int shxi(int v, int k, int lane) { return __builtin_amdgcn_ds_bpermute((lane ^ k) << 2, v); }
__device__ __forceinline__ float shx32(float v, int lane) { const unsigned u = __float_as_uint(v); const auto r = __builtin_amdgcn_permlane32_swap(u, u, false, false); return __uint_as_float((lane >> 5) ? r[0] : r[1]); }
__device__ __forceinline__ float wave_sum(float v, int lane) {
#pragma unroll
    for (int o = 1; o < 64; o <<= 1) v += shx(v, o, lane);
    return v;
}
__device__ __forceinline__ float gelu_t(float x) {
    const float u = 0.7978845608028654f * (x + 0.044715f * x * x * x);
    const float e = __expf(2.f * u);
    const float th = 1.f - 2.f / (e + 1.f);
    return 0.5f * x * (1.f + th);
}
__device__ __forceinline__ int tid_opaque() { int t = threadIdx.x; asm volatile("" : "+v"(t)); return t; }
__device__ __forceinline__ int crow(int reg, int h) { return (reg & 3) + 8 * (reg >> 2) + 4 * h; }

struct Params {
    const float* x; const float* attn_g; const float* w_in; const float* diff_lambda; const float* subln_g;
    const float* sgu_ln_g; const float* sgu_ln_b; const float* sgu_w; const float* sgu_b; const float* w_out;
    const float* mlp_g; const float* w1; const float* w2; const float* final_g;
    float* out; unsigned char* ws;
};

__device__ __forceinline__ void transpose_item(const float* W, int K, int N, bf16* WT, LAS float* scr, int item, int lane, const float* gk) {
    const int nblk = N / 32, kb = item / nblk, nb = item % nblk, k0 = 64 * kb, n0 = 32 * nb;
    float wv[32];
#pragma unroll
    for (int i = 0; i < 32; ++i) { const int kk = 2 * i + (lane >> 5); wv[i] = W[(size_t)(k0 + kk) * N + n0 + (lane & 31)]; }
    if (gk) {
#pragma unroll
        for (int i = 0; i < 32; ++i) wv[i] *= gk[k0 + 2 * i + (lane >> 5)];
    }
#pragma unroll
    for (int i = 0; i < 32; ++i) { const int kk = 2 * i + (lane >> 5); scr[kk * 33 + (lane & 31)] = wv[i]; }
    asm volatile("s_waitcnt lgkmcnt(0)" ::: "memory");
    const int c = lane & 7;
#pragma unroll
    for (int j = 0; j < 4; ++j) { const int n = (lane >> 3) + 8 * j; const LAS float* s = scr + (8 * c) * 33 + n;
        u32x4 o; o.x = pk2(s[0 * 33], s[1 * 33]); o.y = pk2(s[2 * 33], s[3 * 33]); o.z = pk2(s[4 * 33], s[5 * 33]); o.w = pk2(s[6 * 33], s[7 * 33]);
        *(u32x4*)(WT + (size_t)(n0 + n) * K + k0 + 8 * c) = o; }
    asm volatile("s_waitcnt lgkmcnt(0)" ::: "memory");
}

constexpr int NU_OWN = 192, NU_GAT = 456, NU_DIF = 384, NU_SGU = 256;
constexpr int U_GAT = NU_OWN, U_DIF = U_GAT + NU_GAT, U_SGU = U_DIF + NU_DIF, NU_ALL = U_SGU + NU_SGU;
constexpr size_t WS_PART = WS_XRES;
__device__ __forceinline__ void gat_decode(int v, int& n, int& C) {
    if (v < 28) { n = v >> 2; C = v & 3; }
    else if (v < 52) { const int w = v - 28; n = 7 + w / 3; C = 1 + w % 3; }
    else if (v < 68) { const int w = v - 52; n = 15 + (w >> 1); C = 2 + (w & 1); }
    else { n = 23 + (v - 68); C = 3; }
}
__device__ __forceinline__ float unit_cost(int u) {
    if (u < U_GAT) return 3.0f;
    if (u < U_DIF) { int n, C; gat_decode((u - U_GAT) % 76, n, C); const int bs = (n + 1 > 8 * C) ? n + 1 : 8 * C; float cnt = 0.f;
        for (int b = bs; b < 8 * C + 8; ++b) cnt += 256.f * (b < 3 ? (float)b : 3.f) / (float)b;
        return 4.0f * (cnt * (1.f / 256.f) + 0.5f); }
    if (u < U_SGU) return 1.7f * (float)(((u - U_DIF) & 63) + 1);
    return 0.5f;
}

__device__ __forceinline__ void phase_weights(const Params& p, LAS unsigned char* lds) {
    const int tid = tid_opaque(), lane = tid & 63, wave = tid >> 6;
    LAS float* scr = (LAS float*)(lds + wave * 16384);
    const int gw = blockIdx.x * NWAVES + wave, NGW = gridDim.x * NWAVES;
    constexpr int I_IN = (DM / 64) * (INW / 32), I_OUT = (DM / 64) * (DM / 32), I_1 = (DM / 64) * (DFF / 32), I_2 = (DFF / 64) * (DM / 32);
    constexpr int PER_LAYER = I_IN + I_OUT + I_1 + I_2;
    for (int it = gw; it < DEPTH * PER_LAYER; it += NGW) {
        const int l = it / PER_LAYER; int r = it % PER_LAYER;
        if (r < I_IN) { transpose_item(p.w_in + (size_t)l * DM * INW, DM, INW, (bf16*)(p.ws + WS_WIN) + (size_t)l * INW * DM, scr, r, lane, p.attn_g + (size_t)l * DM); continue; } r -= I_IN;
        if (r < I_OUT) { transpose_item(p.w_out + (size_t)l * DM * DM, DM, DM, (bf16*)(p.ws + WS_WOUT) + (size_t)l * DM * DM, scr, r, lane, nullptr); continue; } r -= I_OUT;
        if (r < I_1) { transpose_item(p.w1 + (size_t)l * DM * DFF, DM, DFF, (bf16*)(p.ws + WS_W1) + (size_t)l * DFF * DM, scr, r, lane, p.mlp_g + (size_t)l * DM); continue; } r -= I_1;
        transpose_item(p.w2 + (size_t)l * DFF * DM, DFF, DM, (bf16*)(p.ws + WS_W2) + (size_t)l * DM * DFF, scr, r, lane, nullptr);
    }
    if (blockIdx.x == 0) {
        unsigned* ctl = (unsigned*)(p.ws + WS_CTL);
        if (tid < 64) ctl[tid] = 0u;
        int* order = (int*)(p.ws + WS_ORDER);
        LAS float* cst = (LAS float*)(lds + 65536);
        __syncthreads();
        for (int u = tid; u < NU_ALL; u += NTHR) cst[u] = unit_cost(u);
        __syncthreads();
        for (int u = tid; u < NU_ALL; u += NTHR) {
            const float cu = cst[u]; int rank = 0;
            for (int j = 0; j < NU_ALL; ++j) { const float cj = cst[j]; rank += (cj > cu || (cj == cu && j < u)) ? 1 : 0; }
            order[rank] = u;
        }
    }
}

__device__ __forceinline__ void phase_x0(const float* X, bf16* XB, float* SS0) {
    const int tid = tid_opaque(), lane = tid & 63, wave = tid >> 6;
    const int gw = blockIdx.x * NWAVES + wave, NGW = gridDim.x * NWAVES;
    for (int m = gw; m < SEQ; m += NGW) {
        const f32x4* xr = (const f32x4*)(X + (size_t)m * DM) + lane;
        f32x4 v[8]; float s = 0.f;
#pragma unroll
        for (int j = 0; j < 8; ++j) { v[j] = xr[64 * j]; s += (v[j].x * v[j].x + v[j].y * v[j].y) + (v[j].z * v[j].z + v[j].w * v[j].w); }
        s = wave_sum(s, lane);
        if (lane < 32) SS0[(size_t)m * 32 + lane] = lane == 0 ? s : 0.f;
        u32x2* o8 = (u32x2*)(XB + (size_t)m * DM) + lane;
#pragma unroll
        for (int j = 0; j < 8; ++j) { u32x2 w; w.x = pk2(v[j].x, v[j].y); w.y = pk2(v[j].z, v[j].w); o8[64 * j] = w; }
    }
}
__device__ __forceinline__ void phase_norm_f32(const bf16* X, const float* g, const float* SS, float* O) {
    const int tid = tid_opaque(), lane = tid & 63, wave = tid >> 6;
    const int gw = blockIdx.x * NWAVES + wave, NGW = gridDim.x * NWAVES;
    for (int m = gw; m < SEQ; m += NGW) {
        const u32x4* xr = (const u32x4*)(X + (size_t)m * DM) + lane;
        const float rs = rsqrtf(wave_sum(lane < 32 ? SS[(size_t)m * 32 + lane] : 0.f, lane) * (1.f / DM) + EPS);
        f32x4* o = (f32x4*)(O + (size_t)m * DM) + 2 * lane;
#pragma unroll
        for (int j = 0; j < 4; ++j) { const u32x4 xv = xr[64 * j]; const f32x4 g0 = ((const f32x4*)g)[2 * lane + 128 * j], g1 = ((const f32x4*)g)[2 * lane + 128 * j + 1];
            o[128 * j] = (f32x4){bf_lo(xv.x), bf_hi(xv.x), bf_lo(xv.y), bf_hi(xv.y)} * rs * g0;
            o[128 * j + 1] = (f32x4){bf_lo(xv.z), bf_hi(xv.z), bf_lo(xv.w), bf_hi(xv.w)} * rs * g1; }
    }
}

constexpr int TP_STRIDE = 132;
__device__ __forceinline__ void post_unit(const Params& p, int layer, int unit, LAS unsigned char* lds) {
    const int tid = tid_opaque();
    const int rb = unit / 40, cbi = unit % 40, cb = cbi < 36 ? cbi : cbi + 4;
    const int col0 = cb * 128;
    const int r64 = tid >> 3, j = tid & 7;
    bf16* proj = (bf16*)(p.ws + WS_PROJ);
    int type;
    int hh = 0;
    if (cb < 6) type = 0; else if (cb < 12) type = 1; else if (cb < 18) { type = 2; hh = cb - 12; } else if (cb < 30) type = 3; else if (cb < 36) { type = 2; hh = 6 + cb - 30; } else { type = 4; hh = cb - 40; }
    int c0, c1;
    if (type <= 1) { c0 = 8 * j; c1 = c0 + 64; }
    else if (type == 3) { c0 = (j < 4) ? 8 * j : 64 + 8 * (j - 4); c1 = c0 + 32; }
    else { c0 = 16 * j; c1 = c0 + 8; }
    double inv2pi[8];
    if (type <= 1 || type == 3) {
        const float half = (type == 3) ? 32.f : 64.f; const int i0 = (type == 3) ? 8 * (j & 3) : 8 * j;
#pragma unroll
        for (int e = 0; e < 8; ++e) inv2pi[e] = (double)exp2f(-(float)(i0 + e) * (13.287712379549449f / half)) * 0.15915494309189535;
    } else {
#pragma unroll
        for (int e = 0; e < 8; ++e) inv2pi[e] = 0.0;
    }
    float csa[8], csb[8];
#pragma unroll
    for (int e = 0; e < 8; ++e) { csa[e] = 0.f; csb[e] = 0.f; }
    LAS bf16* tile = (LAS bf16*)lds;
    u32x4 na = *(const u32x4*)(proj + (size_t)(rb * 256 + r64) * INW + col0 + c0), nb = *(const u32x4*)(proj + (size_t)(rb * 256 + r64) * INW + col0 + c1);
    for (int sub = 0; sub < 4; ++sub) {
        const int row = rb * 256 + sub * 64 + r64;
        bf16* rp = proj + (size_t)row * INW + col0;
        const u32x4 ua = na, ub = nb;
        if (sub < 3) { na = *(const u32x4*)(rp + (size_t)64 * INW + c0); nb = *(const u32x4*)(rp + (size_t)64 * INW + c1); }
        float xa[8], xb[8];
#pragma unroll
        for (int e = 0; e < 4; ++e) { xa[2 * e] = bf_lo(ua[e]); xa[2 * e + 1] = bf_hi(ua[e]); xb[2 * e] = bf_lo(ub[e]); xb[2 * e + 1] = bf_hi(ub[e]); }
        if (type <= 1 || type == 3) {
            float ya[8], yb[8];
#pragma unroll
            for (int e = 0; e < 8; ++e) {
                double rev = (double)row * inv2pi[e]; rev -= floor(rev);
                const float fr = (float)rev;
                const float sn = __builtin_amdgcn_sinf(fr), cs = __builtin_amdgcn_cosf(fr);
                ya[e] = xa[e] * cs - xb[e] * sn; yb[e] = xb[e] * cs + xa[e] * sn;
                csa[e] += ya[e]; csb[e] += yb[e];
            }
            u32x4 oa, ob;
#pragma unroll
            for (int e = 0; e < 4; ++e) { oa[e] = pk2(ya[2 * e], ya[2 * e + 1]); ob[e] = pk2(yb[2 * e], yb[2 * e + 1]); }
            *(u32x4*)(rp + c0) = oa; *(u32x4*)(rp + c1) = ob;
        } else {
            u32x4 oa = ua, ob = ub;
            if (type == 4) {
                float s = 0.f;
#pragma unroll
                for (int e = 0; e < 8; ++e) { xa[e] = gelu_t(xa[e]); xb[e] = gelu_t(xb[e]); s += xa[e] + xb[e]; }
                s += shx(s, 1, tid & 63); s += shx(s, 2, tid & 63); s += shx(s, 4, tid & 63);
                const float mu = s * (1.f / 128.f); float s2 = 0.f;
#pragma unroll
                for (int e = 0; e < 8; ++e) { xa[e] -= mu; xb[e] -= mu; s2 += xa[e] * xa[e] + xb[e] * xb[e]; }
                s2 += shx(s2, 1, tid & 63); s2 += shx(s2, 2, tid & 63); s2 += shx(s2, 4, tid & 63);
                const float rstd = rsqrtf(s2 * (1.f / 128.f) + EPS);
                const float* lg = p.sgu_ln_g + ((size_t)layer * 4 + hh) * 128; const float* lb = p.sgu_ln_b + ((size_t)layer * 4 + hh) * 128;
#pragma unroll
                for (int e = 0; e < 8; ++e) { xa[e] = xa[e] * rstd * lg[c0 + e] + lb[c0 + e]; xb[e] = xb[e] * rstd * lg[c1 + e] + lb[c1 + e]; }
#pragma unroll
                for (int e = 0; e < 4; ++e) { oa[e] = pk2(xa[2 * e], xa[2 * e + 1]); ob[e] = pk2(xb[2 * e], xb[2 * e + 1]); }
            }
            __syncthreads();
            LAS u32x2* t0 = (LAS u32x2*)(tile + r64 * TP_STRIDE + c0);
            t0[0] = (u32x2){oa.x, oa.y}; t0[1] = (u32x2){oa.z, oa.w}; t0[2] = (u32x2){ob.x, ob.y}; t0[3] = (u32x2){ob.z, ob.w};
            __syncthreads();
            const int dv = tid >> 2, ch = tid & 3;
            unsigned w[8];
#pragma unroll
            for (int k = 0; k < 8; ++k) { const unsigned lo = tile[(16 * ch + 2 * k) * TP_STRIDE + dv], hi = tile[(16 * ch + 2 * k + 1) * TP_STRIDE + dv]; w[k] = lo | (hi << 16); }
            bf16* dst;
            if (type == 2) dst = (bf16*)(p.ws + WS_VT) + ((size_t)hh * 128 + dv) * SEQ + rb * 256 + sub * 64 + 16 * ch;
            else dst = (bf16*)(p.ws + WS_VNT) + ((size_t)((rb * 2 + (sub >> 1)) * 4 + hh) * 128 + dv) * 128 + (sub & 1) * 64 + 16 * ch;
            if (type == 2) { *(u32x4*)dst = (u32x4){w[0], w[1], w[4], w[5]}; *(u32x4*)(dst + 8) = (u32x4){w[2], w[3], w[6], w[7]}; }
            else { *(u32x4*)dst = (u32x4){w[0], w[1], w[2], w[3]}; *(u32x4*)(dst + 8) = (u32x4){w[4], w[5], w[6], w[7]}; }
        }
    }
    if (type == 1) {
        __syncthreads();
        LAS float* red = (LAS float*)lds;
#pragma unroll
        for (int e = 0; e < 8; ++e) { red[r64 * 128 + c0 + e] = csa[e]; red[r64 * 128 + c1 + e] = csb[e]; }
        __syncthreads();
        if (tid < 128) { float s = 0.f; for (int r = 0; r < 64; ++r) s += red[r * 128 + tid];
            ((float*)(p.ws + WS_KM))[((size_t)(cb - 6) * 32 + rb) * 128 + tid] = s * (1.f / 256.f); }
    }
    __syncthreads();
}

__device__ __forceinline__ void sgu_item(const Params& p, int layer, int item) {
    const int tid = tid_opaque(), lane = tid & 63, wave = tid >> 6, r = lane & 31, h = lane >> 5;
    const int nc = item >> 2, g = item & 3;
    const int tb = wave >> 1;
    const float* W = p.sgu_w + ((size_t)layer * 4 + g) * 128 * 128;
    const bf16* vnt = (const bf16*)(p.ws + WS_VNT) + (size_t)(nc * 4 + g) * 128 * 128;
    const bf16* proj = (const bf16*)(p.ws + WS_PROJ);
    bf16* mix = (bf16*)(p.ws + WS_MIX);
    const int t = 32 * tb + r;
    f32x4 wl[8][2];
#pragma unroll
    for (int ks = 0; ks < 8; ++ks) { const int s0 = 16 * ks + 8 * h; wl[ks][0] = *(const f32x4*)(W + t * 128 + s0); wl[ks][1] = *(const f32x4*)(W + t * 128 + s0 + 4); }
    bf16x8 bfr[2][8];
#pragma unroll
    for (int cc = 0; cc < 2; ++cc)
#pragma unroll
        for (int ks = 0; ks < 8; ++ks) bfr[cc][ks] = *(const bf16x8*)(vnt + (size_t)(32 * ((wave & 1) * 2 + cc) + r) * 128 + 16 * ks + 8 * h);
    bf16x8 af[8];
#pragma unroll
    for (int ks = 0; ks < 8; ++ks) { const int s0 = 16 * ks + 8 * h;
        float wv[8] = {wl[ks][0].x, wl[ks][0].y, wl[ks][0].z, wl[ks][0].w, wl[ks][1].x, wl[ks][1].y, wl[ks][1].z, wl[ks][1].w};
#pragma unroll
        for (int e = 0; e < 8; ++e) wv[e] = (s0 + e <= t) ? wv[e] : 0.f;
        u32x4 au; au.x = pk2(wv[0], wv[1]); au.y = pk2(wv[2], wv[3]); au.z = pk2(wv[4], wv[5]); au.w = pk2(wv[6], wv[7]);
        af[ks] = __builtin_bit_cast(bf16x8, au); }
#pragma unroll
    for (int cc = 0; cc < 2; ++cc) {
        const int cbk = (wave & 1) * 2 + cc;
        const int c = 32 * cbk + r;
        unsigned short ur[16]; float br[16];
#pragma unroll
        for (int i = 0; i < 16; ++i) { const int tt = 32 * tb + crow(i, h); ur[i] = proj[((size_t)nc * 128 + tt) * INW + C_SU + g * 128 + c]; br[i] = p.sgu_b[((size_t)layer * 4 + g) * 128 + tt]; }
        f32x16 acc;
#pragma unroll
        for (int i = 0; i < 16; ++i) acc[i] = 0.f;
#pragma unroll
        for (int ks = 0; ks < 8; ++ks) acc = MFMA32(af[ks], bfr[cc][ks], acc);
#pragma unroll
        for (int i = 0; i < 16; ++i) {
            const int tt = 32 * tb + crow(i, h);
            const size_t tok = (size_t)nc * 128 + tt;
            const float u = gelu_t(__uint_as_float(((unsigned)ur[i]) << 16));
            const float o = u * (acc[i] + br[i]);
            mix[tok * DM + 1536 + g * 128 + c] = (bf16)(pk2(o, 0.f) & 0xffffu);
        }
    }
}

constexpr int KT_BYTES = 16384, VT_BYTES = 16384;
constexpr int ABUF = KT_BYTES + VT_BYTES;
constexpr float LOG2E = 1.4426950408889634f;

__device__ __forceinline__ void tile_dma(LAS unsigned char* slot, const bf16* proj, const bf16* vt, int kcol, int hh, int kbase, int wave, int lane) {
#pragma unroll
    for (int i = 0; i < 2; ++i) { const int c = i * 8 + wave, row = 4 * c + (lane >> 4), g = (lane & 15) ^ (row & 15);
        __builtin_amdgcn_global_load_lds((const unsigned*)(proj + (size_t)(kbase + row) * INW + kcol + g * 8), (LAS unsigned*)(slot + c * 1024), 16, 0, 0); }
#pragma unroll
    for (int i = 0; i < 2; ++i) { const int c = i * 8 + wave, row = 8 * c + (lane >> 3), g = (lane & 7) ^ ((row >> 1) & 7);
        __builtin_amdgcn_global_load_lds((const unsigned*)(vt + ((size_t)hh * 128 + row) * SEQ + kbase + g * 8), (LAS unsigned*)(slot + KT_BYTES + c * 1024), 16, 0, 0); }
}

#define TOP3_INSERT(v, n) do { if ((v) > v0 || ((v) == v0 && (n) < i0)) { v2 = v1; i2 = i1; v1 = v0; i1 = i0; v0 = (v); i0 = (n); } \
    else if ((v) > v1 || ((v) == v1 && (n) < i1)) { v2 = v1; i2 = i1; v1 = (v); i1 = (n); } \
    else if ((v) > v2 || ((v) == v2 && (n) < i2)) { v2 = (v); i2 = (n); } } while (0)
__device__ __forceinline__ unsigned moba_gate(const Params& p, int h, int own, const bf16x8 (&qf)[8], int lane) {
    const int r = lane & 31, hf = lane >> 5;
    unsigned selmask = 0u;
    if (own > 0) {
        f32x16 gt;
#pragma unroll
        for (int i = 0; i < 16; ++i) gt[i] = 0.f;
        const float* kmg = (const float*)(p.ws + WS_KM) + ((size_t)h * 32 + r) * 128 + 8 * hf;
#pragma unroll
        for (int ks = 0; ks < 8; ++ks) {
            const f32x4 a0 = *(const f32x4*)(kmg + 16 * ks), a1 = *(const f32x4*)(kmg + 16 * ks + 4);
            u32x4 hi; hi.x = pk2(a0.x, a0.y); hi.y = pk2(a0.z, a0.w); hi.z = pk2(a1.x, a1.y); hi.w = pk2(a1.z, a1.w);
            u32x4 lo; lo.x = pk2(a0.x - bf_lo(hi.x), a0.y - bf_hi(hi.x)); lo.y = pk2(a0.z - bf_lo(hi.y), a0.w - bf_hi(hi.y));
            lo.z = pk2(a1.x - bf_lo(hi.z), a1.y - bf_hi(hi.z)); lo.w = pk2(a1.z - bf_lo(hi.w), a1.w - bf_hi(hi.w));
            gt = MFMA32(__builtin_bit_cast(bf16x8, hi), qf[ks], gt);
            gt = MFMA32(__builtin_bit_cast(bf16x8, lo), qf[ks], gt);
        }
        float v0 = -INFINITY, v1 = -INFINITY, v2 = -INFINITY; int i0 = 64, i1 = 64, i2 = 64;
#pragma unroll
        for (int i = 0; i < 16; ++i) { const int n = crow(i, hf); if (n < own) TOP3_INSERT(gt[i], n); }
        const float pv0 = shx(v0, 32, lane), pv1 = shx(v1, 32, lane), pv2 = shx(v2, 32, lane);
        const int pi0 = shxi(i0, 32, lane), pi1 = shxi(i1, 32, lane), pi2 = shxi(i2, 32, lane);
        if (pi0 < 64) TOP3_INSERT(pv0, pi0);
        if (pi1 < 64) TOP3_INSERT(pv1, pi1);
        if (pi2 < 64) TOP3_INSERT(pv2, pi2);
        if (i0 < 64) selmask |= 1u << i0;
        if (i1 < 64) selmask |= 1u << i1;
        if (i2 < 64) selmask |= 1u << i2;
    }
    return selmask;
}
__device__ __forceinline__ void sel_item(const Params& p, int item) {
    const int tid = tid_opaque(), lane = tid & 63, wave = tid >> 6, r = lane & 31, hf = lane >> 5;
    const int h = item >> 5, qb = item & 31, q = qb * 256 + 32 * wave + r;
    const bf16* proj = (const bf16*)(p.ws + WS_PROJ);
    bf16x8 qf[8];
#pragma unroll
    for (int ks = 0; ks < 8; ++ks) qf[ks] = *(const bf16x8*)(proj + (size_t)q * INW + C_MQ + h * 128 + 16 * ks + 8 * hf);
    const unsigned mask = moba_gate(p, h, qb, qf, lane);
    if (hf == 0) ((unsigned*)(p.ws + WS_SEL))[(size_t)h * SEQ + q] = mask;
}
template <int MODE>
__device__ __forceinline__ void attn_unit(const Params& p, int layer, int h, int qb, LAS unsigned char* lds, int gq, bool gactive, int gj, int gtile0) {
    constexpr int NKS = MODE == 1 ? 4 : 8;
    const int tid = tid_opaque(), lane = tid & 63, wave = __builtin_amdgcn_readfirstlane(tid >> 6), r = lane & 31, hf = lane >> 5;
    const int grp = wave >> 2;
    const bf16* proj = (const bf16*)(p.ws + WS_PROJ);
    const bf16* vt = (const bf16*)(p.ws + WS_VT);
    bf16* mix = (bf16*)(p.ws + WS_MIX);
    int wrow0, ntiles, qcol, kcol, kc0, hh, tile0; float scale;
    if (MODE != 1) { wrow0 = MODE == 0 ? qb * 256 + 32 * wave : (1 << 20); tile0 = MODE == 0 ? 4 * qb : gtile0; ntiles = 4; qcol = C_MQ + h * 128; kcol = C_MK + h * 128; kc0 = 0; hh = h; scale = 0.08838834764831845f * LOG2E; }
    else { tile0 = 0; wrow0 = qb * 128 + 32 * (wave & 3); ntiles = 2 * (qb + 1); qcol = C_DQ + h * 128 + grp * 64; kcol = C_DK + h * 128; kc0 = grp * 64; hh = 6 + h; scale = 0.125f * LOG2E; }
    const LAS unsigned short* glist = (const LAS unsigned short*)(lds + 102400);
    int q;
    if (MODE == 2) { const int idx = gq + 32 * wave + r; q = glist[idx < gj ? idx : 0]; } else q = wrow0 + r;
    bf16x8 qf[NKS];
#pragma unroll
    for (int ks = 0; ks < NKS; ++ks) qf[ks] = *(const bf16x8*)(proj + (size_t)q * INW + qcol + 16 * ks + 8 * hf);
    f32x16 o[4];
#pragma unroll
    for (int d = 0; d < 4; ++d)
#pragma unroll
        for (int i = 0; i < 16; ++i) o[d][i] = 0.f;
    float m = -1e30f, l = 0.f;
    bf16x8 pf[4];
#pragma unroll
    for (int k = 0; k < 4; ++k) pf[k] = (bf16x8){0, 0, 0, 0, 0, 0, 0, 0};
    bool prev_on = false;
    tile_dma(lds, proj, vt, kcol, hh, tile0 * 64, wave, lane);
    const unsigned ck = (unsigned)(r * 256 + 16 * ((r & 15) ^ hf));
    const unsigned cv = (unsigned)(KT_BYTES + r * 128 + 16 * (((r >> 1) & 7) ^ hf));
    asm volatile("s_waitcnt vmcnt(0)" ::: "memory");
    __syncthreads();
#define ATTN_BACK(vbuf) do { _Pragma("unroll") for (int k4 = 0; k4 < 4; ++k4) { bf16x8 vf_[4]; \
        _Pragma("unroll") for (int d = 0; d < 4; ++d) { \
            const unsigned x_ = ((vbuf) + cv) ^ (unsigned)(32 * k4); \
            vf_[d] = *(const LAS bf16x8*)(lds + x_ + 4096 * d); } \
        __builtin_amdgcn_sched_barrier(0); \
        _Pragma("unroll") for (int d = 0; d < 4; ++d) o[d] = MFMA32(vf_[d], pf[k4], o[d]); \
        __builtin_amdgcn_sched_barrier(0); } } while (0)
    const bool defer = (MODE == 1) && (grp == 1);
    int slot = 0;
    for (int t = 0; t < ntiles; ++t) {
        const int kbase = (tile0 + t) * 64;
        const unsigned buf = (unsigned)(slot * ABUF);
        const unsigned bufp = (unsigned)((slot == 0 ? 2 : slot - 1) * ABUF);
        const int nslot = slot == 2 ? 0 : slot + 1;
        if (t + 1 < ntiles) tile_dma(lds + nslot * ABUF, proj, vt, kcol, hh, kbase + 64, wave, lane);
        if (defer && prev_on) ATTN_BACK(bufp);
        const bool lane_on = true;
        const bool wave_on = (MODE == 2) || (kbase <= wrow0 + 31);
        if (wave_on) {
            f32x16 s[2];
#pragma unroll
            for (int b = 0; b < 2; ++b) {
#pragma unroll
                for (int i = 0; i < 16; ++i) s[b][i] = 0.f;
#pragma unroll
                for (int k0 = 0; k0 < NKS; k0 += 4) {
                    bf16x8 kf[4];
#pragma unroll
                    for (int ks = 0; ks < 4; ++ks) kf[ks] = *(const LAS bf16x8*)(lds + ((buf + 8192u * b + ck) ^ (unsigned)(2 * kc0 + 32 * (k0 + ks))));
                    __builtin_amdgcn_sched_barrier(0);
#pragma unroll
                    for (int ks = 0; ks < 4; ++ks) s[b] = MFMA32(kf[ks], qf[k0 + ks], s[b]);
                    __builtin_amdgcn_sched_barrier(0);
                }
            }
            const bool diag = (MODE != 2) && (kbase + 63 > wrow0);
            float mx = -INFINITY;
            bool lane_off = false;
            if (diag) {
                asm volatile("" ::: "memory");
#pragma unroll
                for (int b = 0; b < 2; ++b)
#pragma unroll
                    for (int i = 0; i < 16; ++i) {
                        const int key = kbase + 32 * b + crow(i, hf);
                        const bool ok = lane_on && (key <= q);
                        s[b][i] = ok ? s[b][i] : -INFINITY;
                        mx = fmaxf(mx, s[b][i]);
                    }
            } else {
#pragma unroll
                for (int b = 0; b < 2; ++b)
#pragma unroll
                    for (int i = 0; i < 16; ++i) mx = fmaxf(mx, s[b][i]);
            }
            mx = fmaxf(mx, shx32(mx, lane));
            const float mn = fmaxf(m, mx);
            const float alpha = __builtin_amdgcn_exp2f((m - mn) * scale);
            const float mns = lane_off ? INFINITY : mn * scale;
            float ls = 0.f;
#pragma unroll
            for (int b = 0; b < 2; ++b)
#pragma unroll
                for (int i = 0; i < 16; ++i) { const float pv = __builtin_amdgcn_exp2f(s[b][i] * scale - mns); s[b][i] = pv; ls += pv; }
            l = l * alpha + ls;
            __builtin_amdgcn_sched_barrier(0);
            if (__builtin_amdgcn_ballot_w64(mn != m) != 0ull) {
#pragma unroll
                for (int d = 0; d < 4; ++d)
#pragma unroll
                    for (int i = 0; i < 16; ++i) o[d][i] *= alpha;
            }
            m = mn;
#pragma unroll
            for (int b = 0; b < 2; ++b)
#pragma unroll
                for (int ss = 0; ss < 2; ++ss) {
                    u32x4 pu;
                    pu.x = pk2(s[b][8 * ss + 0], s[b][8 * ss + 1]); pu.y = pk2(s[b][8 * ss + 2], s[b][8 * ss + 3]);
                    pu.z = pk2(s[b][8 * ss + 4], s[b][8 * ss + 5]); pu.w = pk2(s[b][8 * ss + 6], s[b][8 * ss + 7]);
                    pf[2 * b + ss] = __builtin_bit_cast(bf16x8, pu);
                }
            if (!defer) ATTN_BACK(buf);
        }
        prev_on = wave_on;
        slot = nslot;
        asm volatile("s_waitcnt vmcnt(0)" ::: "memory");
        __syncthreads();
    }
    if (defer && prev_on) { const unsigned bufp = (unsigned)((slot == 0 ? 2 : slot - 1) * ABUF); ATTN_BACK(bufp); }
#undef ATTN_BACK
    const float lt = l + shx(l, 32, lane);
    const float inv = 1.f / lt;
    if (MODE != 1) {
        int q2 = q, jj = 3; bool act = true;
        if (MODE == 2) {
            const int t2 = tid_opaque(), idx = gq + 32 * (t2 >> 6) + (t2 & 31); act = idx < gj; q2 = glist[act ? idx : 0];
            jj = __builtin_popcount(((const unsigned*)(p.ws + WS_SEL))[(size_t)h * SEQ + q2] & ((1u << (gtile0 >> 2)) - 1u)); }
        if (act) {
            unsigned* rec = (unsigned*)(p.ws + WS_PART) + (((size_t)h * SEQ + q2) * 4 + jj) * 68;
            if (hf == 0) { rec[0] = __float_as_uint(m * scale); rec[1] = __float_as_uint(lt); }
#pragma unroll
            for (int d = 0; d < 4; ++d)
#pragma unroll
                for (int g4 = 0; g4 < 4; ++g4) {
                    u32x2 w; w.x = pk2(o[d][4 * g4] * inv, o[d][4 * g4 + 1] * inv); w.y = pk2(o[d][4 * g4 + 2] * inv, o[d][4 * g4 + 3] * inv);
                    *(u32x2*)(rec + 4 + 16 * d + 4 * g4 + 2 * hf) = w;
                }
        }
    } else {
        __syncthreads();
        LAS float* ex = (LAS float*)lds;
        const int wi = wave & 3;
        if (wave >= 4) {
#pragma unroll
            for (int d = 0; d < 4; ++d)
#pragma unroll
                for (int i = 0; i < 16; ++i) ex[(wi * 64 + d * 16 + i) * 64 + lane] = o[d][i] * inv;
        }
        __syncthreads();
        if (wave < 4) {
            int ly = layer; asm volatile("" : "+s"(ly));
            float c08 = 0.8f, c06 = 0.6f; asm volatile("" : "+s"(c08), "+s"(c06));
            const float lin = c08 - c06 * __expf(-0.3f * (float)ly);
            const float* lp = p.diff_lambda + (size_t)ly * 256;
            const float la = wave_sum(lp[lane] * lp[64 + lane], lane), lb = wave_sum(lp[128 + lane] * lp[192 + lane], lane);
            const float lamv = __expf(la) - __expf(lb) + lin, oml = 1.f - lin;
            float ss = 0.f;
#pragma unroll
            for (int d = 0; d < 4; ++d) {
#pragma unroll
                for (int i = 0; i < 16; ++i) { const float v = o[d][i] * inv - lamv * ex[(wi * 64 + d * 16 + i) * 64 + lane]; o[d][i] = v; ss += v * v; }
                __builtin_amdgcn_sched_barrier(0);
            }
            ss += shx(ss, 32, lane);
            const float rs = rsqrtf(ss * (1.f / 128.f) + EPS) * oml;
            const float* sg = p.subln_g + (size_t)layer * 128;
#pragma unroll
            for (int d = 0; d < 4; ++d)
#pragma unroll
                for (int g4 = 0; g4 < 4; ++g4) {
                    const int dv = 32 * d + 8 * g4 + 4 * hf;
                    const f32x4 gg = *(const f32x4*)(sg + dv);
                    u32x2 w; w.x = pk2(o[d][4 * g4] * rs * gg.x, o[d][4 * g4 + 1] * rs * gg.y); w.y = pk2(o[d][4 * g4 + 2] * rs * gg.z, o[d][4 * g4 + 3] * rs * gg.w);
                    *(u32x2*)(mix + (size_t)q * DM + 768 + h * 128 + dv) = w;
                }
        }
        __syncthreads();
    }
}

__device__ __forceinline__ void gathered_unit(const Params& p, int layer, int h, int v, LAS unsigned char* lds) {
    const int tid = tid_opaque(), lane = tid & 63, wave = tid >> 6, r = lane & 31;
    int n, C; gat_decode(v, n, C);
    const int bs = (n + 1 > 8 * C) ? n + 1 : 8 * C, q0 = bs * 256, q1 = (8 * C + 8) * 256;
    LAS unsigned short* list = (LAS unsigned short*)(lds + 102400);
    LAS int* cnt = (LAS int*)(lds + LDS_MISC + 12);
    const unsigned* sel = (const unsigned*)(p.ws + WS_SEL) + (size_t)h * SEQ;
    if (tid == 0) *cnt = 0;
    __syncthreads();
    for (int q = q0 + tid; q < q1; q += NTHR)
        if ((sel[q] >> n) & 1u) { const int s = __hip_atomic_fetch_add(cnt, 1, __ATOMIC_RELAXED, __HIP_MEMORY_SCOPE_WORKGROUP); list[s] = (unsigned short)q; }
    __syncthreads();
    const int count = *(volatile LAS int*)cnt;
    for (int g0 = 0; g0 < count; g0 += 256) {
        attn_unit<2>(p, layer, h, 0, lds, g0, true, count, 4 * n);
        __syncthreads();
    }
}
__device__ __forceinline__ void phase_attn(const Params& p, int layer, LAS unsigned char* lds) {
    const int tid = tid_opaque();
    volatile LAS int* misc = (volatile LAS int*)(lds + LDS_MISC);
    unsigned* ctr = (unsigned*)(p.ws + WS_CTL) + layer;
    const int* order = (const int*)(p.ws + WS_ORDER);
    for (;;) {
        if (tid == 0) misc[0] = (int)atomicAdd(ctr, 1u);
        __syncthreads();
        const int idx = misc[0];
        __syncthreads();
        if (idx >= NU_ALL) break;
        const int u = order[idx];
        if (u < U_GAT) attn_unit<0>(p, layer, u >> 5, u & 31, lds, 0, true, 3, 0);
        else if (u < U_DIF) gathered_unit(p, layer, (u - U_GAT) / 76, (u - U_GAT) % 76, lds);
        else if (u < U_SGU) { const int w = u - U_DIF; attn_unit<1>(p, layer, w >> 6, w & 63, lds, 0, true, 0, 0); }
        else sgu_item(p, layer, u - U_SGU);
    }
}
__device__ __forceinline__ void phase_merge(const Params& p) {
    const int tid = tid_opaque(), lane = tid & 63, wave = tid >> 6;
    const int gw = blockIdx.x * NWAVES + wave, NGW = gridDim.x * NWAVES;
    bf16* mix = (bf16*)(p.ws + WS_MIX);
    for (int it = gw; it < 6 * SEQ; it += NGW) {
        const int h = it / SEQ, q = it % SEQ, cnt = (q >> 8) < 3 ? (q >> 8) : 3;
        const unsigned* rec = (const unsigned*)(p.ws + WS_PART) + ((size_t)h * SEQ + q) * 4 * 68;
        float mj[4], lj[4]; unsigned ow[4];
#pragma unroll
        for (int j = 0; j < 4; ++j) { const bool ok = (j == 3) || (j < cnt);
            mj[j] = ok ? __uint_as_float(rec[j * 68]) : -INFINITY; lj[j] = ok ? __uint_as_float(rec[j * 68 + 1]) : 0.f; ow[j] = ok ? rec[j * 68 + 4 + lane] : 0u; }
        const float M = fmaxf(fmaxf(mj[0], mj[1]), fmaxf(mj[2], mj[3]));
        float W = 0.f, a0 = 0.f, a1 = 0.f;
#pragma unroll
        for (int j = 0; j < 4; ++j) { const float w = lj[j] * __builtin_amdgcn_exp2f(mj[j] - M); W += w; a0 += w * bf_lo(ow[j]); a1 += w * bf_hi(ow[j]); }
        const float iw = 1.f / W;
        ((unsigned*)(mix + (size_t)q * DM + h * 128))[lane] = pk2(a0 * iw, a1 * iw);
    }
}

#define XB_TMO      128
#define XB_XCNT(j)  (256  + 64 * (j))
#define XB_XSUB(j)  (1280 + 64 * (j))
#define XB_XGEN(j)  (2304 + 64 * (j))
#define XB_TOP      3328
#define XB_TOPGEN   3392
#define XCD_BAR_WORDS 3456
#define XB_SPIN_CAP (1u << 18)

__device__ __forceinline__ unsigned xb_ld(unsigned* p)              { return __hip_atomic_load(p, __ATOMIC_RELAXED, __HIP_MEMORY_SCOPE_AGENT); }
__device__ __forceinline__ unsigned xb_add(unsigned* p, unsigned v) { return __hip_atomic_fetch_add(p, v, __ATOMIC_RELAXED, __HIP_MEMORY_SCOPE_AGENT); }
__device__ __forceinline__ unsigned xb_xcc_id() { return (unsigned)__builtin_amdgcn_s_getreg((3 << 11) | 20) & 0xFu; }
#define XB_SPIN(cond, bar) do { unsigned _sp = 0; while (cond) { __builtin_amdgcn_s_sleep(1); \
    if ((++_sp & 255u) == 0u) { if (xb_ld(&(bar)[XB_TMO])) break; if (_sp > XB_SPIN_CAP) { atomicAdd(&(bar)[XB_TMO], 1u); break; } } } } while (0)

struct XcdBarrier {
    unsigned* bar; unsigned x;
    volatile LAS unsigned* st;
};

__device__ __forceinline__ XcdBarrier xcd_barrier_post(unsigned* bar, volatile LAS unsigned* st) {
    XcdBarrier b; b.bar = bar; b.x = xb_xcc_id(); b.st = st;
    if (threadIdx.x == 0) (void)xb_add(&bar[XB_XCNT(b.x)], 1u);
    return b;
}
__device__ __forceinline__ void xcd_barrier_complete(unsigned* bar, unsigned x, unsigned& nloc, unsigned& nx) {
    const unsigned G = gridDim.x * gridDim.y * gridDim.z;
    unsigned sum, cnt, mine, sp = 0u;
    for (;;) {
        sum = 0u; cnt = 0u; mine = 0u;
#pragma unroll
        for (unsigned j = 0; j < 16; ++j) { const unsigned c = xb_ld(&bar[XB_XCNT(j)]); sum += c; cnt += (c > 0u) ? 1u : 0u; mine = (j == x) ? c : mine; }
        if (sum == G) break;
        __builtin_amdgcn_s_sleep(1);
        if ((++sp & 255u) == 0u) { if (xb_ld(&bar[XB_TMO])) break; if (sp > XB_SPIN_CAP) { atomicAdd(&bar[XB_TMO], 1u); break; } }
    }
    nloc = mine > 0u ? mine : 1u; nx = cnt > 0u ? cnt : 1u;
}

__device__ __forceinline__ void xcd_barrier(const XcdBarrier& b) {
    asm volatile("s_waitcnt vmcnt(0)" ::: "memory");
    __syncthreads();
    if (threadIdx.x == 0) {
        unsigned* bar = b.bar;
        __builtin_amdgcn_s_waitcnt(0);
        unsigned nloc = b.st[0], nx = b.st[1];
        if (nloc == 0u) { xcd_barrier_complete(bar, b.x, nloc, nx); b.st[0] = nloc; b.st[1] = nx; }
        const unsigned old = xb_add(&bar[XB_XSUB(b.x)], 1u);
        const unsigned gen = old / nloc;
        if (old + 1u == (gen + 1u) * nloc) {
            __builtin_amdgcn_fence(__ATOMIC_RELEASE, "agent");
            asm volatile("s_waitcnt vmcnt(0)" ::: "memory");
            const unsigned og = xb_add(&bar[XB_TOP], 1u);
            const unsigned tg = og / nx;
            if (og + 1u == (tg + 1u) * nx) xb_add(&bar[XB_TOPGEN], 1u);
            else XB_SPIN(xb_ld(&bar[XB_TOPGEN]) == tg, bar);
            __builtin_amdgcn_fence(__ATOMIC_ACQUIRE, "agent");
            xb_add(&bar[XB_XGEN(b.x)], 1u);
            asm volatile("s_waitcnt vmcnt(0)" ::: "memory");
        } else {
            XB_SPIN(xb_ld(&bar[XB_XGEN(b.x)]) == gen, bar);
            __builtin_amdgcn_fence(__ATOMIC_ACQUIRE, "agent");
            asm volatile("s_waitcnt vmcnt(0)" ::: "memory");
        }
    }
    __syncthreads();
}


__global__ void __launch_bounds__(NTHR, 2) trunk_fwd(Params p) {
    extern __shared__ __attribute__((aligned(16))) unsigned char lds_raw[];
    LAS unsigned char* lds = (LAS unsigned char*)lds_raw;
    cg::grid_group grid = cg::this_grid();
    const int G = gridDim.x, bid = blockIdx.x;
    unsigned char* ws = p.ws;
    bf16* H = (bf16*)(ws + WS_H); bf16* PROJ = (bf16*)(ws + WS_PROJ); bf16* MIX = (bf16*)(ws + WS_MIX); bf16* HID = (bf16*)(ws + WS_HID);

    volatile LAS unsigned* xst = (volatile LAS unsigned*)(lds + LDS_MISC + 64);
    if (threadIdx.x < 4) xst[threadIdx.x] = 0u;
    if (bid == 0) { unsigned* bw = (unsigned*)(ws + WS_BAR); for (int i = threadIdx.x; i < XCD_BAR_WORDS; i += NTHR) bw[i] = 0u; }
    phase_weights(p, lds);
    float* SS = (float*)(ws + WS_SS);
    phase_x0(p.x, H, SS);
    grid.sync();
    const XcdBarrier xb = xcd_barrier_post((unsigned*)(ws + WS_BAR), xst);
#define GRID_BAR() xcd_barrier(xb)
    for (int layer = 0; layer < DEPTH; ++layer) {
        {
            pg8::Gemm g{H, (const bf16*)(ws + WS_WIN) + (size_t)layer * INW * DM, SEQ, INW, DM}; pg8::StaticOrder S; S.init(SEQ, INW, G, bid);
            pg8::EpiBf16<0> E{PROJ, INW, SS + (size_t)(2 * layer) * SEQ * 32, 1.f / DM, (const LAS float*)(lds + 131072)};
            pg8::gemm_phase(lds, g, S, E);
        }
        GRID_BAR();
        for (int u = bid; u < 32 * 40; u += G) post_unit(p, layer, u, lds);
        GRID_BAR();
        for (int it = bid; it < 192; it += G) sel_item(p, it);
        GRID_BAR();
        phase_attn(p, layer, lds);
        GRID_BAR();
        phase_merge(p);
        GRID_BAR();
        {
            pg8::Gemm g{MIX, (const bf16*)(ws + WS_WOUT) + (size_t)layer * DM * DM, SEQ, DM, DM}; pg8::StaticOrder S; S.init(SEQ, DM, G, bid);
            pg8::EpiResid E{H, SS + (size_t)(2 * layer + 1) * SEQ * 32, DM};
            pg8::gemm_phase(lds, g, S, E);
        }
        GRID_BAR();
        {
            pg8::Gemm g{H, (const bf16*)(ws + WS_W1) + (size_t)layer * DFF * DM, SEQ, DFF, DM}; pg8::StaticOrder S; S.init(SEQ, DFF, G, bid);
            pg8::EpiBf16<1> E{HID, DFF, SS + (size_t)(2 * layer + 1) * SEQ * 32, 1.f / DM, (const LAS float*)(lds + 131072)};
            pg8::gemm_phase(lds, g, S, E);
        }
        GRID_BAR();
        {
            pg8::Gemm g{HID, (const bf16*)(ws + WS_W2) + (size_t)layer * DM * DFF, SEQ, DM, DFF}; pg8::StaticOrder S; S.init(SEQ, DM, G, bid);
            pg8::EpiResid E{H, SS + (size_t)(2 * layer + 2) * SEQ * 32, DM};
            pg8::gemm_phase(lds, g, S, E);
        }
        GRID_BAR();
    }
    phase_norm_f32(H, p.final_g, SS + (size_t)8 * SEQ * 32, p.out);
}

extern "C" void kernel_launch(void* const* d_in, const int* in_sizes, int n_in, void* d_out, int out_size, void* d_ws, size_t ws_size, hipStream_t stream) {
    static int grid_blocks = 0;
    if (grid_blocks == 0) {
        if (n_in != 14 || ws_size < WS_END) { fprintf(stderr, "kernel_launch: unexpected inputs (n_in %d, ws %zu, need %zu)\n", n_in, ws_size, (size_t)WS_END); grid_blocks = -1; return; }
        int dev = 0, cus = 0, per_cu = 0;
        hipGetDevice(&dev);
        hipDeviceGetAttribute(&cus, hipDeviceAttributeMultiprocessorCount, dev);
        hipFuncSetAttribute((const void*)trunk_fwd, hipFuncAttributeMaxDynamicSharedMemorySize, LDS_BYTES);
        hipOccupancyMaxActiveBlocksPerMultiprocessor(&per_cu, (const void*)trunk_fwd, NTHR, LDS_BYTES);
        if (per_cu < 1) per_cu = 1;
        grid_blocks = cus * per_cu;
        (void)hipGetLastError();
    }
    if (grid_blocks < 0) return;
    Params p{};
    p.x = (const float*)d_in[0]; p.attn_g = (const float*)d_in[1]; p.w_in = (const float*)d_in[2]; p.diff_lambda = (const float*)d_in[3]; p.subln_g = (const float*)d_in[4];
    p.sgu_ln_g = (const float*)d_in[5]; p.sgu_ln_b = (const float*)d_in[6]; p.sgu_w = (const float*)d_in[7]; p.sgu_b = (const float*)d_in[8]; p.w_out = (const float*)d_in[9];
    p.mlp_g = (const float*)d_in[10]; p.w1 = (const float*)d_in[11]; p.w2 = (const float*)d_in[12]; p.final_g = (const float*)d_in[13];
    p.out = (float*)d_out; p.ws = (unsigned char*)d_ws;
    void* args[] = {&p};
    hipError_t e = hipLaunchCooperativeKernel((const void*)trunk_fwd, dim3(grid_blocks), dim3(NTHR), args, LDS_BYTES, stream);
    if (e != hipSuccess) fprintf(stderr, "cooperative launch failed: %s (grid %d)\n", hipGetErrorString(e), grid_blocks);
}
```

```cpp
#include <hip/hip_runtime.h>
#include <hip/hip_cooperative_groups.h>
#include <cstdio>
#include <cstdint>
namespace cg = cooperative_groups;

namespace pg8 {
#define PG8_LAS __attribute__((address_space(3)))
typedef unsigned short bf16_t;
typedef short bf16x8 __attribute__((ext_vector_type(8)));
typedef float f32x4 __attribute__((ext_vector_type(4)));
typedef unsigned u32x4 __attribute__((ext_vector_type(4)));
typedef unsigned u32x2 __attribute__((ext_vector_type(2)));
constexpr int BM = 256, BK = 64, HALF = 128, HTB = HALF * BK * 2  , STAGE_BYTES = 8 * HTB, NXCD = 8, WGM = 4;

__host__ __device__ __forceinline__ int lds_byte(int r, int c) { const int st = (r >> 4) * 2 + (c >> 5), rr = r & 15, cc = c & 31, ob = rr * 64 + cc * 2; return st * 1024 + (ob ^ (((ob >> 9) & 1) << 5)); }
__host__ __device__ __forceinline__ void stage_rc(int b, int& R, int& C) { const int st = b / 1024, sb = b % 1024, swz = sb ^ (((sb >> 9) & 1) << 5); R = (st >> 1) * 16 + swz / 64; C = (st & 1) * 32 + (swz % 64) / 2; }
__host__ __device__ __forceinline__ int perm32(int rho) { const int n = rho >> 4, i = rho & 15; return 8 * (i >> 2) + 4 * n + (i & 3); }

struct Unit { int pm, pn, ui; };
struct Gemm { const bf16_t* A; const bf16_t* Bt; int M, N, K; };

struct StaticOrder {
    int nM, nN, nwg, G, c;
    __host__ __device__ void init(int M, int N, int G_, int c_) { nM = M / BM; nN = N / BM; nwg = nM * nN; G = G_; c = c_; }
    __host__ __device__ bool next(int i, Unit& u) const {
        const long L = (long)i * G + c; if (L >= nwg) return false;
        int wgid = (int)L; { const int q = nwg / NXCD, r = nwg % NXCD, xcd = wgid % NXCD, off = wgid / NXCD; wgid = (xcd < r ? xcd * (q + 1) : r * (q + 1) + (xcd - r) * q) + off; }
        const int nig = WGM * nN, gid = wgid / nig, fm = gid * WGM, gsz = (nM - fm) < WGM ? (nM - fm) : WGM;
        u.pm = fm + ((wgid % nig) % gsz); u.pn = (wgid % nig) / gsz; u.ui = i; return true;
    }
    __device__ __forceinline__ void a_ready(const Unit&) const {}
    __device__ __forceinline__ void done(const Unit&) const {}
};

typedef float f32x2 __attribute__((ext_vector_type(2)));
typedef __bf16 bf16x2_t __attribute__((ext_vector_type(2)));
__device__ __forceinline__ float shx(float v, int k, int lane) { return __int_as_float(__builtin_amdgcn_ds_bpermute((lane ^ k) << 2, __float_as_int(v))); }
__device__ __forceinline__ unsigned cvt_pk_bf16(float lo, float hi) { f32x2 v = {lo, hi}; bf16x2_t b = __builtin_convertvector(v, bf16x2_t); return __builtin_bit_cast(unsigned, b); }

struct EpiResid {
    static constexpr bool PERM = true, NEEDS_PREP = false;
    bf16_t* XB; float* SS; int ldc;
    __device__ __forceinline__ void operator()(const f32x4 (&acc)[2][2][4][2], const Unit& u, int wr, int wc, int fr, int fq) const {
        const int row0 = u.pm * BM + wr * 64 + fr, col0 = u.pn * BM + wc * 32 + 8 * fq;
        u32x4 xin[2][4][2];
#pragma unroll
        for (int ai = 0; ai < 2; ++ai)
#pragma unroll
            for (int m = 0; m < 4; ++m)
#pragma unroll
                for (int bj = 0; bj < 2; ++bj) xin[ai][m][bj] = *(const u32x4*)(XB + (size_t)(row0 + ai * HALF + m * 16) * ldc + col0 + bj * HALF);
#pragma unroll
        for (int ai = 0; ai < 2; ++ai)
#pragma unroll
            for (int m = 0; m < 4; ++m) { const int row = row0 + ai * HALF + m * 16; const size_t off = (size_t)row * ldc + col0; float part = 0.f;
#pragma unroll
                for (int bj = 0; bj < 2; ++bj) { const u32x4 xi = xin[ai][m][bj]; const f32x4 a0 = acc[ai][bj][m][0], a1 = acc[ai][bj][m][1];
                    u32x4 w;
                    w.x = cvt_pk_bf16(a0[0] + __uint_as_float(xi.x << 16), a0[1] + __uint_as_float(xi.x & 0xffff0000u));
                    w.y = cvt_pk_bf16(a0[2] + __uint_as_float(xi.y << 16), a0[3] + __uint_as_float(xi.y & 0xffff0000u));
                    w.z = cvt_pk_bf16(a1[0] + __uint_as_float(xi.z << 16), a1[1] + __uint_as_float(xi.z & 0xffff0000u));
                    w.w = cvt_pk_bf16(a1[2] + __uint_as_float(xi.w << 16), a1[3] + __uint_as_float(xi.w & 0xffff0000u));
                    *(u32x4*)(XB + off + bj * HALF) = w;
#pragma unroll
                    for (int e = 0; e < 4; ++e) { const float lo = __uint_as_float(w[e] << 16), hi = __uint_as_float(w[e] & 0xffff0000u); part += lo * lo + hi * hi; } }
                part += shx(part, 16, fq * 16 + fr); part += shx(part, 32, fq * 16 + fr);
                if (fq == 0) SS[(size_t)row * 32 + u.pn * 4 + wc] = part; }
    }
};
template <int ACT> struct EpiBf16 {
    static constexpr bool PERM = true;
    static constexpr bool NEEDS_PREP = true;
    bf16_t* O; int ldc; const float* SS; float inv_k; const PG8_LAS float* rstab;
    template <class Sched> __device__ __forceinline__ void prep(const Sched& S, int tid) const {
        PG8_LAS float* tab = (PG8_LAS float*)rstab;
#pragma unroll
        for (int k = 0; k < 2; ++k) { const int ui = (tid >> 8) + 2 * k; Unit u;
            if (S.next(ui, u)) { const f32x4* sp = (const f32x4*)(SS + (size_t)(u.pm * BM + (tid & 255)) * 32); float tot = 0.f;
#pragma unroll
                for (int j = 0; j < 8; ++j) { const f32x4 a = sp[j]; tot += (a[0] + a[1]) + (a[2] + a[3]); }
                tab[ui * 256 + (tid & 255)] = rsqrtf(tot * inv_k + 1e-6f); } }
    }
    __device__ __forceinline__ void operator()(const f32x4 (&acc)[2][2][4][2], const Unit& u, int wr, int wc, int fr, int fq) const {
        const int row0 = u.pm * BM + wr * 64 + fr; const int col0 = u.pn * BM + wc * 32 + 8 * fq;
        float rsv[2][4];
#pragma unroll
        for (int ai = 0; ai < 2; ++ai)
#pragma unroll
            for (int m = 0; m < 4; ++m) rsv[ai][m] = rstab[(u.ui & 3) * 256 + wr * 64 + fr + ai * HALF + m * 16];
#pragma unroll
        for (int ai = 0; ai < 2; ++ai)
#pragma unroll
            for (int m = 0; m < 4; ++m) { const int row = row0 + ai * HALF + m * 16; bf16_t* rowp = O + (size_t)row * ldc + col0;
                const float rs = rsv[ai][m];
#pragma unroll
                for (int bj = 0; bj < 2; ++bj) { f32x4 v0 = acc[ai][bj][m][0] * rs, v1 = acc[ai][bj][m][1] * rs;
                    if (ACT == 1) {
#pragma unroll
                        for (int j = 0; j < 4; ++j) { const float a = fmaxf(v0[j], 0.f), b = fmaxf(v1[j], 0.f); v0[j] = a * a; v1[j] = b * b; } }
                    u32x4 w; w.x = cvt_pk_bf16(v0[0], v0[1]); w.y = cvt_pk_bf16(v0[2], v0[3]); w.z = cvt_pk_bf16(v1[0], v1[1]); w.w = cvt_pk_bf16(v1[2], v1[3]);
                    *(u32x4*)(rowp + bj * HALF) = w; } }
    }
};

template <class Epi, class Sched>
__device__ __forceinline__ void gemm_phase(PG8_LAS unsigned char* lds, const Gemm g, const Sched& S, const Epi& E) {
    int tid_ = threadIdx.x; asm volatile("" : "+v"(tid_));
    const int tid = tid_, wid = __builtin_amdgcn_readfirstlane(tid >> 6), lane = tid & 63, wr = wid >> 2, wc = wid & 3, fr = lane & 15, fq = lane >> 4;
    const int K = g.K, nt = K / BK;
    unsigned voffA[2], voffB[2];
#pragma unroll
    for (int i = 0; i < 2; ++i) { int R, C; stage_rc(tid * 16 + i * 8192, R, C); const int Rb = Epi::PERM ? ((R & ~31) + perm32(R & 31)) : R;
        voffA[i] = (unsigned)(R * K + C) * 2u; voffB[i] = (unsigned)(Rb * K + C) * 2u; }
    const size_t kstep = (size_t)(BK * 2);
    const size_t hstep = (size_t)HALF * K * 2;
    const size_t tstep = 2 * hstep;
    const unsigned ldsw = (unsigned)wid * 1024u;
    const int aoff = lds_byte(wr * 64 + fr, fq * 8), boff = lds_byte(wc * 32 + fr, fq * 8);
#define PG8_SA(b, h) (((b) * 2 + (h)) * HTB)
#define PG8_SB(b, h) ((4 + (b) * 2 + (h)) * HTB)
#define PG8_STAGE(bufoff, gbase, voff) do { _Pragma("unroll") for (int _i = 0; _i < 2; ++_i) \
        __builtin_amdgcn_global_load_lds((const unsigned*)((const char*)(gbase) + (voff)[_i]), (PG8_LAS unsigned*)(lds + (bufoff) + ldsw + _i * 8192), 16, 0, 0); } while (0)
#define PG8_LDA(dst, b, h) do { _Pragma("unroll") for (int m = 0; m < 4; ++m) _Pragma("unroll") for (int k = 0; k < 2; ++k) dst[m][k] = *(const PG8_LAS bf16x8*)(lds + PG8_SA(b, h) + aoff + m * 2048 + k * 1024); } while (0)
#define PG8_LDB(dst, b, h) do { _Pragma("unroll") for (int n = 0; n < 2; ++n) _Pragma("unroll") for (int k = 0; k < 2; ++k) dst[n][k] = *(const PG8_LAS bf16x8*)(lds + PG8_SB(b, h) + boff + n * 2048 + k * 1024); } while (0)
#define PG8_MMA(ai, bj, At, Bt) do { __builtin_amdgcn_s_setprio(1); _Pragma("unroll") for (int m = 0; m < 4; ++m) _Pragma("unroll") for (int n = 0; n < 2; ++n) _Pragma("unroll") for (int k = 0; k < 2; ++k) \
        acc[ai][bj][m][n] = __builtin_amdgcn_mfma_f32_16x16x32_bf16(Bt[n][k], At[m][k], acc[ai][bj][m][n], 0, 0, 0); __builtin_amdgcn_s_setprio(0); } while (0)
#define PG8_WAIT_V(n) asm volatile("s_waitcnt vmcnt(" #n ")" ::: "memory")
#define PG8_WAIT_L(n) asm volatile("s_waitcnt lgkmcnt(" #n ")" ::: "memory")
#define PG8_BAR __builtin_amdgcn_s_barrier()
#define PG8_SCHED __builtin_amdgcn_sched_barrier(0)
    Unit cur, nxt; int ui = 0;
    if (!S.next(0, cur)) return;
    f32x4 acc[2][2][4][2];
#pragma unroll
    for (int a = 0; a < 2; ++a)
#pragma unroll
        for (int b = 0; b < 2; ++b)
#pragma unroll
            for (int m = 0; m < 4; ++m)
#pragma unroll
                for (int n = 0; n < 2; ++n) acc[a][b][m][n] = (f32x4){0.f, 0.f, 0.f, 0.f};
    bf16x8 At[4][2], B0[2][2], B1[2][2];
    const char* cA = (const char*)g.A + (size_t)cur.pm * tstep; const char* cB = (const char*)g.Bt + (size_t)cur.pn * tstep;
    if constexpr (Epi::NEEDS_PREP) { E.prep(S, tid); asm volatile("s_waitcnt lgkmcnt(0)" ::: "memory"); __builtin_amdgcn_s_barrier(); }
    S.a_ready(cur);
    PG8_STAGE(PG8_SB(0, 0), cB, voffB); PG8_STAGE(PG8_SB(0, 1), cB + hstep, voffB); PG8_STAGE(PG8_SA(0, 0), cA, voffA); PG8_STAGE(PG8_SA(0, 1), cA + hstep, voffA);
    if (wr == 1) PG8_BAR;
    PG8_WAIT_V(2); PG8_BAR;
    PG8_STAGE(PG8_SB(1, 0), cB + kstep, voffB); PG8_STAGE(PG8_SA(1, 0), cA + kstep, voffA); PG8_STAGE(PG8_SB(1, 1), cB + hstep + kstep, voffB);
    PG8_WAIT_V(6); PG8_BAR;
    for (;;) {
        const bool has_next = S.next(ui + 1, nxt);
        const char* nA = has_next ? (const char*)g.A + (size_t)nxt.pm * tstep : cA; const char* nB = has_next ? (const char*)g.Bt + (size_t)nxt.pn * tstep : cB;
        for (int t = 0; t < nt; t += 2) {
            const bool last = (t == nt - 2);
            const char* a1 = cA + (size_t)(t + 1) * kstep;
            const char* a2 = last ? nA : cA + (size_t)(t + 2) * kstep; const char* b2 = last ? nB : cB + (size_t)(t + 2) * kstep;
            const char* a3 = a2 + kstep; const char* b3 = b2 + kstep;
            if (last && has_next) S.a_ready(nxt);
            PG8_LDB(B0, 0, 0); PG8_LDB(B1, 0, 1); PG8_SCHED; PG8_LDA(At, 0, 0); PG8_STAGE(PG8_SA(1, 1), a1 + hstep, voffA);
            PG8_WAIT_V(8); PG8_WAIT_L(0); PG8_BAR; PG8_MMA(0, 0, At, B0); PG8_MMA(0, 1, At, B1); PG8_BAR; PG8_SCHED;
            PG8_LDA(At, 0, 1); PG8_STAGE(PG8_SB(0, 0), b2, voffB); PG8_STAGE(PG8_SB(0, 1), b2 + hstep, voffB); PG8_STAGE(PG8_SA(0, 0), a2, voffA);
            PG8_WAIT_V(8); PG8_WAIT_L(0); PG8_BAR; PG8_MMA(1, 0, At, B0); PG8_MMA(1, 1, At, B1); PG8_BAR; PG8_SCHED;
            PG8_LDB(B0, 1, 0); PG8_LDB(B1, 1, 1); PG8_SCHED; PG8_LDA(At, 1, 0); PG8_STAGE(PG8_SA(0, 1), a2 + hstep, voffA);
            PG8_WAIT_V(8); PG8_WAIT_L(0); PG8_BAR; PG8_MMA(0, 0, At, B0); PG8_MMA(0, 1, At, B1); PG8_BAR; PG8_SCHED;
            PG8_LDA(At, 1, 1); PG8_STAGE(PG8_SB(1, 0), b3, voffB); PG8_STAGE(PG8_SB(1, 1), b3 + hstep, voffB); PG8_STAGE(PG8_SA(1, 0), a3, voffA);
            PG8_WAIT_V(8); PG8_WAIT_L(0); PG8_BAR; PG8_MMA(1, 0, At, B0); PG8_MMA(1, 1, At, B1); PG8_BAR; PG8_SCHED;
        }
        if (wr == 0) PG8_BAR;
        E(acc, cur, wr, wc, fr, fq); S.done(cur);
        if (!has_next) break;
#pragma unroll
        for (int a = 0; a < 2; ++a)
#pragma unroll
            for (int b = 0; b < 2; ++b)
#pragma unroll
                for (int m = 0; m < 4; ++m)
#pragma unroll
                    for (int n = 0; n < 2; ++n) acc[a][b][m][n] = (f32x4){0.f, 0.f, 0.f, 0.f};
        cur = nxt; cA = nA; cB = nB; ++ui;
        if (wr == 1) PG8_BAR;
    }
    PG8_WAIT_V(0);
    PG8_BAR;
#undef PG8_SA
#undef PG8_SB
#undef PG8_STAGE
#undef PG8_LDA
#undef PG8_LDB
#undef PG8_MMA
#undef PG8_WAIT_V
#undef PG8_WAIT_L
#undef PG8_BAR
#undef PG8_SCHED
}
}

constexpr int SEQ = 8192, DM = 2048, DEPTH = 4, INW = 5632, DFF = 8192;
constexpr int C_MQ = 0, C_MK = 768, C_MV = 1536, C_DQ = 2304, C_DK = 3072, C_DV = 3840, C_SU = 4608, C_SV = 5120;
constexpr int NWAVES = 8, NTHR = 512;
constexpr int LDS_BYTES = 147456;
constexpr int LDS_MISC = 139264;
constexpr float EPS = 1e-6f;

constexpr size_t WS_CTL = 0;
constexpr size_t WS_BAR = 16384;
constexpr size_t WS_ORDER = 4096;
constexpr size_t WS_WIN = 65536;
constexpr size_t WS_WOUT = WS_WIN + (size_t)DEPTH * INW * DM * 2;
constexpr size_t WS_W1 = WS_WOUT + (size_t)DEPTH * DM * DM * 2;
constexpr size_t WS_W2 = WS_W1 + (size_t)DEPTH * DFF * DM * 2;
constexpr size_t WS_XRES = WS_W2 + (size_t)DEPTH * DM * DFF * 2;
constexpr size_t WS_H = WS_XRES + (size_t)SEQ * DM * 4;
constexpr size_t WS_PROJ = WS_H + (size_t)SEQ * DM * 2;
constexpr size_t WS_VT = WS_PROJ + (size_t)SEQ * INW * 2;
constexpr size_t WS_VNT = WS_VT + (size_t)12 * 128 * SEQ * 2;
constexpr size_t WS_KM = WS_VNT + (size_t)SEQ * 512 * 2;
constexpr size_t WS_SEL = WS_KM + (size_t)6 * 32 * 128 * 4;
constexpr size_t WS_MIX = WS_SEL + (size_t)6 * SEQ * 4;
constexpr size_t WS_HID = WS_MIX + (size_t)SEQ * DM * 2;
constexpr size_t WS_SS = WS_HID + (size_t)SEQ * DFF * 2;
constexpr size_t WS_END = WS_SS + (size_t)9 * SEQ * 32 * 4;

#define LAS __attribute__((address_space(3)))
typedef unsigned short bf16;
typedef short bf16x8 __attribute__((ext_vector_type(8)));
typedef short s16x4 __attribute__((ext_vector_type(4)));
typedef float f32x4 __attribute__((ext_vector_type(4)));
typedef float f32x16 __attribute__((ext_vector_type(16)));
typedef unsigned u32x4 __attribute__((ext_vector_type(4)));
typedef unsigned u32x2 __attribute__((ext_vector_type(2)));
#define MFMA32(a, b, c) __builtin_amdgcn_mfma_f32_32x32x16_bf16((a), (b), (c), 0, 0, 0)

__device__ __forceinline__ unsigned pk2(float lo, float hi) { return pg8::cvt_pk_bf16(lo, hi); }
__device__ __forceinline__ float bf_lo(unsigned w) { return __uint_as_float(w << 16); }
__device__ __forceinline__ float bf_hi(unsigned w) { return __uint_as_float(w & 0xffff0000u); }
__device__ __forceinline__ float shx(float v, int k, int lane) { return __int_as_float(__builtin_amdgcn_ds_bpermute((lane ^ k) << 2, __float_as_int(v))); }
__device__ __forceinline__ int shxi(int v, int k, int lane) { return __builtin_amdgcn_ds_bpermute((lane ^ k) << 2, v); }
__device__ __forceinline__ float shx32(float v, int lane) { const unsigned u = __float_as_uint(v); const auto r = __builtin_amdgcn_permlane32_swap(u, u, false, false); return __uint_as_float((lane >> 5) ? r[0] : r[1]); }
__device__ __forceinline__ float wave_sum(float v, int lane) {
#pragma unroll
    for (int o = 1; o < 64; o <<= 1) v += shx(v, o, lane);
    return v;
}
__device__ __forceinline__ float gelu_t(float x) {
    const float u = 0.7978845608028654f * (x + 0.044715f * x * x * x);
    const float e = __expf(2.f * u);
    const float th = 1.f - 2.f / (e + 1.f);
    return 0.5f * x * (1.f + th);
}
__device__ __forceinline__ int tid_opaque() { int t = threadIdx.x; asm volatile("" : "+v"(t)); return t; }
__device__ __forceinline__ int crow(int reg, int h) { return (reg & 3) + 8 * (reg >> 2) + 4 * h; }

struct Params {
    const float* x; const float* attn_g; const float* w_in; const float* diff_lambda; const float* subln_g;
    const float* sgu_ln_g; const float* sgu_ln_b; const float* sgu_w; const float* sgu_b; const float* w_out;
    const float* mlp_g; const float* w1; const float* w2; const float* final_g;
    float* out; unsigned char* ws;
};

__device__ __forceinline__ void transpose_item(const float* W, int K, int N, bf16* WT, LAS float* scr, int item, int lane, const float* gk) {
    const int nblk = N / 32, kb = item / nblk, nb = item % nblk, k0 = 64 * kb, n0 = 32 * nb;
    float wv[32];
#pragma unroll
    for (int i = 0; i < 32; ++i) { const int kk = 2 * i + (lane >> 5); wv[i] = W[(size_t)(k0 + kk) * N + n0 + (lane & 31)]; }
    if (gk) {
#pragma unroll
        for (int i = 0; i < 32; ++i) wv[i] *= gk[k0 + 2 * i + (lane >> 5)];
    }
#pragma unroll
    for (int i = 0; i < 32; ++i) { const int kk = 2 * i + (lane >> 5); scr[kk * 33 + (lane & 31)] = wv[i]; }
    asm volatile("s_waitcnt lgkmcnt(0)" ::: "memory");
    const int c = lane & 7;
#pragma unroll
    for (int j = 0; j < 4; ++j) { const int n = (lane >> 3) + 8 * j; const LAS float* s = scr + (8 * c) * 33 + n;
        u32x4 o; o.x = pk2(s[0 * 33], s[1 * 33]); o.y = pk2(s[2 * 33], s[3 * 33]); o.z = pk2(s[4 * 33], s[5 * 33]); o.w = pk2(s[6 * 33], s[7 * 33]);
        *(u32x4*)(WT + (size_t)(n0 + n) * K + k0 + 8 * c) = o; }
    asm volatile("s_waitcnt lgkmcnt(0)" ::: "memory");
}

constexpr int NU_OWN = 192, NU_GAT = 456, NU_DIF = 384, NU_SGU = 256;
constexpr int U_GAT = NU_OWN, U_DIF = U_GAT + NU_GAT, U_SGU = U_DIF + NU_DIF, NU_ALL = U_SGU + NU_SGU;
constexpr size_t WS_PART = WS_XRES;
__device__ __forceinline__ void gat_decode(int v, int& n, int& C) {
    if (v < 28) { n = v >> 2; C = v & 3; }
    else if (v < 52) { const int w = v - 28; n = 7 + w / 3; C = 1 + w % 3; }
    else if (v < 68) { const int w = v - 52; n = 15 + (w >> 1); C = 2 + (w & 1); }
    else { n = 23 + (v - 68); C = 3; }
}
__device__ __forceinline__ float unit_cost(int u) {
    if (u < U_GAT) return 3.0f;
    if (u < U_DIF) { int n, C; gat_decode((u - U_GAT) % 76, n, C); const int bs = (n + 1 > 8 * C) ? n + 1 : 8 * C; float cnt = 0.f;
        for (int b = bs; b < 8 * C + 8; ++b) cnt += 256.f * (b < 3 ? (float)b : 3.f) / (float)b;
        return 4.0f * (cnt * (1.f / 256.f) + 0.5f); }
    if (u < U_SGU) return 1.7f * (float)(((u - U_DIF) & 63) + 1);
    return 0.5f;
}

__device__ __forceinline__ void phase_weights(const Params& p, LAS unsigned char* lds) {
    const int tid = tid_opaque(), lane = tid & 63, wave = tid >> 6;
    LAS float* scr = (LAS float*)(lds + wave * 16384);
    const int gw = blockIdx.x * NWAVES + wave, NGW = gridDim.x * NWAVES;
    constexpr int I_IN = (DM / 64) * (INW / 32), I_OUT = (DM / 64) * (DM / 32), I_1 = (DM / 64) * (DFF / 32), I_2 = (DFF / 64) * (DM / 32);
    constexpr int PER_LAYER = I_IN + I_OUT + I_1 + I_2;
    for (int it = gw; it < DEPTH * PER_LAYER; it += NGW) {
        const int l = it / PER_LAYER; int r = it % PER_LAYER;
        if (r < I_IN) { transpose_item(p.w_in + (size_t)l * DM * INW, DM, INW, (bf16*)(p.ws + WS_WIN) + (size_t)l * INW * DM, scr, r, lane, p.attn_g + (size_t)l * DM); continue; } r -= I_IN;
        if (r < I_OUT) { transpose_item(p.w_out + (size_t)l * DM * DM, DM, DM, (bf16*)(p.ws + WS_WOUT) + (size_t)l * DM * DM, scr, r, lane, nullptr); continue; } r -= I_OUT;
        if (r < I_1) { transpose_item(p.w1 + (size_t)l * DM * DFF, DM, DFF, (bf16*)(p.ws + WS_W1) + (size_t)l * DFF * DM, scr, r, lane, p.mlp_g + (size_t)l * DM); continue; } r -= I_1;
        transpose_item(p.w2 + (size_t)l * DFF * DM, DFF, DM, (bf16*)(p.ws + WS_W2) + (size_t)l * DM * DFF, scr, r, lane, nullptr);
    }
    if (blockIdx.x == 0) {
        unsigned* ctl = (unsigned*)(p.ws + WS_CTL);
        if (tid < 64) ctl[tid] = 0u;
        int* order = (int*)(p.ws + WS_ORDER);
        LAS float* cst = (LAS float*)(lds + 65536);
        __syncthreads();
        for (int u = tid; u < NU_ALL; u += NTHR) cst[u] = unit_cost(u);
        __syncthreads();
        for (int u = tid; u < NU_ALL; u += NTHR) {
            const float cu = cst[u]; int rank = 0;
            for (int j = 0; j < NU_ALL; ++j) { const float cj = cst[j]; rank += (cj > cu || (cj == cu && j < u)) ? 1 : 0; }
            order[rank] = u;
        }
    }
}

__device__ __forceinline__ void phase_x0(const float* X, bf16* XB, float* SS0) {
    const int tid = tid_opaque(), lane = tid & 63, wave = tid >> 6;
    const int gw = blockIdx.x * NWAVES + wave, NGW = gridDim.x * NWAVES;
    for (int m = gw; m < SEQ; m += NGW) {
        const f32x4* xr = (const f32x4*)(X + (size_t)m * DM) + lane;
        f32x4 v[8]; float s = 0.f;
#pragma unroll
        for (int j = 0; j < 8; ++j) { v[j] = xr[64 * j]; s += (v[j].x * v[j].x + v[j].y * v[j].y) + (v[j].z * v[j].z + v[j].w * v[j].w); }
        s = wave_sum(s, lane);
        if (lane < 32) SS0[(size_t)m * 32 + lane] = lane == 0 ? s : 0.f;
        u32x2* o8 = (u32x2*)(XB + (size_t)m * DM) + lane;
#pragma unroll
        for (int j = 0; j < 8; ++j) { u32x2 w; w.x = pk2(v[j].x, v[j].y); w.y = pk2(v[j].z, v[j].w); o8[64 * j] = w; }
    }
}
__device__ __forceinline__ void phase_norm_f32(const bf16* X, const float* g, const float* SS, float* O) {
    const int tid = tid_opaque(), lane = tid & 63, wave = tid >> 6;
    const int gw = blockIdx.x * NWAVES + wave, NGW = gridDim.x * NWAVES;
    for (int m = gw; m < SEQ; m += NGW) {
        const u32x4* xr = (const u32x4*)(X + (size_t)m * DM) + lane;
        const float rs = rsqrtf(wave_sum(lane < 32 ? SS[(size_t)m * 32 + lane] : 0.f, lane) * (1.f / DM) + EPS);
        f32x4* o = (f32x4*)(O + (size_t)m * DM) + 2 * lane;
#pragma unroll
        for (int j = 0; j < 4; ++j) { const u32x4 xv = xr[64 * j]; const f32x4 g0 = ((const f32x4*)g)[2 * lane + 128 * j], g1 = ((const f32x4*)g)[2 * lane + 128 * j + 1];
            o[128 * j] = (f32x4){bf_lo(xv.x), bf_hi(xv.x), bf_lo(xv.y), bf_hi(xv.y)} * rs * g0;
            o[128 * j + 1] = (f32x4){bf_lo(xv.z), bf_hi(xv.z), bf_lo(xv.w), bf_hi(xv.w)} * rs * g1; }
    }
}

constexpr int TP_STRIDE = 132;
__device__ __forceinline__ void post_unit(const Params& p, int layer, int unit, LAS unsigned char* lds) {
    const int tid = tid_opaque();
    const int rb = unit / 40, cbi = unit % 40, cb = cbi < 36 ? cbi : cbi + 4;
    const int col0 = cb * 128;
    const int r64 = tid >> 3, j = tid & 7;
    bf16* proj = (bf16*)(p.ws + WS_PROJ);
    int type;
    int hh = 0;
    if (cb < 6) type = 0; else if (cb < 12) type = 1; else if (cb < 18) { type = 2; hh = cb - 12; } else if (cb < 30) type = 3; else if (cb < 36) { type = 2; hh = 6 + cb - 30; } else { type = 4; hh = cb - 40; }
    int c0, c1;
    if (type <= 1) { c0 = 8 * j; c1 = c0 + 64; }
    else if (type == 3) { c0 = (j < 4) ? 8 * j : 64 + 8 * (j - 4); c1 = c0 + 32; }
    else { c0 = 16 * j; c1 = c0 + 8; }
    double inv2pi[8];
    if (type <= 1 || type == 3) {
        const float half = (type == 3) ? 32.f : 64.f; const int i0 = (type == 3) ? 8 * (j & 3) : 8 * j;
#pragma unroll
        for (int e = 0; e < 8; ++e) inv2pi[e] = (double)exp2f(-(float)(i0 + e) * (13.287712379549449f / half)) * 0.15915494309189535;
    } else {
#pragma unroll
        for (int e = 0; e < 8; ++e) inv2pi[e] = 0.0;
    }
    float csa[8], csb[8];
#pragma unroll
    for (int e = 0; e < 8; ++e) { csa[e] = 0.f; csb[e] = 0.f; }
    LAS bf16* tile = (LAS bf16*)lds;
    u32x4 na = *(const u32x4*)(proj + (size_t)(rb * 256 + r64) * INW + col0 + c0), nb = *(const u32x4*)(proj + (size_t)(rb * 256 + r64) * INW + col0 + c1);
    for (int sub = 0; sub < 4; ++sub) {
        const int row = rb * 256 + sub * 64 + r64;
        bf16* rp = proj + (size_t)row * INW + col0;
        const u32x4 ua = na, ub = nb;
        if (sub < 3) { na = *(const u32x4*)(rp + (size_t)64 * INW + c0); nb = *(const u32x4*)(rp + (size_t)64 * INW + c1); }
        float xa[8], xb[8];
#pragma unroll
        for (int e = 0; e < 4; ++e) { xa[2 * e] = bf_lo(ua[e]); xa[2 * e + 1] = bf_hi(ua[e]); xb[2 * e] = bf_lo(ub[e]); xb[2 * e + 1] = bf_hi(ub[e]); }
        if (type <= 1 || type == 3) {
            float ya[8], yb[8];
#pragma unroll
            for (int e = 0; e < 8; ++e) {
                double rev = (double)row * inv2pi[e]; rev -= floor(rev);
                const float fr = (float)rev;
                const float sn = __builtin_amdgcn_sinf(fr), cs = __builtin_amdgcn_cosf(fr);
                ya[e] = xa[e] * cs - xb[e] * sn; yb[e] = xb[e] * cs + xa[e] * sn;
                csa[e] += ya[e]; csb[e] += yb[e];
            }
            u32x4 oa, ob;
#pragma unroll
            for (int e = 0; e < 4; ++e) { oa[e] = pk2(ya[2 * e], ya[2 * e + 1]); ob[e] = pk2(yb[2 * e], yb[2 * e + 1]); }
            *(u32x4*)(rp + c0) = oa; *(u32x4*)(rp + c1) = ob;
        } else {
            u32x4 oa = ua, ob = ub;
            if (type == 4) {
                float s = 0.f;
#pragma unroll
                for (int e = 0; e < 8; ++e) { xa[e] = gelu_t(xa[e]); xb[e] = gelu_t(xb[e]); s += xa[e] + xb[e]; }
                s += shx(s, 1, tid & 63); s += shx(s, 2, tid & 63); s += shx(s, 4, tid & 63);
                const float mu = s * (1.f / 128.f); float s2 = 0.f;
#pragma unroll
                for (int e = 0; e < 8; ++e) { xa[e] -= mu; xb[e] -= mu; s2 += xa[e] * xa[e] + xb[e] * xb[e]; }
                s2 += shx(s2, 1, tid & 63); s2 += shx(s2, 2, tid & 63); s2 += shx(s2, 4, tid & 63);
                const float rstd = rsqrtf(s2 * (1.f / 128.f) + EPS);
                const float* lg = p.sgu_ln_g + ((size_t)layer * 4 + hh) * 128; const float* lb = p.sgu_ln_b + ((size_t)layer * 4 + hh) * 128;
#pragma unroll
                for (int e = 0; e < 8; ++e) { xa[e] = xa[e] * rstd * lg[c0 + e] + lb[c0 + e]; xb[e] = xb[e] * rstd * lg[c1 + e] + lb[c1 + e]; }
#pragma unroll
                for (int e = 0; e < 4; ++e) { oa[e] = pk2(xa[2 * e], xa[2 * e + 1]); ob[e] = pk2(xb[2 * e], xb[2 * e + 1]); }
            }
            __syncthreads();
            LAS u32x2* t0 = (LAS u32x2*)(tile + r64 * TP_STRIDE + c0);
            t0[0] = (u32x2){oa.x, oa.y}; t0[1] = (u32x2){oa.z, oa.w}; t0[2] = (u32x2){ob.x, ob.y}; t0[3] = (u32x2){ob.z, ob.w};
            __syncthreads();
            const int dv = tid >> 2, ch = tid & 3;
            unsigned w[8];
#pragma unroll
            for (int k = 0; k < 8; ++k) { const unsigned lo = tile[(16 * ch + 2 * k) * TP_STRIDE + dv], hi = tile[(16 * ch + 2 * k + 1) * TP_STRIDE + dv]; w[k] = lo | (hi << 16); }
            bf16* dst;
            if (type == 2) dst = (bf16*)(p.ws + WS_VT) + ((size_t)hh * 128 + dv) * SEQ + rb * 256 + sub * 64 + 16 * ch;
            else dst = (bf16*)(p.ws + WS_VNT) + ((size_t)((rb * 2 + (sub >> 1)) * 4 + hh) * 128 + dv) * 128 + (sub & 1) * 64 + 16 * ch;
            if (type == 2) { *(u32x4*)dst = (u32x4){w[0], w[1], w[4], w[5]}; *(u32x4*)(dst + 8) = (u32x4){w[2], w[3], w[6], w[7]}; }
            else { *(u32x4*)dst = (u32x4){w[0], w[1], w[2], w[3]}; *(u32x4*)(dst + 8) = (u32x4){w[4], w[5], w[6], w[7]}; }
        }
    }
    if (type == 1) {
        __syncthreads();
        LAS float* red = (LAS float*)lds;
#pragma unroll
        for (int e = 0; e < 8; ++e) { red[r64 * 128 + c0 + e] = csa[e]; red[r64 * 128 + c1 + e] = csb[e]; }
        __syncthreads();
        if (tid < 128) { float s = 0.f; for (int r = 0; r < 64; ++r) s += red[r * 128 + tid];
            ((float*)(p.ws + WS_KM))[((size_t)(cb - 6) * 32 + rb) * 128 + tid] = s * (1.f / 256.f); }
    }
    __syncthreads();
}

__device__ __forceinline__ void sgu_item(const Params& p, int layer, int item) {
    const int tid = tid_opaque(), lane = tid & 63, wave = tid >> 6, r = lane & 31, h = lane >> 5;
    const int nc = item >> 2, g = item & 3;
    const int tb = wave >> 1;
    const float* W = p.sgu_w + ((size_t)layer * 4 + g) * 128 * 128;
    const bf16* vnt = (const bf16*)(p.ws + WS_VNT) + (size_t)(nc * 4 + g) * 128 * 128;
    const bf16* proj = (const bf16*)(p.ws + WS_PROJ);
    bf16* mix = (bf16*)(p.ws + WS_MIX);
    const int t = 32 * tb + r;
    f32x4 wl[8][2];
#pragma unroll
    for (int ks = 0; ks < 8; ++ks) { const int s0 = 16 * ks + 8 * h; wl[ks][0] = *(const f32x4*)(W + t * 128 + s0); wl[ks][1] = *(const f32x4*)(W + t * 128 + s0 + 4); }
    bf16x8 bfr[2][8];
#pragma unroll
    for (int cc = 0; cc < 2; ++cc)
#pragma unroll
        for (int ks = 0; ks < 8; ++ks) bfr[cc][ks] = *(const bf16x8*)(vnt + (size_t)(32 * ((wave & 1) * 2 + cc) + r) * 128 + 16 * ks + 8 * h);
    bf16x8 af[8];
#pragma unroll
    for (int ks = 0; ks < 8; ++ks) { const int s0 = 16 * ks + 8 * h;
        float wv[8] = {wl[ks][0].x, wl[ks][0].y, wl[ks][0].z, wl[ks][0].w, wl[ks][1].x, wl[ks][1].y, wl[ks][1].z, wl[ks][1].w};
#pragma unroll
        for (int e = 0; e < 8; ++e) wv[e] = (s0 + e <= t) ? wv[e] : 0.f;
        u32x4 au; au.x = pk2(wv[0], wv[1]); au.y = pk2(wv[2], wv[3]); au.z = pk2(wv[4], wv[5]); au.w = pk2(wv[6], wv[7]);
        af[ks] = __builtin_bit_cast(bf16x8, au); }
#pragma unroll
    for (int cc = 0; cc < 2; ++cc) {
        const int cbk = (wave & 1) * 2 + cc;
        const int c = 32 * cbk + r;
        unsigned short ur[16]; float br[16];
#pragma unroll
        for (int i = 0; i < 16; ++i) { const int tt = 32 * tb + crow(i, h); ur[i] = proj[((size_t)nc * 128 + tt) * INW + C_SU + g * 128 + c]; br[i] = p.sgu_b[((size_t)layer * 4 + g) * 128 + tt]; }
        f32x16 acc;
#pragma unroll
        for (int i = 0; i < 16; ++i) acc[i] = 0.f;
#pragma unroll
        for (int ks = 0; ks < 8; ++ks) acc = MFMA32(af[ks], bfr[cc][ks], acc);
#pragma unroll
        for (int i = 0; i < 16; ++i) {
            const int tt = 32 * tb + crow(i, h);
            const size_t tok = (size_t)nc * 128 + tt;
            const float u = gelu_t(__uint_as_float(((unsigned)ur[i]) << 16));
            const float o = u * (acc[i] + br[i]);
            mix[tok * DM + 1536 + g * 128 + c] = (bf16)(pk2(o, 0.f) & 0xffffu);
        }
    }
}

constexpr int KT_BYTES = 16384, VT_BYTES = 16384;
constexpr int ABUF = KT_BYTES + VT_BYTES;
constexpr float LOG2E = 1.4426950408889634f;

__device__ __forceinline__ void tile_dma(LAS unsigned char* slot, const bf16* proj, const bf16* vt, int kcol, int hh, int kbase, int wave, int lane) {
#pragma unroll
    for (int i = 0; i < 2; ++i) { const int c = i * 8 + wave, row = 4 * c + (lane >> 4), g = (lane & 15) ^ (row & 15);
        __builtin_amdgcn_global_load_lds((const unsigned*)(proj + (size_t)(kbase + row) * INW + kcol + g * 8), (LAS unsigned*)(slot + c * 1024), 16, 0, 0); }
#pragma unroll
    for (int i = 0; i < 2; ++i) { const int c = i * 8 + wave, row = 8 * c + (lane >> 3), g = (lane & 7) ^ ((row >> 1) & 7);
        __builtin_amdgcn_global_load_lds((const unsigned*)(vt + ((size_t)hh * 128 + row) * SEQ + kbase + g * 8), (LAS unsigned*)(slot + KT_BYTES + c * 1024), 16, 0, 0); }
}

#define TOP3_INSERT(v, n) do { if ((v) > v0 || ((v) == v0 && (n) < i0)) { v2 = v1; i2 = i1; v1 = v0; i1 = i0; v0 = (v); i0 = (n); } \
    else if ((v) > v1 || ((v) == v1 && (n) < i1)) { v2 = v1; i2 = i1; v1 = (v); i1 = (n); } \
    else if ((v) > v2 || ((v) == v2 && (n) < i2)) { v2 = (v); i2 = (n); } } while (0)
__device__ __forceinline__ unsigned moba_gate(const Params& p, int h, int own, const bf16x8 (&qf)[8], int lane) {
    const int r = lane & 31, hf = lane >> 5;
    unsigned selmask = 0u;
    if (own > 0) {
        f32x16 gt;
#pragma unroll
        for (int i = 0; i < 16; ++i) gt[i] = 0.f;
        const float* kmg = (const float*)(p.ws + WS_KM) + ((size_t)h * 32 + r) * 128 + 8 * hf;
#pragma unroll
        for (int ks = 0; ks < 8; ++ks) {
            const f32x4 a0 = *(const f32x4*)(kmg + 16 * ks), a1 = *(const f32x4*)(kmg + 16 * ks + 4);
            u32x4 hi; hi.x = pk2(a0.x, a0.y); hi.y = pk2(a0.z, a0.w); hi.z = pk2(a1.x, a1.y); hi.w = pk2(a1.z, a1.w);
            u32x4 lo; lo.x = pk2(a0.x - bf_lo(hi.x), a0.y - bf_hi(hi.x)); lo.y = pk2(a0.z - bf_lo(hi.y), a0.w - bf_hi(hi.y));
            lo.z = pk2(a1.x - bf_lo(hi.z), a1.y - bf_hi(hi.z)); lo.w = pk2(a1.z - bf_lo(hi.w), a1.w - bf_hi(hi.w));
            gt = MFMA32(__builtin_bit_cast(bf16x8, hi), qf[ks], gt);
            gt = MFMA32(__builtin_bit_cast(bf16x8, lo), qf[ks], gt);
        }
        float v0 = -INFINITY, v1 = -INFINITY, v2 = -INFINITY; int i0 = 64, i1 = 64, i2 = 64;
#pragma unroll
        for (int i = 0; i < 16; ++i) { const int n = crow(i, hf); if (n < own) TOP3_INSERT(gt[i], n); }
        const float pv0 = shx(v0, 32, lane), pv1 = shx(v1, 32, lane), pv2 = shx(v2, 32, lane);
        const int pi0 = shxi(i0, 32, lane), pi1 = shxi(i1, 32, lane), pi2 = shxi(i2, 32, lane);
        if (pi0 < 64) TOP3_INSERT(pv0, pi0);
        if (pi1 < 64) TOP3_INSERT(pv1, pi1);
        if (pi2 < 64) TOP3_INSERT(pv2, pi2);
        if (i0 < 64) selmask |= 1u << i0;
        if (i1 < 64) selmask |= 1u << i1;
        if (i2 < 64) selmask |= 1u << i2;
    }
    return selmask;
}
__device__ __forceinline__ void sel_item(const Params& p, int item) {
    const int tid = tid_opaque(), lane = tid & 63, wave = tid >> 6, r = lane & 31, hf = lane >> 5;
    const int h = item >> 5, qb = item & 31, q = qb * 256 + 32 * wave + r;
    const bf16* proj = (const bf16*)(p.ws + WS_PROJ);
    bf16x8 qf[8];
#pragma unroll
    for (int ks = 0; ks < 8; ++ks) qf[ks] = *(const bf16x8*)(proj + (size_t)q * INW + C_MQ + h * 128 + 16 * ks + 8 * hf);
    const unsigned mask = moba_gate(p, h, qb, qf, lane);
    if (hf == 0) ((unsigned*)(p.ws + WS_SEL))[(size_t)h * SEQ + q] = mask;
}
template <int MODE>
__device__ __forceinline__ void attn_unit(const Params& p, int layer, int h, int qb, LAS unsigned char* lds, int gq, bool gactive, int gj, int gtile0) {
    constexpr int NKS = MODE == 1 ? 4 : 8;
    const int tid = tid_opaque(), lane = tid & 63, wave = __builtin_amdgcn_readfirstlane(tid >> 6), r = lane & 31, hf = lane >> 5;
    const int grp = wave >> 2;
    const bf16* proj = (const bf16*)(p.ws + WS_PROJ);
    const bf16* vt = (const bf16*)(p.ws + WS_VT);
    bf16* mix = (bf16*)(p.ws + WS_MIX);
    int wrow0, ntiles, qcol, kcol, kc0, hh, tile0; float scale;
    if (MODE != 1) { wrow0 = MODE == 0 ? qb * 256 + 32 * wave : (1 << 20); tile0 = MODE == 0 ? 4 * qb : gtile0; ntiles = 4; qcol = C_MQ + h * 128; kcol = C_MK + h * 128; kc0 = 0; hh = h; scale = 0.08838834764831845f * LOG2E; }
    else { tile0 = 0; wrow0 = qb * 128 + 32 * (wave & 3); ntiles = 2 * (qb + 1); qcol = C_DQ + h * 128 + grp * 64; kcol = C_DK + h * 128; kc0 = grp * 64; hh = 6 + h; scale = 0.125f * LOG2E; }
    const LAS unsigned short* glist = (const LAS unsigned short*)(lds + 102400);
    int q;
    if (MODE == 2) { const int idx = gq + 32 * wave + r; q = glist[idx < gj ? idx : 0]; } else q = wrow0 + r;
    bf16x8 qf[NKS];
#pragma unroll
    for (int ks = 0; ks < NKS; ++ks) qf[ks] = *(const bf16x8*)(proj + (size_t)q * INW + qcol + 16 * ks + 8 * hf);
    f32x16 o[4];
#pragma unroll
    for (int d = 0; d < 4; ++d)
#pragma unroll
        for (int i = 0; i < 16; ++i) o[d][i] = 0.f;
    float m = -1e30f, l = 0.f;
    bf16x8 pf[4];
#pragma unroll
    for (int k = 0; k < 4; ++k) pf[k] = (bf16x8){0, 0, 0, 0, 0, 0, 0, 0};
    bool prev_on = false;
    tile_dma(lds, proj, vt, kcol, hh, tile0 * 64, wave, lane);
    const unsigned ck = (unsigned)(r * 256 + 16 * ((r & 15) ^ hf));
    const unsigned cv = (unsigned)(KT_BYTES + r * 128 + 16 * (((r >> 1) & 7) ^ hf));
    asm volatile("s_waitcnt vmcnt(0)" ::: "memory");
    __syncthreads();
#define ATTN_BACK(vbuf) do { _Pragma("unroll") for (int k4 = 0; k4 < 4; ++k4) { bf16x8 vf_[4]; \
        _Pragma("unroll") for (int d = 0; d < 4; ++d) { \
            const unsigned x_ = ((vbuf) + cv) ^ (unsigned)(32 * k4); \
            vf_[d] = *(const LAS bf16x8*)(lds + x_ + 4096 * d); } \
        __builtin_amdgcn_sched_barrier(0); \
        _Pragma("unroll") for (int d = 0; d < 4; ++d) o[d] = MFMA32(vf_[d], pf[k4], o[d]); \
        __builtin_amdgcn_sched_barrier(0); } } while (0)
    const bool defer = (MODE == 1) && (grp == 1);
    int slot = 0;
    for (int t = 0; t < ntiles; ++t) {
        const int kbase = (tile0 + t) * 64;
        const unsigned buf = (unsigned)(slot * ABUF);
        const unsigned bufp = (unsigned)((slot == 0 ? 2 : slot - 1) * ABUF);
        const int nslot = slot == 2 ? 0 : slot + 1;
        if (t + 1 < ntiles) tile_dma(lds + nslot * ABUF, proj, vt, kcol, hh, kbase + 64, wave, lane);
        if (defer && prev_on) ATTN_BACK(bufp);
        const bool lane_on = true;
        const bool wave_on = (MODE == 2) || (kbase <= wrow0 + 31);
        if (wave_on) {
            f32x16 s[2];
#pragma unroll
            for (int b = 0; b < 2; ++b) {
#pragma unroll
                for (int i = 0; i < 16; ++i) s[b][i] = 0.f;
#pragma unroll
                for (int k0 = 0; k0 < NKS; k0 += 4) {
                    bf16x8 kf[4];
#pragma unroll
                    for (int ks = 0; ks < 4; ++ks) kf[ks] = *(const LAS bf16x8*)(lds + ((buf + 8192u * b + ck) ^ (unsigned)(2 * kc0 + 32 * (k0 + ks))));
                    __builtin_amdgcn_sched_barrier(0);
#pragma unroll
                    for (int ks = 0; ks < 4; ++ks) s[b] = MFMA32(kf[ks], qf[k0 + ks], s[b]);
                    __builtin_amdgcn_sched_barrier(0);
                }
            }
            const bool diag = (MODE != 2) && (kbase + 63 > wrow0);
            float mx = -INFINITY;
            bool lane_off = false;
            if (diag) {
                asm volatile("" ::: "memory");
#pragma unroll
                for (int b = 0; b < 2; ++b)
#pragma unroll
                    for (int i = 0; i < 16; ++i) {
                        const int key = kbase + 32 * b + crow(i, hf);
                        const bool ok = lane_on && (key <= q);
                        s[b][i] = ok ? s[b][i] : -INFINITY;
                        mx = fmaxf(mx, s[b][i]);
                    }
            } else {
#pragma unroll
                for (int b = 0; b < 2; ++b)
#pragma unroll
                    for (int i = 0; i < 16; ++i) mx = fmaxf(mx, s[b][i]);
            }
            mx = fmaxf(mx, shx32(mx, lane));
            const float mn = fmaxf(m, mx);
            const float alpha = __builtin_amdgcn_exp2f((m - mn) * scale);
            const float mns = lane_off ? INFINITY : mn * scale;
            float ls = 0.f;
#pragma unroll
            for (int b = 0; b < 2; ++b)
#pragma unroll
                for (int i = 0; i < 16; ++i) { const float pv = __builtin_amdgcn_exp2f(s[b][i] * scale - mns); s[b][i] = pv; ls += pv; }
            l = l * alpha + ls;
            __builtin_amdgcn_sched_barrier(0);
            if (__builtin_amdgcn_ballot_w64(mn != m) != 0ull) {
#pragma unroll
                for (int d = 0; d < 4; ++d)
#pragma unroll
                    for (int i = 0; i < 16; ++i) o[d][i] *= alpha;
            }
            m = mn;
#pragma unroll
            for (int b = 0; b < 2; ++b)
#pragma unroll
                for (int ss = 0; ss < 2; ++ss) {
                    u32x4 pu;
                    pu.x = pk2(s[b][8 * ss + 0], s[b][8 * ss + 1]); pu.y = pk2(s[b][8 * ss + 2], s[b][8 * ss + 3]);
                    pu.z = pk2(s[b][8 * ss + 4], s[b][8 * ss + 5]); pu.w = pk2(s[b][8 * ss + 6], s[b][8 * ss + 7]);
                    pf[2 * b + ss] = __builtin_bit_cast(bf16x8, pu);
                }
            if (!defer) ATTN_BACK(buf);
        }
        prev_on = wave_on;
        slot = nslot;
        asm volatile("s_waitcnt vmcnt(0)" ::: "memory");
        __syncthreads();
    }
    if (defer && prev_on) { const unsigned bufp = (unsigned)((slot == 0 ? 2 : slot - 1) * ABUF); ATTN_BACK(bufp); }
#undef ATTN_BACK
    const float lt = l + shx(l, 32, lane);
    const float inv = 1.f / lt;
    if (MODE != 1) {
        int q2 = q, jj = 3; bool act = true;
        if (MODE == 2) {
            const int t2 = tid_opaque(), idx = gq + 32 * (t2 >> 6) + (t2 & 31); act = idx < gj; q2 = glist[act ? idx : 0];
            jj = __builtin_popcount(((const unsigned*)(p.ws + WS_SEL))[(size_t)h * SEQ + q2] & ((1u << (gtile0 >> 2)) - 1u)); }
        if (act) {
            unsigned* rec = (unsigned*)(p.ws + WS_PART) + (((size_t)h * SEQ + q2) * 4 + jj) * 68;
            if (hf == 0) { rec[0] = __float_as_uint(m * scale); rec[1] = __float_as_uint(lt); }
#pragma unroll
            for (int d = 0; d < 4; ++d)
#pragma unroll
                for (int g4 = 0; g4 < 4; ++g4) {
                    u32x2 w; w.x = pk2(o[d][4 * g4] * inv, o[d][4 * g4 + 1] * inv); w.y = pk2(o[d][4 * g4 + 2] * inv, o[d][4 * g4 + 3] * inv);
                    *(u32x2*)(rec + 4 + 16 * d + 4 * g4 + 2 * hf) = w;
                }
        }
    } else {
        __syncthreads();
        LAS float* ex = (LAS float*)lds;
        const int wi = wave & 3;
        if (wave >= 4) {
#pragma unroll
            for (int d = 0; d < 4; ++d)
#pragma unroll
                for (int i = 0; i < 16; ++i) ex[(wi * 64 + d * 16 + i) * 64 + lane] = o[d][i] * inv;
        }
        __syncthreads();
        if (wave < 4) {
            int ly = layer; asm volatile("" : "+s"(ly));
            float c08 = 0.8f, c06 = 0.6f; asm volatile("" : "+s"(c08), "+s"(c06));
            const float lin = c08 - c06 * __expf(-0.3f * (float)ly);
            const float* lp = p.diff_lambda + (size_t)ly * 256;
            const float la = wave_sum(lp[lane] * lp[64 + lane], lane), lb = wave_sum(lp[128 + lane] * lp[192 + lane], lane);
            const float lamv = __expf(la) - __expf(lb) + lin, oml = 1.f - lin;
            float ss = 0.f;
#pragma unroll
            for (int d = 0; d < 4; ++d) {
#pragma unroll
                for (int i = 0; i < 16; ++i) { const float v = o[d][i] * inv - lamv * ex[(wi * 64 + d * 16 + i) * 64 + lane]; o[d][i] = v; ss += v * v; }
                __builtin_amdgcn_sched_barrier(0);
            }
            ss += shx(ss, 32, lane);
            const float rs = rsqrtf(ss * (1.f / 128.f) + EPS) * oml;
            const float* sg = p.subln_g + (size_t)layer * 128;
#pragma unroll
            for (int d = 0; d < 4; ++d)
#pragma unroll
                for (int g4 = 0; g4 < 4; ++g4) {
                    const int dv = 32 * d + 8 * g4 + 4 * hf;
                    const f32x4 gg = *(const f32x4*)(sg + dv);
                    u32x2 w; w.x = pk2(o[d][4 * g4] * rs * gg.x, o[d][4 * g4 + 1] * rs * gg.y); w.y = pk2(o[d][4 * g4 + 2] * rs * gg.z, o[d][4 * g4 + 3] * rs * gg.w);
                    *(u32x2*)(mix + (size_t)q * DM + 768 + h * 128 + dv) = w;
                }
        }
        __syncthreads();
    }
}

__device__ __forceinline__ void gathered_unit(const Params& p, int layer, int h, int v, LAS unsigned char* lds) {
    const int tid = tid_opaque(), lane = tid & 63, wave = tid >> 6, r = lane & 31;
    int n, C; gat_decode(v, n, C);
    const int bs = (n + 1 > 8 * C) ? n + 1 : 8 * C, q0 = bs * 256, q1 = (8 * C + 8) * 256;
    LAS unsigned short* list = (LAS unsigned short*)(lds + 102400);
    LAS int* cnt = (LAS int*)(lds + LDS_MISC + 12);
    const unsigned* sel = (const unsigned*)(p.ws + WS_SEL) + (size_t)h * SEQ;
    if (tid == 0) *cnt = 0;
    __syncthreads();
    for (int q = q0 + tid; q < q1; q += NTHR)
        if ((sel[q] >> n) & 1u) { const int s = __hip_atomic_fetch_add(cnt, 1, __ATOMIC_RELAXED, __HIP_MEMORY_SCOPE_WORKGROUP); list[s] = (unsigned short)q; }
    __syncthreads();
    const int count = *(volatile LAS int*)cnt;
    for (int g0 = 0; g0 < count; g0 += 256) {
        attn_unit<2>(p, layer, h, 0, lds, g0, true, count, 4 * n);
        __syncthreads();
    }
}
__device__ __forceinline__ void phase_attn(const Params& p, int layer, LAS unsigned char* lds) {
    const int tid = tid_opaque();
    volatile LAS int* misc = (volatile LAS int*)(lds + LDS_MISC);
    unsigned* ctr = (unsigned*)(p.ws + WS_CTL) + layer;
    const int* order = (const int*)(p.ws + WS_ORDER);
    for (;;) {
        if (tid == 0) misc[0] = (int)atomicAdd(ctr, 1u);
        __syncthreads();
        const int idx = misc[0];
        __syncthreads();
        if (idx >= NU_ALL) break;
        const int u = order[idx];
        if (u < U_GAT) attn_unit<0>(p, layer, u >> 5, u & 31, lds, 0, true, 3, 0);
        else if (u < U_DIF) gathered_unit(p, layer, (u - U_GAT) / 76, (u - U_GAT) % 76, lds);
        else if (u < U_SGU) { const int w = u - U_DIF; attn_unit<1>(p, layer, w >> 6, w & 63, lds, 0, true, 0, 0); }
        else sgu_item(p, layer, u - U_SGU);
    }
}
__device__ __forceinline__ void phase_merge(const Params& p) {
    const int tid = tid_opaque(), lane = tid & 63, wave = tid >> 6;
    const int gw = blockIdx.x * NWAVES + wave, NGW = gridDim.x * NWAVES;
    bf16* mix = (bf16*)(p.ws + WS_MIX);
    for (int it = gw; it < 6 * SEQ; it += NGW) {
        const int h = it / SEQ, q = it % SEQ, cnt = (q >> 8) < 3 ? (q >> 8) : 3;
        const unsigned* rec = (const unsigned*)(p.ws + WS_PART) + ((size_t)h * SEQ + q) * 4 * 68;
        float mj[4], lj[4]; unsigned ow[4];
#pragma unroll
        for (int j = 0; j < 4; ++j) { const bool ok = (j == 3) || (j < cnt);
            mj[j] = ok ? __uint_as_float(rec[j * 68]) : -INFINITY; lj[j] = ok ? __uint_as_float(rec[j * 68 + 1]) : 0.f; ow[j] = ok ? rec[j * 68 + 4 + lane] : 0u; }
        const float M = fmaxf(fmaxf(mj[0], mj[1]), fmaxf(mj[2], mj[3]));
        float W = 0.f, a0 = 0.f, a1 = 0.f;
#pragma unroll
        for (int j = 0; j < 4; ++j) { const float w = lj[j] * __builtin_amdgcn_exp2f(mj[j] - M); W += w; a0 += w * bf_lo(ow[j]); a1 += w * bf_hi(ow[j]); }
        const float iw = 1.f / W;
        ((unsigned*)(mix + (size_t)q * DM + h * 128))[lane] = pk2(a0 * iw, a1 * iw);
    }
}

#define XB_TMO      128
#define XB_XCNT(j)  (256  + 64 * (j))
#define XB_XSUB(j)  (1280 + 64 * (j))
#define XB_XGEN(j)  (2304 + 64 * (j))
#define XB_TOP      3328
#define XB_TOPGEN   3392
#define XCD_BAR_WORDS 3456
#define XB_SPIN_CAP (1u << 18)

__device__ __forceinline__ unsigned xb_ld(unsigned* p)              { return __hip_atomic_load(p, __ATOMIC_RELAXED, __HIP_MEMORY_SCOPE_AGENT); }
__device__ __forceinline__ unsigned xb_add(unsigned* p, unsigned v) { return __hip_atomic_fetch_add(p, v, __ATOMIC_RELAXED, __HIP_MEMORY_SCOPE_AGENT); }
__device__ __forceinline__ unsigned xb_xcc_id() { return (unsigned)__builtin_amdgcn_s_getreg((3 << 11) | 20) & 0xFu; }
#define XB_SPIN(cond, bar) do { unsigned _sp = 0; while (cond) { __builtin_amdgcn_s_sleep(1); \
    if ((++_sp & 255u) == 0u) { if (xb_ld(&(bar)[XB_TMO])) break; if (_sp > XB_SPIN_CAP) { atomicAdd(&(bar)[XB_TMO], 1u); break; } } } } while (0)

struct XcdBarrier {
    unsigned* bar; unsigned x;
    volatile LAS unsigned* st;
};

__device__ __forceinline__ XcdBarrier xcd_barrier_post(unsigned* bar, volatile LAS unsigned* st) {
    XcdBarrier b; b.bar = bar; b.x = xb_xcc_id(); b.st = st;
    if (threadIdx.x == 0) (void)xb_add(&bar[XB_XCNT(b.x)], 1u);
    return b;
}
__device__ __forceinline__ void xcd_barrier_complete(unsigned* bar, unsigned x, unsigned& nloc, unsigned& nx) {
    const unsigned G = gridDim.x * gridDim.y * gridDim.z;
    unsigned sum, cnt, mine, sp = 0u;
    for (;;) {
        sum = 0u; cnt = 0u; mine = 0u;
#pragma unroll
        for (unsigned j = 0; j < 16; ++j) { const unsigned c = xb_ld(&bar[XB_XCNT(j)]); sum += c; cnt += (c > 0u) ? 1u : 0u; mine = (j == x) ? c : mine; }
        if (sum == G) break;
        __builtin_amdgcn_s_sleep(1);
        if ((++sp & 255u) == 0u) { if (xb_ld(&bar[XB_TMO])) break; if (sp > XB_SPIN_CAP) { atomicAdd(&bar[XB_TMO], 1u); break; } }
    }
    nloc = mine > 0u ? mine : 1u; nx = cnt > 0u ? cnt : 1u;
}

__device__ __forceinline__ void xcd_barrier(const XcdBarrier& b) {
    asm volatile("s_waitcnt vmcnt(0)" ::: "memory");
    __syncthreads();
    if (threadIdx.x == 0) {
        unsigned* bar = b.bar;
        __builtin_amdgcn_s_waitcnt(0);
        unsigned nloc = b.st[0], nx = b.st[1];
        if (nloc == 0u) { xcd_barrier_complete(bar, b.x, nloc, nx); b.st[0] = nloc; b.st[1] = nx; }
        const unsigned old = xb_add(&bar[XB_XSUB(b.x)], 1u);
        const unsigned gen = old / nloc;
        if (old + 1u == (gen + 1u) * nloc) {
            __builtin_amdgcn_fence(__ATOMIC_RELEASE, "agent");
            asm volatile("s_waitcnt vmcnt(0)" ::: "memory");
            const unsigned og = xb_add(&bar[XB_TOP], 1u);
            const unsigned tg = og / nx;
            if (og + 1u == (tg + 1u) * nx) xb_add(&bar[XB_TOPGEN], 1u);
            else XB_SPIN(xb_ld(&bar[XB_TOPGEN]) == tg, bar);
            __builtin_amdgcn_fence(__ATOMIC_ACQUIRE, "agent");
            xb_add(&bar[XB_XGEN(b.x)], 1u);
            asm volatile("s_waitcnt vmcnt(0)" ::: "memory");
        } else {
            XB_SPIN(xb_ld(&bar[XB_XGEN(b.x)]) == gen, bar);
            __builtin_amdgcn_fence(__ATOMIC_ACQUIRE, "agent");
            asm volatile("s_waitcnt vmcnt(0)" ::: "memory");
        }
    }
    __syncthreads();
}


__global__ void __launch_bounds__(NTHR, 2) trunk_fwd(Params p) {
    extern __shared__ __attribute__((aligned(16))) unsigned char lds_raw[];
    LAS unsigned char* lds = (LAS unsigned char*)lds_raw;
    cg::grid_group grid = cg::this_grid();
    const int G = gridDim.x, bid = blockIdx.x;
    unsigned char* ws = p.ws;
    bf16* H = (bf16*)(ws + WS_H); bf16* PROJ = (bf16*)(ws + WS_PROJ); bf16* MIX = (bf16*)(ws + WS_MIX); bf16* HID = (bf16*)(ws + WS_HID);

    volatile LAS unsigned* xst = (volatile LAS unsigned*)(lds + LDS_MISC + 64);
    if (threadIdx.x < 4) xst[threadIdx.x] = 0u;
    if (bid == 0) { unsigned* bw = (unsigned*)(ws + WS_BAR); for (int i = threadIdx.x; i < XCD_BAR_WORDS; i += NTHR) bw[i] = 0u; }
    phase_weights(p, lds);
    float* SS = (float*)(ws + WS_SS);
    phase_x0(p.x, H, SS);
    grid.sync();
    const XcdBarrier xb = xcd_barrier_post((unsigned*)(ws + WS_BAR), xst);
#define GRID_BAR() xcd_barrier(xb)
    for (int layer = 0; layer < DEPTH; ++layer) {
        {
            pg8::Gemm g{H, (const bf16*)(ws + WS_WIN) + (size_t)layer * INW * DM, SEQ, INW, DM}; pg8::StaticOrder S; S.init(SEQ, INW, G, bid);
            pg8::EpiBf16<0> E{PROJ, INW, SS + (size_t)(2 * layer) * SEQ * 32, 1.f / DM, (const LAS float*)(lds + 131072)};
            pg8::gemm_phase(lds, g, S, E);
        }
        GRID_BAR();
        for (int u = bid; u < 32 * 40; u += G) post_unit(p, layer, u, lds);
        GRID_BAR();
        for (int it = bid; it < 192; it += G) sel_item(p, it);
        GRID_BAR();
        phase_attn(p, layer, lds);
        GRID_BAR();
        phase_merge(p);
        GRID_BAR();
        {
            pg8::Gemm g{MIX, (const bf16*)(ws + WS_WOUT) + (size_t)layer * DM * DM, SEQ, DM, DM}; pg8::StaticOrder S; S.init(SEQ, DM, G, bid);
            pg8::EpiResid E{H, SS + (size_t)(2 * layer + 1) * SEQ * 32, DM};
            pg8::gemm_phase(lds, g, S, E);
        }
        GRID_BAR();
        {
            pg8::Gemm g{H, (const bf16*)(ws + WS_W1) + (size_t)layer * DFF * DM, SEQ, DFF, DM}; pg8::StaticOrder S; S.init(SEQ, DFF, G, bid);
            pg8::EpiBf16<1> E{HID, DFF, SS + (size_t)(2 * layer + 1) * SEQ * 32, 1.f / DM, (const LAS float*)(lds + 131072)};
            pg8::gemm_phase(lds, g, S, E);
        }
        GRID_BAR();
        {
            pg8::Gemm g{HID, (const bf16*)(ws + WS_W2) + (size_t)layer * DM * DFF, SEQ, DM, DFF}; pg8::StaticOrder S; S.init(SEQ, DM, G, bid);
            pg8::EpiResid E{H, SS + (size_t)(2 * layer + 2) * SEQ * 32, DM};
            pg8::gemm_phase(lds, g, S, E);
        }
        GRID_BAR();
    }
    phase_norm_f32(H, p.final_g, SS + (size_t)8 * SEQ * 32, p.out);
}

extern "C" void kernel_launch(void* const* d_in, const int* in_sizes, int n_in, void* d_out, int out_size, void* d_ws, size_t ws_size, hipStream_t stream) {
    static int grid_blocks = 0;
    if (grid_blocks == 0) {
        if (n_in != 14 || ws_size < WS_END) { fprintf(stderr, "kernel_launch: unexpected inputs (n_in %d, ws %zu, need %zu)\n", n_in, ws_size, (size_t)WS_END); grid_blocks = -1; return; }
        int dev = 0, cus = 0, per_cu = 0;
        hipGetDevice(&dev);
        hipDeviceGetAttribute(&cus, hipDeviceAttributeMultiprocessorCount, dev);
        hipFuncSetAttribute((const void*)trunk_fwd, hipFuncAttributeMaxDynamicSharedMemorySize, LDS_BYTES);
        hipOccupancyMaxActiveBlocksPerMultiprocessor(&per_cu, (const void*)trunk_fwd, NTHR, LDS_BYTES);
        if (per_cu < 1) per_cu = 1;
        grid_blocks = cus * per_cu;
        (void)hipGetLastError();
    }
    if (grid_blocks < 0) return;
    Params p{};
    p.x = (const float*)d_in[0]; p.attn_g = (const float*)d_in[1]; p.w_in = (const float*)d_in[2]; p.diff_lambda = (const float*)d_in[3]; p.subln_g = (const float*)d_in[4];
    p.sgu_ln_g = (const float*)d_in[5]; p.sgu_ln_b = (const float*)d_in[6]; p.sgu_w = (const float*)d_in[7]; p.sgu_b = (const float*)d_in[8]; p.w_out = (const float*)d_in[9];
    p.mlp_g = (const float*)d_in[10]; p.w1 = (const float*)d_in[11]; p.w2 = (const float*)d_in[12]; p.final_g = (const float*)d_in[13];
    p.out = (float*)d_out; p.ws = (unsigned char*)d_ws;
    void* args[] = {&p};
    hipError_t e = hipLaunchCooperativeKernel((const void*)trunk_fwd, dim3(grid_blocks), dim3(NTHR), args, LDS_BYTES, stream);
    if (e != hipSuccess) fprintf(stderr, "cooperative launch failed: %s (grid %d)\n", hipGetErrorString(e), grid_blocks);
}
```

```cpp
#include <hip/hip_runtime.h>
#include <hip/hip_cooperative_groups.h>
#include <cstdio>
#include <cstdint>
namespace cg = cooperative_groups;

namespace pg8 {
#define PG8_LAS __attribute__((address_space(3)))
typedef unsigned short bf16_t;
typedef short bf16x8 __attribute__((ext_vector_type(8)));
typedef float f32x4 __attribute__((ext_vector_type(4)));
typedef unsigned u32x4 __attribute__((ext_vector_type(4)));
typedef unsigned u32x2 __attribute__((ext_vector_type(2)));
constexpr int BM = 256, BK = 64, HALF = 128, HTB = HALF * BK * 2  , STAGE_BYTES = 8 * HTB, NXCD = 8, WGM = 4;

__host__ __device__ __forceinline__ int lds_byte(int r, int c) { const int st = (r >> 4) * 2 + (c >> 5), rr = r & 15, cc = c & 31, ob = rr * 64 + cc * 2; return st * 1024 + (ob ^ (((ob >> 9) & 1) << 5)); }
__host__ __device__ __forceinline__ void stage_rc(int b, int& R, int& C) { const int st = b / 1024, sb = b % 1024, swz = sb ^ (((sb >> 9) & 1) << 5); R = (st >> 1) * 16 + swz / 64; C = (st & 1) * 32 + (swz % 64) / 2; }
__host__ __device__ __forceinline__ int perm32(int rho) { const int n = rho >> 4, i = rho & 15; return 8 * (i >> 2) + 4 * n + (i & 3); }

struct Unit { int pm, pn, ui; };
struct Gemm { const bf16_t* A; const bf16_t* Bt; int M, N, K; };

struct StaticOrder {
    int nM, nN, nwg, G, c;
    __host__ __device__ void init(int M, int N, int G_, int c_) { nM = M / BM; nN = N / BM; nwg = nM * nN; G = G_; c = c_; }
    __host__ __device__ bool next(int i, Unit& u) const {
        const long L = (long)i * G + c; if (L >= nwg) return false;
        int wgid = (int)L; { const int q = nwg / NXCD, r = nwg % NXCD, xcd = wgid % NXCD, off = wgid / NXCD; wgid = (xcd < r ? xcd * (q + 1) : r * (q + 1) + (xcd - r) * q) + off; }
        const int nig = WGM * nN, gid = wgid / nig, fm = gid * WGM, gsz = (nM - fm) < WGM ? (nM - fm) : WGM;
        u.pm = fm + ((wgid % nig) % gsz); u.pn = (wgid % nig) / gsz; u.ui = i; return true;
    }
    __device__ __forceinline__ void a_ready(const Unit&) const {}
    __device__ __forceinline__ void done(const Unit&) const {}
};

typedef float f32x2 __attribute__((ext_vector_type(2)));
typedef __bf16 bf16x2_t __attribute__((ext_vector_type(2)));
__device__ __forceinline__ float shx(float v, int k, int lane) { return __int_as_float(__builtin_amdgcn_ds_bpermute((lane ^ k) << 2, __float_as_int(v))); }
__device__ __forceinline__ unsigned cvt_pk_bf16(float lo, float hi) { f32x2 v = {lo, hi}; bf16x2_t b = __builtin_convertvector(v, bf16x2_t); return __builtin_bit_cast(unsigned, b); }

struct EpiResid {
    static constexpr bool PERM = true, NEEDS_PREP = false;
    bf16_t* XB; float* SS; int ldc;
    __device__ __forceinline__ void operator()(const f32x4 (&acc)[2][2][4][2], const Unit& u, int wr, int wc, int fr, int fq) const {
        const int row0 = u.pm * BM + wr * 64 + fr, col0 = u.pn * BM + wc * 32 + 8 * fq;
        u32x4 xin[2][4][2];
#pragma unroll
        for (int ai = 0; ai < 2; ++ai)
#pragma unroll
            for (int m = 0; m < 4; ++m)
#pragma unroll
                for (int bj = 0; bj < 2; ++bj) xin[ai][m][bj] = *(const u32x4*)(XB + (size_t)(row0 + ai * HALF + m * 16) * ldc + col0 + bj * HALF);
#pragma unroll
        for (int ai = 0; ai < 2; ++ai)
#pragma unroll
            for (int m = 0; m < 4; ++m) { const int row = row0 + ai * HALF + m * 16; const size_t off = (size_t)row * ldc + col0; float part = 0.f;
#pragma unroll
                for (int bj = 0; bj < 2; ++bj) { const u32x4 xi = xin[ai][m][bj]; const f32x4 a0 = acc[ai][bj][m][0], a1 = acc[ai][bj][m][1];
                    u32x4 w;
                    w.x = cvt_pk_bf16(a0[0] + __uint_as_float(xi.x << 16), a0[1] + __uint_as_float(xi.x & 0xffff0000u));
                    w.y = cvt_pk_bf16(a0[2] + __uint_as_float(xi.y << 16), a0[3] + __uint_as_float(xi.y & 0xffff0000u));
                    w.z = cvt_pk_bf16(a1[0] + __uint_as_float(xi.z << 16), a1[1] + __uint_as_float(xi.z & 0xffff0000u));
                    w.w = cvt_pk_bf16(a1[2] + __uint_as_float(xi.w << 16), a1[3] + __uint_as_float(xi.w & 0xffff0000u));
                    *(u32x4*)(XB + off + bj * HALF) = w;
#pragma unroll
                    for (int e = 0; e < 4; ++e) { const float lo = __uint_as_float(w[e] << 16), hi = __uint_as_float(w[e] & 0xffff0000u); part += lo * lo + hi * hi; } }
                part += shx(part, 16, fq * 16 + fr); part += shx(part, 32, fq * 16 + fr);
                if (fq == 0) SS[(size_t)row * 32 + u.pn * 4 + wc] = part; }
    }
};
template <int ACT> struct EpiBf16 {
    static constexpr bool PERM = true;
    static constexpr bool NEEDS_PREP = true;
    bf16_t* O; int ldc; const float* SS; float inv_k; const PG8_LAS float* rstab;
    template <class Sched> __device__ __forceinline__ void prep(const Sched& S, int tid) const {
        PG8_LAS float* tab = (PG8_LAS float*)rstab;
#pragma unroll
        for (int k = 0; k < 2; ++k) { const int ui = (tid >> 8) + 2 * k; Unit u;
            if (S.next(ui, u)) { const f32x4* sp = (const f32x4*)(SS + (size_t)(u.pm * BM + (tid & 255)) * 32); float tot = 0.f;
#pragma unroll
                for (int j = 0; j < 8; ++j) { const f32x4 a = sp[j]; tot += (a[0] + a[1]) + (a[2] + a[3]); }
                tab[ui * 256 + (tid & 255)] = rsqrtf(tot * inv_k + 1e-6f); } }
    }
    __device__ __forceinline__ void operator()(const f32x4 (&acc)[2][2][4][2], const Unit& u, int wr, int wc, int fr, int fq) const {
        const int row0 = u.pm * BM + wr * 64 + fr; const int col0 = u.pn * BM + wc * 32 + 8 * fq;
        float rsv[2][4];
#pragma unroll
        for (int ai = 0; ai < 2; ++ai)
#pragma unroll
            for (int m = 0; m < 4; ++m) rsv[ai][m] = rstab[(u.ui & 3) * 256 + wr * 64 + fr + ai * HALF + m * 16];
#pragma unroll
        for (int ai = 0; ai < 2; ++ai)
#pragma unroll
            for (int m = 0; m < 4; ++m) { const int row = row0 + ai * HALF + m * 16; bf16_t* rowp = O + (size_t)row * ldc + col0;
                const float rs = rsv[ai][m];
#pragma unroll
                for (int bj = 0; bj < 2; ++bj) { f32x4 v0 = acc[ai][bj][m][0] * rs, v1 = acc[ai][bj][m][1] * rs;
                    if (ACT == 1) {
#pragma unroll
                        for (int j = 0; j < 4; ++j) { const float a = fmaxf(v0[j], 0.f), b = fmaxf(v1[j], 0.f); v0[j] = a * a; v1[j] = b * b; } }
                    u32x4 w; w.x = cvt_pk_bf16(v0[0], v0[1]); w.y = cvt_pk_bf16(v0[2], v0[3]); w.z = cvt_pk_bf16(v1[0], v1[1]); w.w = cvt_pk_bf16(v1[2], v1[3]);
                    *(u32x4*)(rowp + bj * HALF) = w; } }
    }
};

template <class Epi, class Sched>
__device__ __forceinline__ void gemm_phase(PG8_LAS unsigned char* lds, const Gemm g, const Sched& S, const Epi& E) {
    int tid_ = threadIdx.x; asm volatile("" : "+v"(tid_));
    const int tid = tid_, wid = __builtin_amdgcn_readfirstlane(tid >> 6), lane = tid & 63, wr = wid >> 2, wc = wid & 3, fr = lane & 15, fq = lane >> 4;
    const int K = g.K, nt = K / BK;
    unsigned voffA[2], voffB[2];
#pragma unroll
    for (int i = 0; i < 2; ++i) { int R, C; stage_rc(tid * 16 + i * 8192, R, C); const int Rb = Epi::PERM ? ((R & ~31) + perm32(R & 31)) : R;
        voffA[i] = (unsigned)(R * K + C) * 2u; voffB[i] = (unsigned)(Rb * K + C) * 2u; }
    const size_t kstep = (size_t)(BK * 2);
    const size_t hstep = (size_t)HALF * K * 2;
    const size_t tstep = 2 * hstep;
    const unsigned ldsw = (unsigned)wid * 1024u;
    const int aoff = lds_byte(wr * 64 + fr, fq * 8), boff = lds_byte(wc * 32 + fr, fq * 8);
#define PG8_SA(b, h) (((b) * 2 + (h)) * HTB)
#define PG8_SB(b, h) ((4 + (b) * 2 + (h)) * HTB)
#define PG8_STAGE(bufoff, gbase, voff) do { _Pragma("unroll") for (int _i = 0; _i < 2; ++_i) \
        __builtin_amdgcn_global_load_lds((const unsigned*)((const char*)(gbase) + (voff)[_i]), (PG8_LAS unsigned*)(lds + (bufoff) + ldsw + _i * 8192), 16, 0, 0); } while (0)
#define PG8_LDA(dst, b, h) do { _Pragma("unroll") for (int m = 0; m < 4; ++m) _Pragma("unroll") for (int k = 0; k < 2; ++k) dst[m][k] = *(const PG8_LAS bf16x8*)(lds + PG8_SA(b, h) + aoff + m * 2048 + k * 1024); } while (0)
#define PG8_LDB(dst, b, h) do { _Pragma("unroll") for (int n = 0; n < 2; ++n) _Pragma("unroll") for (int k = 0; k < 2; ++k) dst[n][k] = *(const PG8_LAS bf16x8*)(lds + PG8_SB(b, h) + boff + n * 2048 + k * 1024); } while (0)
#define PG8_MMA(ai, bj, At, Bt) do { __builtin_amdgcn_s_setprio(1); _Pragma("unroll") for (int m = 0; m < 4; ++m) _Pragma("unroll") for (int n = 0; n < 2; ++n) _Pragma("unroll") for (int k = 0; k < 2; ++k) \
        acc[ai][bj][m][n] = __builtin_amdgcn_mfma_f32_16x16x32_bf16(Bt[n][k], At[m][k], acc[ai][bj][m][n], 0, 0, 0); __builtin_amdgcn_s_setprio(0); } while (0)
#define PG8_WAIT_V(n) asm volatile("s_waitcnt vmcnt(" #n ")" ::: "memory")
#define PG8_WAIT_L(n) asm volatile("s_waitcnt lgkmcnt(" #n ")" ::: "memory")
#define PG8_BAR __builtin_amdgcn_s_barrier()
#define PG8_SCHED __builtin_amdgcn_sched_barrier(0)
    Unit cur, nxt; int ui = 0;
    if (!S.next(0, cur)) return;
    f32x4 acc[2][2][4][2];
#pragma unroll
    for (int a = 0; a < 2; ++a)
#pragma unroll
        for (int b = 0; b < 2; ++b)
#pragma unroll
            for (int m = 0; m < 4; ++m)
#pragma unroll
                for (int n = 0; n < 2; ++n) acc[a][b][m][n] = (f32x4){0.f, 0.f, 0.f, 0.f};
    bf16x8 At[4][2], B0[2][2], B1[2][2];
    const char* cA = (const char*)g.A + (size_t)cur.pm * tstep; const char* cB = (const char*)g.Bt + (size_t)cur.pn * tstep;
    if constexpr (Epi::NEEDS_PREP) { E.prep(S, tid); asm volatile("s_waitcnt lgkmcnt(0)" ::: "memory"); __builtin_amdgcn_s_barrier(); }
    S.a_ready(cur);
    PG8_STAGE(PG8_SB(0, 0), cB, voffB); PG8_STAGE(PG8_SB(0, 1), cB + hstep, voffB); PG8_STAGE(PG8_SA(0, 0), cA, voffA); PG8_STAGE(PG8_SA(0, 1), cA + hstep, voffA);
    if (wr == 1) PG8_BAR;
    PG8_WAIT_V(2); PG8_BAR;
    PG8_STAGE(PG8_SB(1, 0), cB + kstep, voffB); PG8_STAGE(PG8_SA(1, 0), cA + kstep, voffA); PG8_STAGE(PG8_SB(1, 1), cB + hstep + kstep, voffB);
    PG8_WAIT_V(6); PG8_BAR;
    for (;;) {
        const bool has_next = S.next(ui + 1, nxt);
        const char* nA = has_next ? (const char*)g.A + (size_t)nxt.pm * tstep : cA; const char* nB = has_next ? (const char*)g.Bt + (size_t)nxt.pn * tstep : cB;
        for (int t = 0; t < nt; t += 2) {
            const bool last = (t == nt - 2);
            const char* a1 = cA + (size_t)(t + 1) * kstep;
            const char* a2 = last ? nA : cA + (size_t)(t + 2) * kstep; const char* b2 = last ? nB : cB + (size_t)(t + 2) * kstep;
            const char* a3 = a2 + kstep; const char* b3 = b2 + kstep;
            if (last && has_next) S.a_ready(nxt);
            PG8_LDB(B0, 0, 0); PG8_LDB(B1, 0, 1); PG8_SCHED; PG8_LDA(At, 0, 0); PG8_STAGE(PG8_SA(1, 1), a1 + hstep, voffA);
            PG8_WAIT_V(8); PG8_WAIT_L(0); PG8_BAR; PG8_MMA(0, 0, At, B0); PG8_MMA(0, 1, At, B1); PG8_BAR; PG8_SCHED;
            PG8_LDA(At, 0, 1); PG8_STAGE(PG8_SB(0, 0), b2, voffB); PG8_STAGE(PG8_SB(0, 1), b2 + hstep, voffB); PG8_STAGE(PG8_SA(0, 0), a2, voffA);
            PG8_WAIT_V(8); PG8_WAIT_L(0); PG8_BAR; PG8_MMA(1, 0, At, B0); PG8_MMA(1, 1, At, B1); PG8_BAR; PG8_SCHED;
            PG8_LDB(B0, 1, 0); PG8_LDB(B1, 1, 1); PG8_SCHED; PG8_LDA(At, 1, 0); PG8_STAGE(PG8_SA(0, 1), a2 + hstep, voffA);
            PG8_WAIT_V(8); PG8_WAIT_L(0); PG8_BAR; PG8_MMA(0, 0, At, B0); PG8_MMA(0, 1, At, B1); PG8_BAR; PG8_SCHED;
            PG8_LDA(At, 1, 1); PG8_STAGE(PG8_SB(1, 0), b3, voffB); PG8_STAGE(PG8_SB(1, 1), b3 + hstep, voffB); PG8_STAGE(PG8_SA(1, 0), a3, voffA);
            PG8_WAIT_V(8); PG8_WAIT_L(0); PG8_BAR; PG8_MMA(1, 0, At, B0); PG8_MMA(1, 1, At, B1); PG8_BAR; PG8_SCHED;
        }
        if (wr == 0) PG8_BAR;
        E(acc, cur, wr, wc, fr, fq); S.done(cur);
        if (!has_next) break;
#pragma unroll
        for (int a = 0; a < 2; ++a)
#pragma unroll
            for (int b = 0; b < 2; ++b)
#pragma unroll
                for (int m = 0; m < 4; ++m)
#pragma unroll
                    for (int n = 0; n < 2; ++n) acc[a][b][m][n] = (f32x4){0.f, 0.f, 0.f, 0.f};
        cur = nxt; cA = nA; cB = nB; ++ui;
        if (wr == 1) PG8_BAR;
    }
    PG8_WAIT_V(0);
    PG8_BAR;
#undef PG8_SA
#undef PG8_SB
#undef PG8_STAGE
#undef PG8_LDA
#undef PG8_LDB
#undef PG8_MMA
#undef PG8_WAIT_V
#undef PG8_WAIT_L
#undef PG8_BAR
#undef PG8_SCHED
}
}

constexpr int SEQ = 8192, DM = 2048, DEPTH = 4, INW = 5632, DFF = 8192;
constexpr int C_MQ = 0, C_MK = 768, C_MV = 1536, C_DQ = 2304, C_DK = 3072, C_DV = 3840, C_SU = 4608, C_SV = 5120;
constexpr int NWAVES = 8, NTHR = 512;
constexpr int LDS_BYTES = 147456;
constexpr int LDS_MISC = 139264;
constexpr float EPS = 1e-6f;

constexpr size_t WS_CTL = 0;
constexpr size_t WS_BAR = 16384;
constexpr size_t WS_ORDER = 4096;
constexpr size_t WS_WIN = 65536;
constexpr size_t WS_WOUT = WS_WIN + (size_t)DEPTH * INW * DM * 2;
constexpr size_t WS_W1 = WS_WOUT + (size_t)DEPTH * DM * DM * 2;
constexpr size_t WS_W2 = WS_W1 + (size_t)DEPTH * DFF * DM * 2;
constexpr size_t WS_XRES = WS_W2 + (size_t)DEPTH * DM * DFF * 2;
constexpr size_t WS_H = WS_XRES + (size_t)SEQ * DM * 4;
constexpr size_t WS_PROJ = WS_H + (size_t)SEQ * DM * 2;
constexpr size_t WS_VT = WS_PROJ + (size_t)SEQ * INW * 2;
constexpr size_t WS_VNT = WS_VT + (size_t)12 * 128 * SEQ * 2;
constexpr size_t WS_KM = WS_VNT + (size_t)SEQ * 512 * 2;
constexpr size_t WS_SEL = WS_KM + (size_t)6 * 32 * 128 * 4;
constexpr size_t WS_MIX = WS_SEL + (size_t)6 * SEQ * 4;
constexpr size_t WS_HID = WS_MIX + (size_t)SEQ * DM * 2;
constexpr size_t WS_SS = WS_HID + (size_t)SEQ * DFF * 2;
constexpr size_t WS_END = WS_SS + (size_t)9 * SEQ * 32 * 4;

#define LAS __attribute__((address_space(3)))
typedef unsigned short bf16;
typedef short bf16x8 __attribute__((ext_vector_type(8)));
typedef short s16x4 __attribute__((ext_vector_type(4)));
typedef float f32x4 __attribute__((ext_vector_type(4)));
typedef float f32x16 __attribute__((ext_vector_type(16)));
typedef unsigned u32x4 __attribute__((ext_vector_type(4)));
typedef unsigned u32x2 __attribute__((ext_vector_type(2)));
#define MFMA32(a, b, c) __builtin_amdgcn_mfma_f32_32x32x16_bf16((a), (b), (c), 0, 0, 0)

__device__ __forceinline__ unsigned pk2(float lo, float hi) { return pg8::cvt_pk_bf16(lo, hi); }
__device__ __forceinline__ float bf_lo(unsigned w) { return __uint_as_float(w << 16); }
__device__ __forceinline__ float bf_hi(unsigned w) { return __uint_as_float(w & 0xffff0000u); }
__device__ __forceinline__ float shx(float v, int k, int lane) { return __int_as_float(__builtin_amdgcn_ds_bpermute((lane ^ k) << 2, __float_as_int(v))); }
__device__ __forceinline__ int shxi(int v, int k, int lane) { return __builtin_amdgcn_ds_bpermute((lane ^ k) << 2, v); }
__device__ __forceinline__ float shx32(float v, int lane) { const unsigned u = __float_as_uint(v); const auto r = __builtin_amdgcn_permlane32_swap(u, u, false, false); return __uint_as_float((lane >> 5) ? r[0] : r[1]); }
__device__ __forceinline__ float wave_sum(float v, int lane) {
#pragma unroll
    for (int o = 1; o < 64; o <<= 1) v += shx(v, o, lane);
    return v;
}
__device__ __forceinline__ float gelu_t(float x) {
    const float u = 0.7978845608028654f * (x + 0.044715f * x * x * x);
    const float e = __expf(2.f * u);
    const float th = 1.f - 2.f / (e + 1.f);
    return 0.5f * x * (1.f + th);
}
__device__ __forceinline__ int tid_opaque() { int t = threadIdx.x; asm volatile("" : "+v"(t)); return t; }
__device__ __forceinline__ int crow(int reg, int h) { return (reg & 3) + 8 * (reg >> 2) + 4 * h; }

struct Params {
    const float* x; const float* attn_g; const float* w_in; const float* diff_lambda; const float* subln_g;
    const float* sgu_ln_g; const float* sgu_ln_b; const float* sgu_w; const float* sgu_b; const float* w_out;
    const float* mlp_g; const float* w1; const float* w2; const float* final_g;
    float* out; unsigned char* ws;
};

__device__ __forceinline__ void transpose_item(const float* W, int K, int N, bf16* WT, LAS float* scr, int item, int lane, const float* gk) {
    const int nblk = N / 32, kb = item / nblk, nb = item % nblk, k0 = 64 * kb, n0 = 32 * nb;
    float wv[32];
#pragma unroll
    for (int i = 0; i < 32; ++i) { const int kk = 2 * i + (lane >> 5); wv[i] = __builtin_nontemporal_load(W + (size_t)(k0 + kk) * N + n0 + (lane & 31)); }
    if (gk) {
#pragma unroll
        for (int i = 0; i < 32; ++i) wv[i] *= gk[k0 + 2 * i + (lane >> 5)];
    }
#pragma unroll
    for (int i = 0; i < 32; ++i) { const int kk = 2 * i + (lane >> 5); scr[kk * 33 + (lane & 31)] = wv[i]; }
    asm volatile("s_waitcnt lgkmcnt(0)" ::: "memory");
    const int c = lane & 7;
#pragma unroll
    for (int j = 0; j < 4; ++j) { const int n = (lane >> 3) + 8 * j; const LAS float* s = scr + (8 * c) * 33 + n;
        u32x4 o; o.x = pk2(s[0 * 33], s[1 * 33]); o.y = pk2(s[2 * 33], s[3 * 33]); o.z = pk2(s[4 * 33], s[5 * 33]); o.w = pk2(s[6 * 33], s[7 * 33]);
        *(u32x4*)(WT + (size_t)(n0 + n) * K + k0 + 8 * c) = o; }
    asm volatile("s_waitcnt lgkmcnt(0)" ::: "memory");
}

constexpr int NU_OWN = 192, NU_GAT = 456, NU_DIF = 384, NU_SGU = 256;
constexpr int U_GAT = NU_OWN, U_DIF = U_GAT + NU_GAT, U_SGU = U_DIF + NU_DIF, NU_ALL = U_SGU + NU_SGU;
constexpr size_t WS_PART = WS_XRES;
__device__ __forceinline__ void gat_decode(int v, int& n, int& C) {
    if (v < 28) { n = v >> 2; C = v & 3; }
    else if (v < 52) { const int w = v - 28; n = 7 + w / 3; C = 1 + w % 3; }
    else if (v < 68) { const int w = v - 52; n = 15 + (w >> 1); C = 2 + (w & 1); }
    else { n = 23 + (v - 68); C = 3; }
}
__device__ __forceinline__ float unit_cost(int u) {
    if (u < U_GAT) return 3.0f;
    if (u < U_DIF) { int n, C; gat_decode((u - U_GAT) % 76, n, C); const int bs = (n + 1 > 8 * C) ? n + 1 : 8 * C; float cnt = 0.f;
        for (int b = bs; b < 8 * C + 8; ++b) cnt += 256.f * (b < 3 ? (float)b : 3.f) / (float)b;
        return 4.0f * (cnt * (1.f / 256.f) + 0.5f); }
    if (u < U_SGU) return 1.7f * (float)(((u - U_DIF) & 63) + 1);
    return 0.5f;
}

__device__ __forceinline__ void phase_weights(const Params& p, LAS unsigned char* lds) {
    const int tid = tid_opaque(), lane = tid & 63, wave = tid >> 6;
    LAS float* scr = (LAS float*)(lds + wave * 16384);
    const int gw = blockIdx.x * NWAVES + wave, NGW = gridDim.x * NWAVES;
    constexpr int I_IN = (DM / 64) * (INW / 32), I_OUT = (DM / 64) * (DM / 32), I_1 = (DM / 64) * (DFF / 32), I_2 = (DFF / 64) * (DM / 32);
    constexpr int PER_LAYER = I_IN + I_OUT + I_1 + I_2;
    for (int it = gw; it < DEPTH * PER_LAYER; it += NGW) {
        const int l = it / PER_LAYER; int r = it % PER_LAYER;
        if (r < I_IN) { transpose_item(p.w_in + (size_t)l * DM * INW, DM, INW, (bf16*)(p.ws + WS_WIN) + (size_t)l * INW * DM, scr, r, lane, p.attn_g + (size_t)l * DM); continue; } r -= I_IN;
        if (r < I_OUT) { transpose_item(p.w_out + (size_t)l * DM * DM, DM, DM, (bf16*)(p.ws + WS_WOUT) + (size_t)l * DM * DM, scr, r, lane, nullptr); continue; } r -= I_OUT;
        if (r < I_1) { transpose_item(p.w1 + (size_t)l * DM * DFF, DM, DFF, (bf16*)(p.ws + WS_W1) + (size_t)l * DFF * DM, scr, r, lane, p.mlp_g + (size_t)l * DM); continue; } r -= I_1;
        transpose_item(p.w2 + (size_t)l * DFF * DM, DFF, DM, (bf16*)(p.ws + WS_W2) + (size_t)l * DM * DFF, scr, r, lane, nullptr);
    }
    if (blockIdx.x == 0) {
        unsigned* ctl = (unsigned*)(p.ws + WS_CTL);
        if (tid < 64) ctl[tid] = 0u;
        int* order = (int*)(p.ws + WS_ORDER);
        LAS float* cst = (LAS float*)(lds + 65536);
        __syncthreads();
        for (int u = tid; u < NU_ALL; u += NTHR) cst[u] = unit_cost(u);
        __syncthreads();
        for (int u = tid; u < NU_ALL; u += NTHR) {
            const float cu = cst[u]; int rank = 0;
            for (int j = 0; j < NU_ALL; ++j) { const float cj = cst[j]; rank += (cj > cu || (cj == cu && j < u)) ? 1 : 0; }
            order[rank] = u;
        }
    }
}

__device__ __forceinline__ void phase_x0(const float* X, bf16* XB, float* SS0) {
    const int tid = tid_opaque(), lane = tid & 63, wave = tid >> 6;
    const int gw = blockIdx.x * NWAVES + wave, NGW = gridDim.x * NWAVES;
    for (int m = gw; m < SEQ; m += NGW) {
        const f32x4* xr = (const f32x4*)(X + (size_t)m * DM) + lane;
        f32x4 v[8]; float s = 0.f;
#pragma unroll
        for (int j = 0; j < 8; ++j) { v[j] = xr[64 * j]; s += (v[j].x * v[j].x + v[j].y * v[j].y) + (v[j].z * v[j].z + v[j].w * v[j].w); }
        s = wave_sum(s, lane);
        if (lane < 32) SS0[(size_t)m * 32 + lane] = lane == 0 ? s : 0.f;
        u32x2* o8 = (u32x2*)(XB + (size_t)m * DM) + lane;
#pragma unroll
        for (int j = 0; j < 8; ++j) { u32x2 w; w.x = pk2(v[j].x, v[j].y); w.y = pk2(v[j].z, v[j].w); o8[64 * j] = w; }
    }
}
__device__ __forceinline__ void phase_norm_f32(const bf16* X, const float* g, const float* SS, float* O) {
    const int tid = tid_opaque(), lane = tid & 63, wave = tid >> 6;
    const int gw = blockIdx.x * NWAVES + wave, NGW = gridDim.x * NWAVES;
    for (int m = gw; m < SEQ; m += NGW) {
        const u32x4* xr = (const u32x4*)(X + (size_t)m * DM) + lane;
        const float rs = rsqrtf(wave_sum(lane < 32 ? SS[(size_t)m * 32 + lane] : 0.f, lane) * (1.f / DM) + EPS);
        f32x4* o = (f32x4*)(O + (size_t)m * DM) + 2 * lane;
#pragma unroll
        for (int j = 0; j < 4; ++j) { const u32x4 xv = xr[64 * j]; const f32x4 g0 = ((const f32x4*)g)[2 * lane + 128 * j], g1 = ((const f32x4*)g)[2 * lane + 128 * j + 1];
            o[128 * j] = (f32x4){bf_lo(xv.x), bf_hi(xv.x), bf_lo(xv.y), bf_hi(xv.y)} * rs * g0;
            o[128 * j + 1] = (f32x4){bf_lo(xv.z), bf_hi(xv.z), bf_lo(xv.w), bf_hi(xv.w)} * rs * g1; }
    }
}

constexpr int TP_STRIDE = 132;
__device__ __forceinline__ void post_unit(const Params& p, int layer, int unit, LAS unsigned char* lds) {
    const int tid = tid_opaque();
    const int rb = unit / 40, cbi = unit % 40, cb = cbi < 36 ? cbi : cbi + 4;
    const int col0 = cb * 128;
    const int r64 = tid >> 3, j = tid & 7;
    bf16* proj = (bf16*)(p.ws + WS_PROJ);
    int type;
    int hh = 0;
    if (cb < 6) type = 0; else if (cb < 12) type = 1; else if (cb < 18) { type = 2; hh = cb - 12; } else if (cb < 30) type = 3; else if (cb < 36) { type = 2; hh = 6 + cb - 30; } else { type = 4; hh = cb - 40; }
    int c0, c1;
    if (type <= 1) { c0 = 8 * j; c1 = c0 + 64; }
    else if (type == 3) { c0 = (j < 4) ? 8 * j : 64 + 8 * (j - 4); c1 = c0 + 32; }
    else { c0 = 16 * j; c1 = c0 + 8; }
    double inv2pi[8];
    if (type <= 1 || type == 3) {
        const float half = (type == 3) ? 32.f : 64.f; const int i0 = (type == 3) ? 8 * (j & 3) : 8 * j;
#pragma unroll
        for (int e = 0; e < 8; ++e) inv2pi[e] = (double)exp2f(-(float)(i0 + e) * (13.287712379549449f / half)) * 0.15915494309189535;
    } else {
#pragma unroll
        for (int e = 0; e < 8; ++e) inv2pi[e] = 0.0;
    }
    float csa[8], csb[8];
#pragma unroll
    for (int e = 0; e < 8; ++e) { csa[e] = 0.f; csb[e] = 0.f; }
    LAS bf16* tile = (LAS bf16*)lds;
    u32x4 na = *(const u32x4*)(proj + (size_t)(rb * 256 + r64) * INW + col0 + c0), nb = *(const u32x4*)(proj + (size_t)(rb * 256 + r64) * INW + col0 + c1);
    for (int sub = 0; sub < 4; ++sub) {
        const int row = rb * 256 + sub * 64 + r64;
        bf16* rp = proj + (size_t)row * INW + col0;
        const u32x4 ua = na, ub = nb;
        if (sub < 3) { na = *(const u32x4*)(rp + (size_t)64 * INW + c0); nb = *(const u32x4*)(rp + (size_t)64 * INW + c1); }
        float xa[8], xb[8];
#pragma unroll
        for (int e = 0; e < 4; ++e) { xa[2 * e] = bf_lo(ua[e]); xa[2 * e + 1] = bf_hi(ua[e]); xb[2 * e] = bf_lo(ub[e]); xb[2 * e + 1] = bf_hi(ub[e]); }
        if (type <= 1 || type == 3) {
            float ya[8], yb[8];
#pragma unroll
            for (int e = 0; e < 8; ++e) {
                double rev = (double)row * inv2pi[e]; rev -= floor(rev);
                const float fr = (float)rev;
                const float sn = __builtin_amdgcn_sinf(fr), cs = __builtin_amdgcn_cosf(fr);
                ya[e] = xa[e] * cs - xb[e] * sn; yb[e] = xb[e] * cs + xa[e] * sn;
                csa[e] += ya[e]; csb[e] += yb[e];
            }
            u32x4 oa, ob;
#pragma unroll
            for (int e = 0; e < 4; ++e) { oa[e] = pk2(ya[2 * e], ya[2 * e + 1]); ob[e] = pk2(yb[2 * e], yb[2 * e + 1]); }
            *(u32x4*)(rp + c0) = oa; *(u32x4*)(rp + c1) = ob;
        } else {
            u32x4 oa = ua, ob = ub;
            if (type == 4) {
                float s = 0.f;
#pragma unroll
                for (int e = 0; e < 8; ++e) { xa[e] = gelu_t(xa[e]); xb[e] = gelu_t(xb[e]); s += xa[e] + xb[e]; }
                s += shx(s, 1, tid & 63); s += shx(s, 2, tid & 63); s += shx(s, 4, tid & 63);
                const float mu = s * (1.f / 128.f); float s2 = 0.f;
#pragma unroll
                for (int e = 0; e < 8; ++e) { xa[e] -= mu; xb[e] -= mu; s2 += xa[e] * xa[e] + xb[e] * xb[e]; }
                s2 += shx(s2, 1, tid & 63); s2 += shx(s2, 2, tid & 63); s2 += shx(s2, 4, tid & 63);
                const float rstd = rsqrtf(s2 * (1.f / 128.f) + EPS);
                const float* lg = p.sgu_ln_g + ((size_t)layer * 4 + hh) * 128; const float* lb = p.sgu_ln_b + ((size_t)layer * 4 + hh) * 128;
#pragma unroll
                for (int e = 0; e < 8; ++e) { xa[e] = xa[e] * rstd * lg[c0 + e] + lb[c0 + e]; xb[e] = xb[e] * rstd * lg[c1 + e] + lb[c1 + e]; }
#pragma unroll
                for (int e = 0; e < 4; ++e) { oa[e] = pk2(xa[2 * e], xa[2 * e + 1]); ob[e] = pk2(xb[2 * e], xb[2 * e + 1]); }
            }
            __syncthreads();
            LAS u32x2* t0 = (LAS u32x2*)(tile + r64 * TP_STRIDE + c0);
            t0[0] = (u32x2){oa.x, oa.y}; t0[1] = (u32x2){oa.z, oa.w}; t0[2] = (u32x2){ob.x, ob.y}; t0[3] = (u32x2){ob.z, ob.w};
            __syncthreads();
            const int dv = tid >> 2, ch = tid & 3;
            unsigned w[8];
#pragma unroll
            for (int k = 0; k < 8; ++k) { const unsigned lo = tile[(16 * ch + 2 * k) * TP_STRIDE + dv], hi = tile[(16 * ch + 2 * k + 1) * TP_STRIDE + dv]; w[k] = lo | (hi << 16); }
            bf16* dst;
            if (type == 2) dst = (bf16*)(p.ws + WS_VT) + ((size_t)hh * 128 + dv) * SEQ + rb * 256 + sub * 64 + 16 * ch;
            else dst = (bf16*)(p.ws + WS_VNT) + ((size_t)((rb * 2 + (sub >> 1)) * 4 + hh) * 128 + dv) * 128 + (sub & 1) * 64 + 16 * ch;
            if (type == 2) { *(u32x4*)dst = (u32x4){w[0], w[1], w[4], w[5]}; *(u32x4*)(dst + 8) = (u32x4){w[2], w[3], w[6], w[7]}; }
            else { *(u32x4*)dst = (u32x4){w[0], w[1], w[2], w[3]}; *(u32x4*)(dst + 8) = (u32x4){w[4], w[5], w[6], w[7]}; }
        }
    }
    if (type == 1) {
        __syncthreads();
        LAS float* red = (LAS float*)lds;
#pragma unroll
        for (int e = 0; e < 8; ++e) { red[r64 * 128 + c0 + e] = csa[e]; red[r64 * 128 + c1 + e] = csb[e]; }
        __syncthreads();
        if (tid < 128) { float s = 0.f; for (int r = 0; r < 64; ++r) s += red[r * 128 + tid];
            ((float*)(p.ws + WS_KM))[((size_t)(cb - 6) * 32 + rb) * 128 + tid] = s * (1.f / 256.f); }
    }
    __syncthreads();
}

__device__ __forceinline__ void sgu_item(const Params& p, int layer, int item) {
    const int tid = tid_opaque(), lane = tid & 63, wave = tid >> 6, r = lane & 31, h = lane >> 5;
    const int nc = item >> 2, g = item & 3;
    const int tb = wave >> 1;
    const float* W = p.sgu_w + ((size_t)layer * 4 + g) * 128 * 128;
    const bf16* vnt = (const bf16*)(p.ws + WS_VNT) + (size_t)(nc * 4 + g) * 128 * 128;
    const bf16* proj = (const bf16*)(p.ws + WS_PROJ);
    bf16* mix = (bf16*)(p.ws + WS_MIX);
    const int t = 32 * tb + r;
    f32x4 wl[8][2];
#pragma unroll
    for (int ks = 0; ks < 8; ++ks) { const int s0 = 16 * ks + 8 * h; wl[ks][0] = *(const f32x4*)(W + t * 128 + s0); wl[ks][1] = *(const f32x4*)(W + t * 128 + s0 + 4); }
    bf16x8 bfr[2][8];
#pragma unroll
    for (int cc = 0; cc < 2; ++cc)
#pragma unroll
        for (int ks = 0; ks < 8; ++ks) bfr[cc][ks] = *(const bf16x8*)(vnt + (size_t)(32 * ((wave & 1) * 2 + cc) + r) * 128 + 16 * ks + 8 * h);
    bf16x8 af[8];
#pragma unroll
    for (int ks = 0; ks < 8; ++ks) { const int s0 = 16 * ks + 8 * h;
        float wv[8] = {wl[ks][0].x, wl[ks][0].y, wl[ks][0].z, wl[ks][0].w, wl[ks][1].x, wl[ks][1].y, wl[ks][1].z, wl[ks][1].w};
#pragma unroll
        for (int e = 0; e < 8; ++e) wv[e] = (s0 + e <= t) ? wv[e] : 0.f;
        u32x4 au; au.x = pk2(wv[0], wv[1]); au.y = pk2(wv[2], wv[3]); au.z = pk2(wv[4], wv[5]); au.w = pk2(wv[6], wv[7]);
        af[ks] = __builtin_bit_cast(bf16x8, au); }
#pragma unroll
    for (int cc = 0; cc < 2; ++cc) {
        const int cbk = (wave & 1) * 2 + cc;
        const int c = 32 * cbk + r;
        unsigned short ur[16]; float br[16];
#pragma unroll
        for (int i = 0; i < 16; ++i) { const int tt = 32 * tb + crow(i, h); ur[i] = proj[((size_t)nc * 128 + tt) * INW + C_SU + g * 128 + c]; br[i] = p.sgu_b[((size_t)layer * 4 + g) * 128 + tt]; }
        f32x16 acc;
#pragma unroll
        for (int i = 0; i < 16; ++i) acc[i] = 0.f;
#pragma unroll
        for (int ks = 0; ks < 8; ++ks) acc = MFMA32(af[ks], bfr[cc][ks], acc);
#pragma unroll
        for (int i = 0; i < 16; ++i) {
            const int tt = 32 * tb + crow(i, h);
            const size_t tok = (size_t)nc * 128 + tt;
            const float u = gelu_t(__uint_as_float(((unsigned)ur[i]) << 16));
            const float o = u * (acc[i] + br[i]);
            mix[tok * DM + 1536 + g * 128 + c] = (bf16)(pk2(o, 0.f) & 0xffffu);
        }
    }
}

constexpr int KT_BYTES = 16384, VT_BYTES = 16384;
constexpr int ABUF = KT_BYTES + VT_BYTES;
constexpr float LOG2E = 1.4426950408889634f;

__device__ __forceinline__ void tile_dma(LAS unsigned char* slot, const bf16* proj, const bf16* vt, int kcol, int hh, int kbase, int wave, int lane) {
#pragma unroll
    for (int i = 0; i < 2; ++i) { const int c = i * 8 + wave, row = 4 * c + (lane >> 4), g = (lane & 15) ^ (row & 15);
        __builtin_amdgcn_global_load_lds((const unsigned*)(proj + (size_t)(kbase + row) * INW + kcol + g * 8), (LAS unsigned*)(slot + c * 1024), 16, 0, 0); }
#pragma unroll
    for (int i = 0; i < 2; ++i) { const int c = i * 8 + wave, row = 8 * c + (lane >> 3), g = (lane & 7) ^ ((row >> 1) & 7);
        __builtin_amdgcn_global_load_lds((const unsigned*)(vt + ((size_t)hh * 128 + row) * SEQ + kbase + g * 8), (LAS unsigned*)(slot + KT_BYTES + c * 1024), 16, 0, 0); }
}

#define TOP3_INSERT(v, n) do { if ((v) > v0 || ((v) == v0 && (n) < i0)) { v2 = v1; i2 = i1; v1 = v0; i1 = i0; v0 = (v); i0 = (n); } \
    else if ((v) > v1 || ((v) == v1 && (n) < i1)) { v2 = v1; i2 = i1; v1 = (v); i1 = (n); } \
    else if ((v) > v2 || ((v) == v2 && (n) < i2)) { v2 = (v); i2 = (n); } } while (0)
__device__ __forceinline__ unsigned moba_gate(const Params& p, int h, int own, const bf16x8 (&qf)[8], int lane) {
    const int r = lane & 31, hf = lane >> 5;
    unsigned selmask = 0u;
    if (own > 0) {
        f32x16 gt;
#pragma unroll
        for (int i = 0; i < 16; ++i) gt[i] = 0.f;
        const float* kmg = (const float*)(p.ws + WS_KM) + ((size_t)h * 32 + r) * 128 + 8 * hf;
#pragma unroll
        for (int ks = 0; ks < 8; ++ks) {
            const f32x4 a0 = *(const f32x4*)(kmg + 16 * ks), a1 = *(const f32x4*)(kmg + 16 * ks + 4);
            u32x4 hi; hi.x = pk2(a0.x, a0.y); hi.y = pk2(a0.z, a0.w); hi.z = pk2(a1.x, a1.y); hi.w = pk2(a1.z, a1.w);
            u32x4 lo; lo.x = pk2(a0.x - bf_lo(hi.x), a0.y - bf_hi(hi.x)); lo.y = pk2(a0.z - bf_lo(hi.y), a0.w - bf_hi(hi.y));
            lo.z = pk2(a1.x - bf_lo(hi.z), a1.y - bf_hi(hi.z)); lo.w = pk2(a1.z - bf_lo(hi.w), a1.w - bf_hi(hi.w));
            gt = MFMA32(__builtin_bit_cast(bf16x8, hi), qf[ks], gt);
            gt = MFMA32(__builtin_bit_cast(bf16x8, lo), qf[ks], gt);
        }
        float v0 = -INFINITY, v1 = -INFINITY, v2 = -INFINITY; int i0 = 64, i1 = 64, i2 = 64;
#pragma unroll
        for (int i = 0; i < 16; ++i) { const int n = crow(i, hf); if (n < own) TOP3_INSERT(gt[i], n); }
        const float pv0 = shx(v0, 32, lane), pv1 = shx(v1, 32, lane), pv2 = shx(v2, 32, lane);
        const int pi0 = shxi(i0, 32, lane), pi1 = shxi(i1, 32, lane), pi2 = shxi(i2, 32, lane);
        if (pi0 < 64) TOP3_INSERT(pv0, pi0);
        if (pi1 < 64) TOP3_INSERT(pv1, pi1);
        if (pi2 < 64) TOP3_INSERT(pv2, pi2);
        if (i0 < 64) selmask |= 1u << i0;
        if (i1 < 64) selmask |= 1u << i1;
        if (i2 < 64) selmask |= 1u << i2;
    }
    return selmask;
}
__device__ __forceinline__ void sel_item(const Params& p, int item) {
    const int tid = tid_opaque(), lane = tid & 63, wave = tid >> 6, r = lane & 31, hf = lane >> 5;
    const int h = item >> 5, qb = item & 31, q = qb * 256 + 32 * wave + r;
    const bf16* proj = (const bf16*)(p.ws + WS_PROJ);
    bf16x8 qf[8];
#pragma unroll
    for (int ks = 0; ks < 8; ++ks) qf[ks] = *(const bf16x8*)(proj + (size_t)q * INW + C_MQ + h * 128 + 16 * ks + 8 * hf);
    const unsigned mask = moba_gate(p, h, qb, qf, lane);
    if (hf == 0) ((unsigned*)(p.ws + WS_SEL))[(size_t)h * SEQ + q] = mask;
}
template <int MODE>
__device__ __forceinline__ void attn_unit(const Params& p, int layer, int h, int qb, LAS unsigned char* lds, int gq, bool gactive, int gj, int gtile0) {
    constexpr int NKS = MODE == 1 ? 4 : 8;
    const int tid = tid_opaque(), lane = tid & 63, wave = __builtin_amdgcn_readfirstlane(tid >> 6), r = lane & 31, hf = lane >> 5;
    const int grp = wave >> 2;
    const bf16* proj = (const bf16*)(p.ws + WS_PROJ);
    const bf16* vt = (const bf16*)(p.ws + WS_VT);
    bf16* mix = (bf16*)(p.ws + WS_MIX);
    int wrow0, ntiles, qcol, kcol, kc0, hh, tile0; float scale;
    if (MODE != 1) { wrow0 = MODE == 0 ? qb * 256 + 32 * wave : (1 << 20); tile0 = MODE == 0 ? 4 * qb : gtile0; ntiles = 4; qcol = C_MQ + h * 128; kcol = C_MK + h * 128; kc0 = 0; hh = h; scale = 0.08838834764831845f * LOG2E; }
    else { tile0 = 0; wrow0 = qb * 128 + 32 * (wave & 3); ntiles = 2 * (qb + 1); qcol = C_DQ + h * 128 + grp * 64; kcol = C_DK + h * 128; kc0 = grp * 64; hh = 6 + h; scale = 0.125f * LOG2E; }
    const LAS unsigned short* glist = (const LAS unsigned short*)(lds + 102400);
    int q;
    if (MODE == 2) { const int idx = gq + 32 * wave + r; q = glist[idx < gj ? idx : 0]; } else q = wrow0 + r;
    bf16x8 qf[NKS];
#pragma unroll
    for (int ks = 0; ks < NKS; ++ks) qf[ks] = *(const bf16x8*)(proj + (size_t)q * INW + qcol + 16 * ks + 8 * hf);
    f32x16 o[4];
#pragma unroll
    for (int d = 0; d < 4; ++d)
#pragma unroll
        for (int i = 0; i < 16; ++i) o[d][i] = 0.f;
    float m = -1e30f, l = 0.f;
    bf16x8 pf[4];
#pragma unroll
    for (int k = 0; k < 4; ++k) pf[k] = (bf16x8){0, 0, 0, 0, 0, 0, 0, 0};
    bool prev_on = false;
    tile_dma(lds, proj, vt, kcol, hh, tile0 * 64, wave, lane);
    const unsigned ck = (unsigned)(r * 256 + 16 * ((r & 15) ^ hf));
    const unsigned cv = (unsigned)(KT_BYTES + r * 128 + 16 * (((r >> 1) & 7) ^ hf));
    asm volatile("s_waitcnt vmcnt(0)" ::: "memory");
    __syncthreads();
#define ATTN_BACK(vbuf) do { _Pragma("unroll") for (int k4 = 0; k4 < 4; ++k4) { bf16x8 vf_[4]; \
        _Pragma("unroll") for (int d = 0; d < 4; ++d) { \
            const unsigned x_ = ((vbuf) + cv) ^ (unsigned)(32 * k4); \
            vf_[d] = *(const LAS bf16x8*)(lds + x_ + 4096 * d); } \
        __builtin_amdgcn_sched_barrier(0); \
        _Pragma("unroll") for (int d = 0; d < 4; ++d) o[d] = MFMA32(vf_[d], pf[k4], o[d]); \
        __builtin_amdgcn_sched_barrier(0); } } while (0)
    const bool defer = (MODE == 1) && (grp == 1);
    int slot = 0;
    for (int t = 0; t < ntiles; ++t) {
        const int kbase = (tile0 + t) * 64;
        const unsigned buf = (unsigned)(slot * ABUF);
        const unsigned bufp = (unsigned)((slot == 0 ? 2 : slot - 1) * ABUF);
        const int nslot = slot == 2 ? 0 : slot + 1;
        if (t + 1 < ntiles) tile_dma(lds + nslot * ABUF, proj, vt, kcol, hh, kbase + 64, wave, lane);
        if (defer && prev_on) ATTN_BACK(bufp);
        const bool lane_on = true;
        const bool wave_on = (MODE == 2) || (kbase <= wrow0 + 31);
        if (wave_on) {
            f32x16 s[2];
#pragma unroll
            for (int b = 0; b < 2; ++b) {
#pragma unroll
                for (int i = 0; i < 16; ++i) s[b][i] = 0.f;
#pragma unroll
                for (int k0 = 0; k0 < NKS; k0 += 4) {
                    bf16x8 kf[4];
#pragma unroll
                    for (int ks = 0; ks < 4; ++ks) kf[ks] = *(const LAS bf16x8*)(lds + ((buf + 8192u * b + ck) ^ (unsigned)(2 * kc0 + 32 * (k0 + ks))));
                    __builtin_amdgcn_sched_barrier(0);
#pragma unroll
                    for (int ks = 0; ks < 4; ++ks) s[b] = MFMA32(kf[ks], qf[k0 + ks], s[b]);
                    __builtin_amdgcn_sched_barrier(0);
                }
            }
            const bool diag = (MODE != 2) && (kbase + 63 > wrow0);
            float mx = -INFINITY;
            bool lane_off = false;
            if (diag) {
                asm volatile("" ::: "memory");
#pragma unroll
                for (int b = 0; b < 2; ++b)
#pragma unroll
                    for (int i = 0; i < 16; ++i) {
                        const int key = kbase + 32 * b + crow(i, hf);
                        const bool ok = lane_on && (key <= q);
                        s[b][i] = ok ? s[b][i] : -INFINITY;
                        mx = fmaxf(mx, s[b][i]);
                    }
            } else {
#pragma unroll
                for (int b = 0; b < 2; ++b)
#pragma unroll
                    for (int i = 0; i < 16; ++i) mx = fmaxf(mx, s[b][i]);
            }
            mx = fmaxf(mx, shx32(mx, lane));
            const float mn = fmaxf(m, mx);
            const float alpha = __builtin_amdgcn_exp2f((m - mn) * scale);
            const float mns = lane_off ? INFINITY : mn * scale;
            float ls = 0.f;
#pragma unroll
            for (int b = 0; b < 2; ++b)
#pragma unroll
                for (int i = 0; i < 16; ++i) { const float pv = __builtin_amdgcn_exp2f(s[b][i] * scale - mns); s[b][i] = pv; ls += pv; }
            l = l * alpha + ls;
            __builtin_amdgcn_sched_barrier(0);
            if (__builtin_amdgcn_ballot_w64(mn != m) != 0ull) {
#pragma unroll
                for (int d = 0; d < 4; ++d)
#pragma unroll
                    for (int i = 0; i < 16; ++i) o[d][i] *= alpha;
            }
            m = mn;
#pragma unroll
            for (int b = 0; b < 2; ++b)
#pragma unroll
                for (int ss = 0; ss < 2; ++ss) {
                    u32x4 pu;
                    pu.x = pk2(s[b][8 * ss + 0], s[b][8 * ss + 1]); pu.y = pk2(s[b][8 * ss + 2], s[b][8 * ss + 3]);
                    pu.z = pk2(s[b][8 * ss + 4], s[b][8 * ss + 5]); pu.w = pk2(s[b][8 * ss + 6], s[b][8 * ss + 7]);
                    pf[2 * b + ss] = __builtin_bit_cast(bf16x8, pu);
                }
            if (!defer) ATTN_BACK(buf);
        }
        prev_on = wave_on;
        slot = nslot;
        asm volatile("s_waitcnt vmcnt(0)" ::: "memory");
        __syncthreads();
    }
    if (defer && prev_on) { const unsigned bufp = (unsigned)((slot == 0 ? 2 : slot - 1) * ABUF); ATTN_BACK(bufp); }
#undef ATTN_BACK
    const float lt = l + shx(l, 32, lane);
    const float inv = 1.f / lt;
    if (MODE != 1) {
        int q2 = q, jj = 3; bool act = true;
        if (MODE == 2) {
            const int t2 = tid_opaque(), idx = gq + 32 * (t2 >> 6) + (t2 & 31); act = idx < gj; q2 = glist[act ? idx : 0];
            jj = __builtin_popcount(((const unsigned*)(p.ws + WS_SEL))[(size_t)h * SEQ + q2] & ((1u << (gtile0 >> 2)) - 1u)); }
        if (act) {
            unsigned* rec = (unsigned*)(p.ws + WS_PART) + (((size_t)h * SEQ + q2) * 4 + jj) * 68;
            if (hf == 0) { rec[0] = __float_as_uint(m * scale); rec[1] = __float_as_uint(lt); }
#pragma unroll
            for (int d = 0; d < 4; ++d)
#pragma unroll
                for (int g4 = 0; g4 < 4; ++g4) {
                    u32x2 w; w.x = pk2(o[d][4 * g4] * inv, o[d][4 * g4 + 1] * inv); w.y = pk2(o[d][4 * g4 + 2] * inv, o[d][4 * g4 + 3] * inv);
                    *(u32x2*)(rec + 4 + 16 * d + 4 * g4 + 2 * hf) = w;
                }
        }
    } else {
        __syncthreads();
        LAS float* ex = (LAS float*)lds;
        const int wi = wave & 3;
        if (wave >= 4) {
#pragma unroll
            for (int d = 0; d < 4; ++d)
#pragma unroll
                for (int i = 0; i < 16; ++i) ex[(wi * 64 + d * 16 + i) * 64 + lane] = o[d][i] * inv;
        }
        __syncthreads();
        if (wave < 4) {
            int ly = layer; asm volatile("" : "+s"(ly));
            float c08 = 0.8f, c06 = 0.6f; asm volatile("" : "+s"(c08), "+s"(c06));
            const float lin = c08 - c06 * __expf(-0.3f * (float)ly);
            const float* lp = p.diff_lambda + (size_t)ly * 256;
            const float la = wave_sum(lp[lane] * lp[64 + lane], lane), lb = wave_sum(lp[128 + lane] * lp[192 + lane], lane);
            const float lamv = __expf(la) - __expf(lb) + lin, oml = 1.f - lin;
            float ss = 0.f;
#pragma unroll
            for (int d = 0; d < 4; ++d) {
#pragma unroll
                for (int i = 0; i < 16; ++i) { const float v = o[d][i] * inv - lamv * ex[(wi * 64 + d * 16 + i) * 64 + lane]; o[d][i] = v; ss += v * v; }
                __builtin_amdgcn_sched_barrier(0);
            }
            ss += shx(ss, 32, lane);
            const float rs = rsqrtf(ss * (1.f / 128.f) + EPS) * oml;
            const float* sg = p.subln_g + (size_t)layer * 128;
#pragma unroll
            for (int d = 0; d < 4; ++d)
#pragma unroll
                for (int g4 = 0; g4 < 4; ++g4) {
                    const int dv = 32 * d + 8 * g4 + 4 * hf;
                    const f32x4 gg = *(const f32x4*)(sg + dv);
                    u32x2 w; w.x = pk2(o[d][4 * g4] * rs * gg.x, o[d][4 * g4 + 1] * rs * gg.y); w.y = pk2(o[d][4 * g4 + 2] * rs * gg.z, o[d][4 * g4 + 3] * rs * gg.w);
                    *(u32x2*)(mix + (size_t)q * DM + 768 + h * 128 + dv) = w;
                }
        }
        __syncthreads();
    }
}

__device__ __forceinline__ void gathered_unit(const Params& p, int layer, int h, int v, LAS unsigned char* lds) {
    const int tid = tid_opaque(), lane = tid & 63, wave = tid >> 6, r = lane & 31;
    int n, C; gat_decode(v, n, C);
    const int bs = (n + 1 > 8 * C) ? n + 1 : 8 * C, q0 = bs * 256, q1 = (8 * C + 8) * 256;
    LAS unsigned short* list = (LAS unsigned short*)(lds + 102400);
    LAS int* cnt = (LAS int*)(lds + LDS_MISC + 12);
    const unsigned* sel = (const unsigned*)(p.ws + WS_SEL) + (size_t)h * SEQ;
    if (tid == 0) *cnt = 0;
    __syncthreads();
    for (int q = q0 + tid; q < q1; q += NTHR)
        if ((sel[q] >> n) & 1u) { const int s = __hip_atomic_fetch_add(cnt, 1, __ATOMIC_RELAXED, __HIP_MEMORY_SCOPE_WORKGROUP); list[s] = (unsigned short)q; }
    __syncthreads();
    const int count = *(volatile LAS int*)cnt;
    for (int g0 = 0; g0 < count; g0 += 256) {
        attn_unit<2>(p, layer, h, 0, lds, g0, true, count, 4 * n);
        __syncthreads();
    }
}
__device__ __forceinline__ void phase_attn(const Params& p, int layer, LAS unsigned char* lds) {
    const int tid = tid_opaque();
    volatile LAS int* misc = (volatile LAS int*)(lds + LDS_MISC);
    unsigned* ctr = (unsigned*)(p.ws + WS_CTL) + layer;
    const int* order = (const int*)(p.ws + WS_ORDER);
    for (;;) {
        if (tid == 0) misc[0] = (int)atomicAdd(ctr, 1u);
        __syncthreads();
        const int idx = misc[0];
        __syncthreads();
        if (idx >= NU_ALL) break;
        const int u = order[idx];
        if (u < U_GAT) attn_unit<0>(p, layer, u >> 5, u & 31, lds, 0, true, 3, 0);
        else if (u < U_DIF) gathered_unit(p, layer, (u - U_GAT) / 76, (u - U_GAT) % 76, lds);
        else if (u < U_SGU) { const int w = u - U_DIF; attn_unit<1>(p, layer, w >> 6, w & 63, lds, 0, true, 0, 0); }
        else sgu_item(p, layer, u - U_SGU);
    }
}
__device__ __forceinline__ void phase_merge(const Params& p) {
    const int tid = tid_opaque(), lane = tid & 63, wave = tid >> 6;
    const int gw = blockIdx.x * NWAVES + wave, NGW = gridDim.x * NWAVES;
    bf16* mix = (bf16*)(p.ws + WS_MIX);
    for (int it = gw; it < 6 * SEQ; it += NGW) {
        const int h = it / SEQ, q = it % SEQ, cnt = (q >> 8) < 3 ? (q >> 8) : 3;
        const unsigned* rec = (const unsigned*)(p.ws + WS_PART) + ((size_t)h * SEQ + q) * 4 * 68;
        float mj[4], lj[4]; unsigned ow[4];
#pragma unroll
        for (int j = 0; j < 4; ++j) { const bool ok = (j == 3) || (j < cnt);
            mj[j] = ok ? __uint_as_float(rec[j * 68]) : -INFINITY; lj[j] = ok ? __uint_as_float(rec[j * 68 + 1]) : 0.f; ow[j] = ok ? rec[j * 68 + 4 + lane] : 0u; }
        const float M = fmaxf(fmaxf(mj[0], mj[1]), fmaxf(mj[2], mj[3]));
        float W = 0.f, a0 = 0.f, a1 = 0.f;
#pragma unroll
        for (int j = 0; j < 4; ++j) { const float w = lj[j] * __builtin_amdgcn_exp2f(mj[j] - M); W += w; a0 += w * bf_lo(ow[j]); a1 += w * bf_hi(ow[j]); }
        const float iw = 1.f / W;
        ((unsigned*)(mix + (size_t)q * DM + h * 128))[lane] = pk2(a0 * iw, a1 * iw);
    }
}

#define XB_TMO      128
#define XB_XCNT(j)  (256  + 64 * (j))
#define XB_XSUB(j)  (1280 + 64 * (j))
#define XB_XGEN(j)  (2304 + 64 * (j))
#define XB_TOP      3328
#define XB_TOPGEN   3392
#define XCD_BAR_WORDS 3456
#define XB_SPIN_CAP (1u << 18)

__device__ __forceinline__ unsigned xb_ld(unsigned* p)              { return __hip_atomic_load(p, __ATOMIC_RELAXED, __HIP_MEMORY_SCOPE_AGENT); }
__device__ __forceinline__ unsigned xb_add(unsigned* p, unsigned v) { return __hip_atomic_fetch_add(p, v, __ATOMIC_RELAXED, __HIP_MEMORY_SCOPE_AGENT); }
__device__ __forceinline__ unsigned xb_xcc_id() { return (unsigned)__builtin_amdgcn_s_getreg((3 << 11) | 20) & 0xFu; }
#define XB_SPIN(cond, bar) do { unsigned _sp = 0; while (cond) { __builtin_amdgcn_s_sleep(1); \
    if ((++_sp & 255u) == 0u) { if (xb_ld(&(bar)[XB_TMO])) break; if (_sp > XB_SPIN_CAP) { atomicAdd(&(bar)[XB_TMO], 1u); break; } } } } while (0)

struct XcdBarrier {
    unsigned* bar; unsigned x;
    volatile LAS unsigned* st;
};

__device__ __forceinline__ XcdBarrier xcd_barrier_post(unsigned* bar, volatile LAS unsigned* st) {
    XcdBarrier b; b.bar = bar; b.x = xb_xcc_id(); b.st = st;
    if (threadIdx.x == 0) (void)xb_add(&bar[XB_XCNT(b.x)], 1u);
    return b;
}
__device__ __forceinline__ void xcd_barrier_complete(unsigned* bar, unsigned x, unsigned& nloc, unsigned& nx) {
    const unsigned G = gridDim.x * gridDim.y * gridDim.z;
    unsigned sum, cnt, mine, sp = 0u;
    for (;;) {
        sum = 0u; cnt = 0u; mine = 0u;
#pragma unroll
        for (unsigned j = 0; j < 16; ++j) { const unsigned c = xb_ld(&bar[XB_XCNT(j)]); sum += c; cnt += (c > 0u) ? 1u : 0u; mine = (j == x) ? c : mine; }
        if (sum == G) break;
        __builtin_amdgcn_s_sleep(1);
        if ((++sp & 255u) == 0u) { if (xb_ld(&bar[XB_TMO])) break; if (sp > XB_SPIN_CAP) { atomicAdd(&bar[XB_TMO], 1u); break; } }
    }
    nloc = mine > 0u ? mine : 1u; nx = cnt > 0u ? cnt : 1u;
}

__device__ __forceinline__ void xcd_barrier(const XcdBarrier& b) {
    asm volatile("s_waitcnt vmcnt(0)" ::: "memory");
    __syncthreads();
    if (threadIdx.x == 0) {
        unsigned* bar = b.bar;
        __builtin_amdgcn_s_waitcnt(0);
        unsigned nloc = b.st[0], nx = b.st[1];
        if (nloc == 0u) { xcd_barrier_complete(bar, b.x, nloc, nx); b.st[0] = nloc; b.st[1] = nx; }
        const unsigned old = xb_add(&bar[XB_XSUB(b.x)], 1u);
        const unsigned gen = old / nloc;
        if (old + 1u == (gen + 1u) * nloc) {
            __builtin_amdgcn_fence(__ATOMIC_RELEASE, "agent");
            asm volatile("s_waitcnt vmcnt(0)" ::: "memory");
            const unsigned og = xb_add(&bar[XB_TOP], 1u);
            const unsigned tg = og / nx;
            if (og + 1u == (tg + 1u) * nx) xb_add(&bar[XB_TOPGEN], 1u);
            else XB_SPIN(xb_ld(&bar[XB_TOPGEN]) == tg, bar);
            __builtin_amdgcn_fence(__ATOMIC_ACQUIRE, "agent");
            xb_add(&bar[XB_XGEN(b.x)], 1u);
            asm volatile("s_waitcnt vmcnt(0)" ::: "memory");
        } else {
            XB_SPIN(xb_ld(&bar[XB_XGEN(b.x)]) == gen, bar);
            __builtin_amdgcn_fence(__ATOMIC_ACQUIRE, "agent");
            asm volatile("s_waitcnt vmcnt(0)" ::: "memory");
        }
    }
    __syncthreads();
}


__global__ void __launch_bounds__(NTHR, 2) trunk_fwd(Params p) {
    extern __shared__ __attribute__((aligned(16))) unsigned char lds_raw[];
    LAS unsigned char* lds = (LAS unsigned char*)lds_raw;
    cg::grid_group grid = cg::this_grid();
    const int G = gridDim.x, bid = blockIdx.x;
    unsigned char* ws = p.ws;
    bf16* H = (bf16*)(ws + WS_H); bf16* PROJ = (bf16*)(ws + WS_PROJ); bf16* MIX = (bf16*)(ws + WS_MIX); bf16* HID = (bf16*)(ws + WS_HID);

    volatile LAS unsigned* xst = (volatile LAS unsigned*)(lds + LDS_MISC + 64);
    if (threadIdx.x < 4) xst[threadIdx.x] = 0u;
    if (bid == 0) { unsigned* bw = (unsigned*)(ws + WS_BAR); for (int i = threadIdx.x; i < XCD_BAR_WORDS; i += NTHR) bw[i] = 0u; }
    phase_weights(p, lds);
    float* SS = (float*)(ws + WS_SS);
    phase_x0(p.x, H, SS);
    grid.sync();
    const XcdBarrier xb = xcd_barrier_post((unsigned*)(ws + WS_BAR), xst);
#define GRID_BAR() xcd_barrier(xb)
    for (int layer = 0; layer < DEPTH; ++layer) {
        {
            pg8::Gemm g{H, (const bf16*)(ws + WS_WIN) + (size_t)layer * INW * DM, SEQ, INW, DM}; pg8::StaticOrder S; S.init(SEQ, INW, G, bid);
            pg8::EpiBf16<0> E{PROJ, INW, SS + (size_t)(2 * layer) * SEQ * 32, 1.f / DM, (const LAS float*)(lds + 131072)};
            pg8::gemm_phase(lds, g, S, E);
        }
        GRID_BAR();
        for (int u = bid; u < 32 * 40; u += G) post_unit(p, layer, u, lds);
        GRID_BAR();
        for (int it = bid; it < 192; it += G) sel_item(p, it);
        GRID_BAR();
        phase_attn(p, layer, lds);
        GRID_BAR();
        phase_merge(p);
        GRID_BAR();
        {
            pg8::Gemm g{MIX, (const bf16*)(ws + WS_WOUT) + (size_t)layer * DM * DM, SEQ, DM, DM}; pg8::StaticOrder S; S.init(SEQ, DM, G, bid);
            pg8::EpiResid E{H, SS + (size_t)(2 * layer + 1) * SEQ * 32, DM};
            pg8::gemm_phase(lds, g, S, E);
        }
        GRID_BAR();
        {
            pg8::Gemm g{H, (const bf16*)(ws + WS_W1) + (size_t)layer * DFF * DM, SEQ, DFF, DM}; pg8::StaticOrder S; S.init(SEQ, DFF, G, bid);
            pg8::EpiBf16<1> E{HID, DFF, SS + (size_t)(2 * layer + 1) * SEQ * 32, 1.f / DM, (const LAS float*)(lds + 131072)};
            pg8::gemm_phase(lds, g, S, E);
        }
        GRID_BAR();
        {
            pg8::Gemm g{HID, (const bf16*)(ws + WS_W2) + (size_t)layer * DM * DFF, SEQ, DM, DFF}; pg8::StaticOrder S; S.init(SEQ, DM, G, bid);
            pg8::EpiResid E{H, SS + (size_t)(2 * layer + 2) * SEQ * 32, DM};
            pg8::gemm_phase(lds, g, S, E);
        }
        GRID_BAR();
    }
    phase_norm_f32(H, p.final_g, SS + (size_t)8 * SEQ * 32, p.out);
}

extern "C" void kernel_launch(void* const* d_in, const int* in_sizes, int n_in, void* d_out, int out_size, void* d_ws, size_t ws_size, hipStream_t stream) {
    static int grid_blocks = 0;
    if (grid_blocks == 0) {
        if (n_in != 14 || ws_size < WS_END) { fprintf(stderr, "kernel_launch: unexpected inputs (n_in %d, ws %zu, need %zu)\n", n_in, ws_size, (size_t)WS_END); grid_blocks = -1; return; }
        int dev = 0, cus = 0, per_cu = 0;
        hipGetDevice(&dev);
        hipDeviceGetAttribute(&cus, hipDeviceAttributeMultiprocessorCount, dev);
        hipFuncSetAttribute((const void*)trunk_fwd, hipFuncAttributeMaxDynamicSharedMemorySize, LDS_BYTES);
        hipOccupancyMaxActiveBlocksPerMultiprocessor(&per_cu, (const void*)trunk_fwd, NTHR, LDS_BYTES);
        if (per_cu < 1) per_cu = 1;
        grid_blocks = cus * per_cu;
        (void)hipGetLastError();
    }
    if (grid_blocks < 0) return;
    Params p{};
    p.x = (const float*)d_in[0]; p.attn_g = (const float*)d_in[1]; p.w_in = (const float*)d_in[2]; p.diff_lambda = (const float*)d_in[3]; p.subln_g = (const float*)d_in[4];
    p.sgu_ln_g = (const float*)d_in[5]; p.sgu_ln_b = (const float*)d_in[6]; p.sgu_w = (const float*)d_in[7]; p.sgu_b = (const float*)d_in[8]; p.w_out = (const float*)d_in[9];
    p.mlp_g = (const float*)d_in[10]; p.w1 = (const float*)d_in[11]; p.w2 = (const float*)d_in[12]; p.final_g = (const float*)d_in[13];
    p.out = (float*)d_out; p.ws = (unsigned char*)d_ws;
    void* args[] = {&p};
    hipError_t e = hipLaunchCooperativeKernel((const void*)trunk_fwd, dim3(grid_blocks), dim3(NTHR), args, LDS_BYTES, stream);
    if (e != hipSuccess) fprintf(stderr, "cooperative launch failed: %s (grid %d)\n", hipGetErrorString(e), grid_blocks);
}
```

```cpp
#include <hip/hip_runtime.h>
#include <hip/hip_cooperative_groups.h>
#include <cstdio>
#include <cstdint>
namespace cg = cooperative_groups;

namespace pg8 {
#define PG8_LAS __attribute__((address_space(3)))
typedef unsigned short bf16_t;
typedef short bf16x8 __attribute__((ext_vector_type(8)));
typedef float f32x4 __attribute__((ext_vector_type(4)));
typedef unsigned u32x4 __attribute__((ext_vector_type(4)));
typedef unsigned u32x2 __attribute__((ext_vector_type(2)));
constexpr int BM = 256, BK = 64, HALF = 128, HTB = HALF * BK * 2  , STAGE_BYTES = 8 * HTB, NXCD = 8, WGM = 4;

__host__ __device__ __forceinline__ int lds_byte(int r, int c) { const int st = (r >> 4) * 2 + (c >> 5), rr = r & 15, cc = c & 31, ob = rr * 64 + cc * 2; return st * 1024 + (ob ^ (((ob >> 9) & 1) << 5)); }
__host__ __device__ __forceinline__ void stage_rc(int b, int& R, int& C) { const int st = b / 1024, sb = b % 1024, swz = sb ^ (((sb >> 9) & 1) << 5); R = (st >> 1) * 16 + swz / 64; C = (st & 1) * 32 + (swz % 64) / 2; }
__host__ __device__ __forceinline__ int perm32(int rho) { const int n = rho >> 4, i = rho & 15; return 8 * (i >> 2) + 4 * n + (i & 3); }

struct Unit { int pm, pn, ui; };
struct Gemm { const bf16_t* A; const bf16_t* Bt; int M, N, K; };

struct StaticOrder {
    int nM, nN, nwg, G, c;
    __host__ __device__ void init(int M, int N, int G_, int c_) { nM = M / BM; nN = N / BM; nwg = nM * nN; G = G_; c = c_; }
    __host__ __device__ bool next(int i, Unit& u) const {
        const long L = (long)i * G + c; if (L >= nwg) return false;
        int wgid = (int)L; { const int q = nwg / NXCD, r = nwg % NXCD, xcd = wgid % NXCD, off = wgid / NXCD; wgid = (xcd < r ? xcd * (q + 1) : r * (q + 1) + (xcd - r) * q) + off; }
        const int nig = WGM * nN, gid = wgid / nig, fm = gid * WGM, gsz = (nM - fm) < WGM ? (nM - fm) : WGM;
        u.pm = fm + ((wgid % nig) % gsz); u.pn = (wgid % nig) / gsz; u.ui = i; return true;
    }
    __device__ __forceinline__ void a_ready(const Unit&) const {}
    __device__ __forceinline__ void done(const Unit&) const {}
};

typedef float f32x2 __attribute__((ext_vector_type(2)));
typedef __bf16 bf16x2_t __attribute__((ext_vector_type(2)));
__device__ __forceinline__ float shx(float v, int k, int lane) { return __int_as_float(__builtin_amdgcn_ds_bpermute((lane ^ k) << 2, __float_as_int(v))); }
__device__ __forceinline__ unsigned cvt_pk_bf16(float lo, float hi) { f32x2 v = {lo, hi}; bf16x2_t b = __builtin_convertvector(v, bf16x2_t); return __builtin_bit_cast(unsigned, b); }

struct EpiResid {
    static constexpr bool PERM = true, NEEDS_PREP = false;
    bf16_t* XB; float* SS; int ldc;
    __device__ __forceinline__ void operator()(const f32x4 (&acc)[2][2][4][2], const Unit& u, int wr, int wc, int fr, int fq) const {
        const int row0 = u.pm * BM + wr * 64 + fr, col0 = u.pn * BM + wc * 32 + 8 * fq;
        u32x4 xin[2][4][2];
#pragma unroll
        for (int ai = 0; ai < 2; ++ai)
#pragma unroll
            for (int m = 0; m < 4; ++m)
#pragma unroll
                for (int bj = 0; bj < 2; ++bj) xin[ai][m][bj] = *(const u32x4*)(XB + (size_t)(row0 + ai * HALF + m * 16) * ldc + col0 + bj * HALF);
#pragma unroll
        for (int ai = 0; ai < 2; ++ai)
#pragma unroll
            for (int m = 0; m < 4; ++m) { const int row = row0 + ai * HALF + m * 16; const size_t off = (size_t)row * ldc + col0; float part = 0.f;
#pragma unroll
                for (int bj = 0; bj < 2; ++bj) { const u32x4 xi = xin[ai][m][bj]; const f32x4 a0 = acc[ai][bj][m][0], a1 = acc[ai][bj][m][1];
                    u32x4 w;
                    w.x = cvt_pk_bf16(a0[0] + __uint_as_float(xi.x << 16), a0[1] + __uint_as_float(xi.x & 0xffff0000u));
                    w.y = cvt_pk_bf16(a0[2] + __uint_as_float(xi.y << 16), a0[3] + __uint_as_float(xi.y & 0xffff0000u));
                    w.z = cvt_pk_bf16(a1[0] + __uint_as_float(xi.z << 16), a1[1] + __uint_as_float(xi.z & 0xffff0000u));
                    w.w = cvt_pk_bf16(a1[2] + __uint_as_float(xi.w << 16), a1[3] + __uint_as_float(xi.w & 0xffff0000u));
                    *(u32x4*)(XB + off + bj * HALF) = w;
#pragma unroll
                    for (int e = 0; e < 4; ++e) { const float lo = __uint_as_float(w[e] << 16), hi = __uint_as_float(w[e] & 0xffff0000u); part += lo * lo + hi * hi; } }
                part += shx(part, 16, fq * 16 + fr); part += shx(part, 32, fq * 16 + fr);
                if (fq == 0) SS[(size_t)row * 32 + u.pn * 4 + wc] = part; }
    }
};
template <int ACT> struct EpiBf16 {
    static constexpr bool PERM = true;
    static constexpr bool NEEDS_PREP = true;
    bf16_t* O; int ldc; const float* SS; float inv_k; const PG8_LAS float* rstab;
    template <class Sched> __device__ __forceinline__ void prep(const Sched& S, int tid) const {
        PG8_LAS float* tab = (PG8_LAS float*)rstab;
#pragma unroll
        for (int k = 0; k < 2; ++k) { const int ui = (tid >> 8) + 2 * k; Unit u;
            if (S.next(ui, u)) { const f32x4* sp = (const f32x4*)(SS + (size_t)(u.pm * BM + (tid & 255)) * 32); float tot = 0.f;
#pragma unroll
                for (int j = 0; j < 8; ++j) { const f32x4 a = sp[j]; tot += (a[0] + a[1]) + (a[2] + a[3]); }
                tab[ui * 256 + (tid & 255)] = rsqrtf(tot * inv_k + 1e-6f); } }
    }
    __device__ __forceinline__ void operator()(const f32x4 (&acc)[2][2][4][2], const Unit& u, int wr, int wc, int fr, int fq) const {
        const int row0 = u.pm * BM + wr * 64 + fr; const int col0 = u.pn * BM + wc * 32 + 8 * fq;
        float rsv[2][4];
#pragma unroll
        for (int ai = 0; ai < 2; ++ai)
#pragma unroll
            for (int m = 0; m < 4; ++m) rsv[ai][m] = rstab[(u.ui & 3) * 256 + wr * 64 + fr + ai * HALF + m * 16];
#pragma unroll
        for (int ai = 0; ai < 2; ++ai)
#pragma unroll
            for (int m = 0; m < 4; ++m) { const int row = row0 + ai * HALF + m * 16; bf16_t* rowp = O + (size_t)row * ldc + col0;
                const float rs = rsv[ai][m];
#pragma unroll
                for (int bj = 0; bj < 2; ++bj) { f32x4 v0 = acc[ai][bj][m][0] * rs, v1 = acc[ai][bj][m][1] * rs;
                    if (ACT == 1) {
#pragma unroll
                        for (int j = 0; j < 4; ++j) { const float a = fmaxf(v0[j], 0.f), b = fmaxf(v1[j], 0.f); v0[j] = a * a; v1[j] = b * b; } }
                    u32x4 w; w.x = cvt_pk_bf16(v0[0], v0[1]); w.y = cvt_pk_bf16(v0[2], v0[3]); w.z = cvt_pk_bf16(v1[0], v1[1]); w.w = cvt_pk_bf16(v1[2], v1[3]);
                    *(u32x4*)(rowp + bj * HALF) = w; } }
    }
};

template <class Epi, class Sched>
__device__ __forceinline__ void gemm_phase(PG8_LAS unsigned char* lds, const Gemm g, const Sched& S, const Epi& E) {
    int tid_ = threadIdx.x; asm volatile("" : "+v"(tid_));
    const int tid = tid_, wid = __builtin_amdgcn_readfirstlane(tid >> 6), lane = tid & 63, wr = wid >> 2, wc = wid & 3, fr = lane & 15, fq = lane >> 4;
    const int K = g.K, nt = K / BK;
    unsigned voffA[2], voffB[2];
#pragma unroll
    for (int i = 0; i < 2; ++i) { int R, C; stage_rc(tid * 16 + i * 8192, R, C); const int Rb = Epi::PERM ? ((R & ~31) + perm32(R & 31)) : R;
        voffA[i] = (unsigned)(R * K + C) * 2u; voffB[i] = (unsigned)(Rb * K + C) * 2u; }
    const size_t kstep = (size_t)(BK * 2);
    const size_t hstep = (size_t)HALF * K * 2;
    const size_t tstep = 2 * hstep;
    const unsigned ldsw = (unsigned)wid * 1024u;
    const int aoff = lds_byte(wr * 64 + fr, fq * 8), boff = lds_byte(wc * 32 + fr, fq * 8);
#define PG8_SA(b, h) (((b) * 2 + (h)) * HTB)
#define PG8_SB(b, h) ((4 + (b) * 2 + (h)) * HTB)
#define PG8_STAGE(bufoff, gbase, voff) do { _Pragma("unroll") for (int _i = 0; _i < 2; ++_i) \
        __builtin_amdgcn_global_load_lds((const unsigned*)((const char*)(gbase) + (voff)[_i]), (PG8_LAS unsigned*)(lds + (bufoff) + ldsw + _i * 8192), 16, 0, 0); } while (0)
#define PG8_LDA(dst, b, h) do { _Pragma("unroll") for (int m = 0; m < 4; ++m) _Pragma("unroll") for (int k = 0; k < 2; ++k) dst[m][k] = *(const PG8_LAS bf16x8*)(lds + PG8_SA(b, h) + aoff + m * 2048 + k * 1024); } while (0)
#define PG8_LDB(dst, b, h) do { _Pragma("unroll") for (int n = 0; n < 2; ++n) _Pragma("unroll") for (int k = 0; k < 2; ++k) dst[n][k] = *(const PG8_LAS bf16x8*)(lds + PG8_SB(b, h) + boff + n * 2048 + k * 1024); } while (0)
#define PG8_MMA(ai, bj, At, Bt) do { __builtin_amdgcn_s_setprio(1); _Pragma("unroll") for (int m = 0; m < 4; ++m) _Pragma("unroll") for (int n = 0; n < 2; ++n) _Pragma("unroll") for (int k = 0; k < 2; ++k) \
        acc[ai][bj][m][n] = __builtin_amdgcn_mfma_f32_16x16x32_bf16(Bt[n][k], At[m][k], acc[ai][bj][m][n], 0, 0, 0); __builtin_amdgcn_s_setprio(0); } while (0)
#define PG8_WAIT_V(n) asm volatile("s_waitcnt vmcnt(" #n ")" ::: "memory")
#define PG8_WAIT_L(n) asm volatile("s_waitcnt lgkmcnt(" #n ")" ::: "memory")
#define PG8_BAR __builtin_amdgcn_s_barrier()
#define PG8_SCHED __builtin_amdgcn_sched_barrier(0)
    Unit cur, nxt; int ui = 0;
    if (!S.next(0, cur)) return;
    f32x4 acc[2][2][4][2];
#pragma unroll
    for (int a = 0; a < 2; ++a)
#pragma unroll
        for (int b = 0; b < 2; ++b)
#pragma unroll
            for (int m = 0; m < 4; ++m)
#pragma unroll
                for (int n = 0; n < 2; ++n) acc[a][b][m][n] = (f32x4){0.f, 0.f, 0.f, 0.f};
    bf16x8 At[4][2], B0[2][2], B1[2][2];
    const char* cA = (const char*)g.A + (size_t)cur.pm * tstep; const char* cB = (const char*)g.Bt + (size_t)cur.pn * tstep;
    if constexpr (Epi::NEEDS_PREP) { E.prep(S, tid); asm volatile("s_waitcnt lgkmcnt(0)" ::: "memory"); __builtin_amdgcn_s_barrier(); }
    S.a_ready(cur);
    PG8_STAGE(PG8_SB(0, 0), cB, voffB); PG8_STAGE(PG8_SB(0, 1), cB + hstep, voffB); PG8_STAGE(PG8_SA(0, 0), cA, voffA); PG8_STAGE(PG8_SA(0, 1), cA + hstep, voffA);
    if (wr == 1) PG8_BAR;
    PG8_WAIT_V(2); PG8_BAR;
    PG8_STAGE(PG8_SB(1, 0), cB + kstep, voffB); PG8_STAGE(PG8_SA(1, 0), cA + kstep, voffA); PG8_STAGE(PG8_SB(1, 1), cB + hstep + kstep, voffB);
    PG8_WAIT_V(6); PG8_BAR;
    for (;;) {
        const bool has_next = S.next(ui + 1, nxt);
        const char* nA = has_next ? (const char*)g.A + (size_t)nxt.pm * tstep : cA; const char* nB = has_next ? (const char*)g.Bt + (size_t)nxt.pn * tstep : cB;
        for (int t = 0; t < nt; t += 2) {
            const bool last = (t == nt - 2);
            const char* a1 = cA + (size_t)(t + 1) * kstep;
            const char* a2 = last ? nA : cA + (size_t)(t + 2) * kstep; const char* b2 = last ? nB : cB + (size_t)(t + 2) * kstep;
            const char* a3 = a2 + kstep; const char* b3 = b2 + kstep;
            if (last && has_next) S.a_ready(nxt);
            PG8_LDB(B0, 0, 0); PG8_LDB(B1, 0, 1); PG8_SCHED; PG8_LDA(At, 0, 0); PG8_STAGE(PG8_SA(1, 1), a1 + hstep, voffA);
            PG8_WAIT_V(8); PG8_WAIT_L(0); PG8_BAR; PG8_MMA(0, 0, At, B0); PG8_MMA(0, 1, At, B1); PG8_BAR; PG8_SCHED;
            PG8_LDA(At, 0, 1); PG8_STAGE(PG8_SB(0, 0), b2, voffB); PG8_STAGE(PG8_SB(0, 1), b2 + hstep, voffB); PG8_STAGE(PG8_SA(0, 0), a2, voffA);
            PG8_WAIT_V(8); PG8_WAIT_L(0); PG8_BAR; PG8_MMA(1, 0, At, B0); PG8_MMA(1, 1, At, B1); PG8_BAR; PG8_SCHED;
            PG8_LDB(B0, 1, 0); PG8_LDB(B1, 1, 1); PG8_SCHED; PG8_LDA(At, 1, 0); PG8_STAGE(PG8_SA(0, 1), a2 + hstep, voffA);
            PG8_WAIT_V(8); PG8_WAIT_L(0); PG8_BAR; PG8_MMA(0, 0, At, B0); PG8_MMA(0, 1, At, B1); PG8_BAR; PG8_SCHED;
            PG8_LDA(At, 1, 1); PG8_STAGE(PG8_SB(1, 0), b3, voffB); PG8_STAGE(PG8_SB(1, 1), b3 + hstep, voffB); PG8_STAGE(PG8_SA(1, 0), a3, voffA);
            PG8_WAIT_V(8); PG8_WAIT_L(0); PG8_BAR; PG8_MMA(1, 0, At, B0); PG8_MMA(1, 1, At, B1); PG8_BAR; PG8_SCHED;
        }
        if (wr == 0) PG8_BAR;
        E(acc, cur, wr, wc, fr, fq); S.done(cur);
        if (!has_next) break;
#pragma unroll
        for (int a = 0; a < 2; ++a)
#pragma unroll
            for (int b = 0; b < 2; ++b)
#pragma unroll
                for (int m = 0; m < 4; ++m)
#pragma unroll
                    for (int n = 0; n < 2; ++n) acc[a][b][m][n] = (f32x4){0.f, 0.f, 0.f, 0.f};
        cur = nxt; cA = nA; cB = nB; ++ui;
        if (wr == 1) PG8_BAR;
    }
    PG8_WAIT_V(0);
    PG8_BAR;
#undef PG8_SA
#undef PG8_SB
#undef PG8_STAGE
#undef PG8_LDA
#undef PG8_LDB
#undef PG8_MMA
#undef PG8_WAIT_V
#undef PG8_WAIT_L
#undef PG8_BAR
#undef PG8_SCHED
}
}

constexpr int SEQ = 8192, DM = 2048, DEPTH = 4, INW = 5632, DFF = 8192;
constexpr int C_MQ = 0, C_MK = 768, C_MV = 1536, C_DQ = 2304, C_DK = 3072, C_DV = 3840, C_SU = 4608, C_SV = 5120;
constexpr int NWAVES = 8, NTHR = 512;
constexpr int LDS_BYTES = 147456;
constexpr int LDS_MISC = 139264;
constexpr float EPS = 1e-6f;

constexpr size_t WS_CTL = 0;
constexpr size_t WS_BAR = 16384;
constexpr size_t WS_ORDER = 4096;
constexpr size_t WS_WIN = 65536;
constexpr size_t WS_WOUT = WS_WIN + (size_t)DEPTH * INW * DM * 2;
constexpr size_t WS_W1 = WS_WOUT + (size_t)DEPTH * DM * DM * 2;
constexpr size_t WS_W2 = WS_W1 + (size_t)DEPTH * DFF * DM * 2;
constexpr size_t WS_XRES = WS_W2 + (size_t)DEPTH * DM * DFF * 2;
constexpr size_t WS_H = WS_XRES + (size_t)SEQ * DM * 4;
constexpr size_t WS_PROJ = WS_H + (size_t)SEQ * DM * 2;
constexpr size_t WS_VT = WS_PROJ + (size_t)SEQ * INW * 2;
constexpr size_t WS_VNT = WS_VT + (size_t)12 * 128 * SEQ * 2;
constexpr size_t WS_KM = WS_VNT + (size_t)SEQ * 512 * 2;
constexpr size_t WS_SEL = WS_KM + (size_t)6 * 32 * 128 * 4;
constexpr size_t WS_MIX = WS_SEL + (size_t)6 * SEQ * 4;
constexpr size_t WS_HID = WS_MIX + (size_t)SEQ * DM * 2;
constexpr size_t WS_SS = WS_HID + (size_t)SEQ * DFF * 2;
constexpr size_t WS_END = WS_SS + (size_t)9 * SEQ * 32 * 4;

#define LAS __attribute__((address_space(3)))
typedef unsigned short bf16;
typedef short bf16x8 __attribute__((ext_vector_type(8)));
typedef short s16x4 __attribute__((ext_vector_type(4)));
typedef float f32x4 __attribute__((ext_vector_type(4)));
typedef float f32x16 __attribute__((ext_vector_type(16)));
typedef unsigned u32x4 __attribute__((ext_vector_type(4)));
typedef unsigned u32x2 __attribute__((ext_vector_type(2)));
#define MFMA32(a, b, c) __builtin_amdgcn_mfma_f32_32x32x16_bf16((a), (b), (c), 0, 0, 0)

__device__ __forceinline__ unsigned pk2(float lo, float hi) { return pg8::cvt_pk_bf16(lo, hi); }
__device__ __forceinline__ float bf_lo(unsigned w) { return __uint_as_float(w << 16); }
__device__ __forceinline__ float bf_hi(unsigned w) { return __uint_as_float(w & 0xffff0000u); }
__device__ __forceinline__ float shx(float v, int k, int lane) { return __int_as_float(__builtin_amdgcn_ds_bpermute((lane ^ k) << 2, __float_as_int(v))); }
__device__ __forceinline__ int shxi(int v, int k, int lane) { return __builtin_amdgcn_ds_bpermute((lane ^ k) << 2, v); }
__device__ __forceinline__ float shx32(float v, int lane) { const unsigned u = __float_as_uint(v); const auto r = __builtin_amdgcn_permlane32_swap(u, u, false, false); return __uint_as_float((lane >> 5) ? r[0] : r[1]); }
__device__ __forceinline__ float wave_sum(float v, int lane) {
#pragma unroll
    for (int o = 1; o < 64; o <<= 1) v += shx(v, o, lane);
    return v;
}
__device__ __forceinline__ float gelu_t(float x) {
    const float u = 0.7978845608028654f * (x + 0.044715f * x * x * x);
    const float e = __expf(2.f * u);
    const float th = 1.f - 2.f / (e + 1.f);
    return 0.5f * x * (1.f + th);
}
__device__ __forceinline__ int tid_opaque() { int t = threadIdx.x; asm volatile("" : "+v"(t)); return t; }
__device__ __forceinline__ int crow(int reg, int h) { return (reg & 3) + 8 * (reg >> 2) + 4 * h; }

struct Params {
    const float* x; const float* attn_g; const float* w_in; const float* diff_lambda; const float* subln_g;
    const float* sgu_ln_g; const float* sgu_ln_b; const float* sgu_w; const float* sgu_b; const float* w_out;
    const float* mlp_g; const float* w1; const float* w2; const float* final_g;
    float* out; unsigned char* ws;
};

__device__ __forceinline__ void transpose_item(const float* W, int K, int N, bf16* WT, LAS float* scr, int item, int lane, const float* gk) {
    const int nblk = N / 32, kb = item / nblk, nb = item % nblk, k0 = 64 * kb, n0 = 32 * nb;
    float wv[32];
#pragma unroll
    for (int i = 0; i < 32; ++i) { const int kk = 2 * i + (lane >> 5); wv[i] = __builtin_nontemporal_load(W + (size_t)(k0 + kk) * N + n0 + (lane & 31)); }
    if (gk) {
#pragma unroll
        for (int i = 0; i < 32; ++i) wv[i] *= gk[k0 + 2 * i + (lane >> 5)];
    }
#pragma unroll
    for (int i = 0; i < 32; ++i) { const int kk = 2 * i + (lane >> 5); scr[kk * 33 + (lane & 31)] = wv[i]; }
    asm volatile("s_waitcnt lgkmcnt(0)" ::: "memory");
    const int c = lane & 7;
#pragma unroll
    for (int j = 0; j < 4; ++j) { const int n = (lane >> 3) + 8 * j; const LAS float* s = scr + (8 * c) * 33 + n;
        u32x4 o; o.x = pk2(s[0 * 33], s[1 * 33]); o.y = pk2(s[2 * 33], s[3 * 33]); o.z = pk2(s[4 * 33], s[5 * 33]); o.w = pk2(s[6 * 33], s[7 * 33]);
        __builtin_nontemporal_store(o, (u32x4*)(WT + (size_t)(n0 + n) * K + k0 + 8 * c)); }
    asm volatile("s_waitcnt lgkmcnt(0)" ::: "memory");
}

constexpr int NU_OWN = 192, NU_GAT = 456, NU_DIF = 384, NU_SGU = 256;
constexpr int U_GAT = NU_OWN, U_DIF = U_GAT + NU_GAT, U_SGU = U_DIF + NU_DIF, NU_ALL = U_SGU + NU_SGU;
constexpr size_t WS_PART = WS_XRES;
__device__ __forceinline__ void gat_decode(int v, int& n, int& C) {
    if (v < 28) { n = v >> 2; C = v & 3; }
    else if (v < 52) { const int w = v - 28; n = 7 + w / 3; C = 1 + w % 3; }
    else if (v < 68) { const int w = v - 52; n = 15 + (w >> 1); C = 2 + (w & 1); }
    else { n = 23 + (v - 68); C = 3; }
}
__device__ __forceinline__ float unit_cost(int u) {
    if (u < U_GAT) return 3.0f;
    if (u < U_DIF) { int n, C; gat_decode((u - U_GAT) % 76, n, C); const int bs = (n + 1 > 8 * C) ? n + 1 : 8 * C; float cnt = 0.f;
        for (int b = bs; b < 8 * C + 8; ++b) cnt += 256.f * (b < 3 ? (float)b : 3.f) / (float)b;
        return 4.0f * (cnt * (1.f / 256.f) + 0.5f); }
    if (u < U_SGU) return 1.7f * (float)(((u - U_DIF) & 63) + 1);
    return 0.5f;
}

__device__ __forceinline__ void phase_weights(const Params& p, LAS unsigned char* lds) {
    const int tid = tid_opaque(), lane = tid & 63, wave = tid >> 6;
    LAS float* scr = (LAS float*)(lds + wave * 16384);
    const int gw = blockIdx.x * NWAVES + wave, NGW = gridDim.x * NWAVES;
    constexpr int I_IN = (DM / 64) * (INW / 32), I_OUT = (DM / 64) * (DM / 32), I_1 = (DM / 64) * (DFF / 32), I_2 = (DFF / 64) * (DM / 32);
    constexpr int PER_LAYER = I_IN + I_OUT + I_1 + I_2;
    for (int it = gw; it < DEPTH * PER_LAYER; it += NGW) {
        const int l = it / PER_LAYER; int r = it % PER_LAYER;
        if (r < I_IN) { transpose_item(p.w_in + (size_t)l * DM * INW, DM, INW, (bf16*)(p.ws + WS_WIN) + (size_t)l * INW * DM, scr, r, lane, p.attn_g + (size_t)l * DM); continue; } r -= I_IN;
        if (r < I_OUT) { transpose_item(p.w_out + (size_t)l * DM * DM, DM, DM, (bf16*)(p.ws + WS_WOUT) + (size_t)l * DM * DM, scr, r, lane, nullptr); continue; } r -= I_OUT;
        if (r < I_1) { transpose_item(p.w1 + (size_t)l * DM * DFF, DM, DFF, (bf16*)(p.ws + WS_W1) + (size_t)l * DFF * DM, scr, r, lane, p.mlp_g + (size_t)l * DM); continue; } r -= I_1;
        transpose_item(p.w2 + (size_t)l * DFF * DM, DFF, DM, (bf16*)(p.ws + WS_W2) + (size_t)l * DM * DFF, scr, r, lane, nullptr);
    }
    if (blockIdx.x == 0) {
        unsigned* ctl = (unsigned*)(p.ws + WS_CTL);
        if (tid < 64) ctl[tid] = 0u;
        int* order = (int*)(p.ws + WS_ORDER);
        LAS float* cst = (LAS float*)(lds + 65536);
        __syncthreads();
        for (int u = tid; u < NU_ALL; u += NTHR) cst[u] = unit_cost(u);
        __syncthreads();
        for (int u = tid; u < NU_ALL; u += NTHR) {
            const float cu = cst[u]; int rank = 0;
            for (int j = 0; j < NU_ALL; ++j) { const float cj = cst[j]; rank += (cj > cu || (cj == cu && j < u)) ? 1 : 0; }
            order[rank] = u;
        }
    }
}

__device__ __forceinline__ void phase_x0(const float* X, bf16* XB, float* SS0) {
    const int tid = tid_opaque(), lane = tid & 63, wave = tid >> 6;
    const int gw = blockIdx.x * NWAVES + wave, NGW = gridDim.x * NWAVES;
    for (int m = gw; m < SEQ; m += NGW) {
        const f32x4* xr = (const f32x4*)(X + (size_t)m * DM) + lane;
        f32x4 v[8]; float s = 0.f;
#pragma unroll
        for (int j = 0; j < 8; ++j) { v[j] = __builtin_nontemporal_load(xr + 64 * j); s += (v[j].x * v[j].x + v[j].y * v[j].y) + (v[j].z * v[j].z + v[j].w * v[j].w); }
        s = wave_sum(s, lane);
        if (lane < 32) SS0[(size_t)m * 32 + lane] = lane == 0 ? s : 0.f;
        u32x2* o8 = (u32x2*)(XB + (size_t)m * DM) + lane;
#pragma unroll
        for (int j = 0; j < 8; ++j) { u32x2 w; w.x = pk2(v[j].x, v[j].y); w.y = pk2(v[j].z, v[j].w); o8[64 * j] = w; }
    }
}
__device__ __forceinline__ void phase_norm_f32(const bf16* X, const float* g, const float* SS, float* O) {
    const int tid = tid_opaque(), lane = tid & 63, wave = tid >> 6;
    const int gw = blockIdx.x * NWAVES + wave, NGW = gridDim.x * NWAVES;
    for (int m = gw; m < SEQ; m += NGW) {
        const u32x4* xr = (const u32x4*)(X + (size_t)m * DM) + lane;
        const float rs = rsqrtf(wave_sum(lane < 32 ? SS[(size_t)m * 32 + lane] : 0.f, lane) * (1.f / DM) + EPS);
        f32x4* o = (f32x4*)(O + (size_t)m * DM) + 2 * lane;
#pragma unroll
        for (int j = 0; j < 4; ++j) { const u32x4 xv = xr[64 * j]; const f32x4 g0 = ((const f32x4*)g)[2 * lane + 128 * j], g1 = ((const f32x4*)g)[2 * lane + 128 * j + 1];
            __builtin_nontemporal_store((f32x4){bf_lo(xv.x), bf_hi(xv.x), bf_lo(xv.y), bf_hi(xv.y)} * rs * g0, o + 128 * j);
            __builtin_nontemporal_store((f32x4){bf_lo(xv.z), bf_hi(xv.z), bf_lo(xv.w), bf_hi(xv.w)} * rs * g1, o + 128 * j + 1); }
    }
}

constexpr int TP_STRIDE = 132;
__device__ __forceinline__ void post_unit(const Params& p, int layer, int unit, LAS unsigned char* lds) {
    const int tid = tid_opaque();
    const int rb = unit / 40, cbi = unit % 40, cb = cbi < 36 ? cbi : cbi + 4;
    const int col0 = cb * 128;
    const int r64 = tid >> 3, j = tid & 7;
    bf16* proj = (bf16*)(p.ws + WS_PROJ);
    int type;
    int hh = 0;
    if (cb < 6) type = 0; else if (cb < 12) type = 1; else if (cb < 18) { type = 2; hh = cb - 12; } else if (cb < 30) type = 3; else if (cb < 36) { type = 2; hh = 6 + cb - 30; } else { type = 4; hh = cb - 40; }
    int c0, c1;
    if (type <= 1) { c0 = 8 * j; c1 = c0 + 64; }
    else if (type == 3) { c0 = (j < 4) ? 8 * j : 64 + 8 * (j - 4); c1 = c0 + 32; }
    else { c0 = 16 * j; c1 = c0 + 8; }
    double inv2pi[8];
    if (type <= 1 || type == 3) {
        const float half = (type == 3) ? 32.f : 64.f; const int i0 = (type == 3) ? 8 * (j & 3) : 8 * j;
#pragma unroll
        for (int e = 0; e < 8; ++e) inv2pi[e] = (double)exp2f(-(float)(i0 + e) * (13.287712379549449f / half)) * 0.15915494309189535;
    } else {
#pragma unroll
        for (int e = 0; e < 8; ++e) inv2pi[e] = 0.0;
    }
    float csa[8], csb[8];
#pragma unroll
    for (int e = 0; e < 8; ++e) { csa[e] = 0.f; csb[e] = 0.f; }
    LAS bf16* tile = (LAS bf16*)lds;
    u32x4 na = *(const u32x4*)(proj + (size_t)(rb * 256 + r64) * INW + col0 + c0), nb = *(const u32x4*)(proj + (size_t)(rb * 256 + r64) * INW + col0 + c1);
    for (int sub = 0; sub < 4; ++sub) {
        const int row = rb * 256 + sub * 64 + r64;
        bf16* rp = proj + (size_t)row * INW + col0;
        const u32x4 ua = na, ub = nb;
        if (sub < 3) { na = *(const u32x4*)(rp + (size_t)64 * INW + c0); nb = *(const u32x4*)(rp + (size_t)64 * INW + c1); }
        float xa[8], xb[8];
#pragma unroll
        for (int e = 0; e < 4; ++e) { xa[2 * e] = bf_lo(ua[e]); xa[2 * e + 1] = bf_hi(ua[e]); xb[2 * e] = bf_lo(ub[e]); xb[2 * e + 1] = bf_hi(ub[e]); }
        if (type <= 1 || type == 3) {
            float ya[8], yb[8];
#pragma unroll
            for (int e = 0; e < 8; ++e) {
                double rev = (double)row * inv2pi[e]; rev -= floor(rev);
                const float fr = (float)rev;
                const float sn = __builtin_amdgcn_sinf(fr), cs = __builtin_amdgcn_cosf(fr);
                ya[e] = xa[e] * cs - xb[e] * sn; yb[e] = xb[e] * cs + xa[e] * sn;
                csa[e] += ya[e]; csb[e] += yb[e];
            }
            u32x4 oa, ob;
#pragma unroll
            for (int e = 0; e < 4; ++e) { oa[e] = pk2(ya[2 * e], ya[2 * e + 1]); ob[e] = pk2(yb[2 * e], yb[2 * e + 1]); }
            *(u32x4*)(rp + c0) = oa; *(u32x4*)(rp + c1) = ob;
        } else {
            u32x4 oa = ua, ob = ub;
            if (type == 4) {
                float s = 0.f;
#pragma unroll
                for (int e = 0; e < 8; ++e) { xa[e] = gelu_t(xa[e]); xb[e] = gelu_t(xb[e]); s += xa[e] + xb[e]; }
                s += shx(s, 1, tid & 63); s += shx(s, 2, tid & 63); s += shx(s, 4, tid & 63);
                const float mu = s * (1.f / 128.f); float s2 = 0.f;
#pragma unroll
                for (int e = 0; e < 8; ++e) { xa[e] -= mu; xb[e] -= mu; s2 += xa[e] * xa[e] + xb[e] * xb[e]; }
                s2 += shx(s2, 1, tid & 63); s2 += shx(s2, 2, tid & 63); s2 += shx(s2, 4, tid & 63);
                const float rstd = rsqrtf(s2 * (1.f / 128.f) + EPS);
                const float* lg = p.sgu_ln_g + ((size_t)layer * 4 + hh) * 128; const float* lb = p.sgu_ln_b + ((size_t)layer * 4 + hh) * 128;
#pragma unroll
                for (int e = 0; e < 8; ++e) { xa[e] = xa[e] * rstd * lg[c0 + e] + lb[c0 + e]; xb[e] = xb[e] * rstd * lg[c1 + e] + lb[c1 + e]; }
#pragma unroll
                for (int e = 0; e < 4; ++e) { oa[e] = pk2(xa[2 * e], xa[2 * e + 1]); ob[e] = pk2(xb[2 * e], xb[2 * e + 1]); }
            }
            __syncthreads();
            LAS u32x2* t0 = (LAS u32x2*)(tile + r64 * TP_STRIDE + c0);
            t0[0] = (u32x2){oa.x, oa.y}; t0[1] = (u32x2){oa.z, oa.w}; t0[2] = (u32x2){ob.x, ob.y}; t0[3] = (u32x2){ob.z, ob.w};
            __syncthreads();
            const int dv = tid >> 2, ch = tid & 3;
            unsigned w[8];
#pragma unroll
            for (int k = 0; k < 8; ++k) { const unsigned lo = tile[(16 * ch + 2 * k) * TP_STRIDE + dv], hi = tile[(16 * ch + 2 * k + 1) * TP_STRIDE + dv]; w[k] = lo | (hi << 16); }
            bf16* dst;
            if (type == 2) dst = (bf16*)(p.ws + WS_VT) + ((size_t)hh * 128 + dv) * SEQ + rb * 256 + sub * 64 + 16 * ch;
            else dst = (bf16*)(p.ws + WS_VNT) + ((size_t)((rb * 2 + (sub >> 1)) * 4 + hh) * 128 + dv) * 128 + (sub & 1) * 64 + 16 * ch;
            if (type == 2) { *(u32x4*)dst = (u32x4){w[0], w[1], w[4], w[5]}; *(u32x4*)(dst + 8) = (u32x4){w[2], w[3], w[6], w[7]}; }
            else { *(u32x4*)dst = (u32x4){w[0], w[1], w[2], w[3]}; *(u32x4*)(dst + 8) = (u32x4){w[4], w[5], w[6], w[7]}; }
        }
    }
    if (type == 1) {
        __syncthreads();
        LAS float* red = (LAS float*)lds;
#pragma unroll
        for (int e = 0; e < 8; ++e) { red[r64 * 128 + c0 + e] = csa[e]; red[r64 * 128 + c1 + e] = csb[e]; }
        __syncthreads();
        if (tid < 128) { float s = 0.f; for (int r = 0; r < 64; ++r) s += red[r * 128 + tid];
            ((float*)(p.ws + WS_KM))[((size_t)(cb - 6) * 32 + rb) * 128 + tid] = s * (1.f / 256.f); }
    }
    __syncthreads();
}

__device__ __forceinline__ void sgu_item(const Params& p, int layer, int item) {
    const int tid = tid_opaque(), lane = tid & 63, wave = tid >> 6, r = lane & 31, h = lane >> 5;
    const int nc = item >> 2, g = item & 3;
    const int tb = wave >> 1;
    const float* W = p.sgu_w + ((size_t)layer * 4 + g) * 128 * 128;
    const bf16* vnt = (const bf16*)(p.ws + WS_VNT) + (size_t)(nc * 4 + g) * 128 * 128;
    const bf16* proj = (const bf16*)(p.ws + WS_PROJ);
    bf16* mix = (bf16*)(p.ws + WS_MIX);
    const int t = 32 * tb + r;
    f32x4 wl[8][2];
#pragma unroll
    for (int ks = 0; ks < 8; ++ks) { const int s0 = 16 * ks + 8 * h; wl[ks][0] = *(const f32x4*)(W + t * 128 + s0); wl[ks][1] = *(const f32x4*)(W + t * 128 + s0 + 4); }
    bf16x8 bfr[2][8];
#pragma unroll
    for (int cc = 0; cc < 2; ++cc)
#pragma unroll
        for (int ks = 0; ks < 8; ++ks) bfr[cc][ks] = *(const bf16x8*)(vnt + (size_t)(32 * ((wave & 1) * 2 + cc) + r) * 128 + 16 * ks + 8 * h);
    bf16x8 af[8];
#pragma unroll
    for (int ks = 0; ks < 8; ++ks) { const int s0 = 16 * ks + 8 * h;
        float wv[8] = {wl[ks][0].x, wl[ks][0].y, wl[ks][0].z, wl[ks][0].w, wl[ks][1].x, wl[ks][1].y, wl[ks][1].z, wl[ks][1].w};
#pragma unroll
        for (int e = 0; e < 8; ++e) wv[e] = (s0 + e <= t) ? wv[e] : 0.f;
        u32x4 au; au.x = pk2(wv[0], wv[1]); au.y = pk2(wv[2], wv[3]); au.z = pk2(wv[4], wv[5]); au.w = pk2(wv[6], wv[7]);
        af[ks] = __builtin_bit_cast(bf16x8, au); }
#pragma unroll
    for (int cc = 0; cc < 2; ++cc) {
        const int cbk = (wave & 1) * 2 + cc;
        const int c = 32 * cbk + r;
        unsigned short ur[16]; float br[16];
#pragma unroll
        for (int i = 0; i < 16; ++i) { const int tt = 32 * tb + crow(i, h); ur[i] = proj[((size_t)nc * 128 + tt) * INW + C_SU + g * 128 + c]; br[i] = p.sgu_b[((size_t)layer * 4 + g) * 128 + tt]; }
        f32x16 acc;
#pragma unroll
        for (int i = 0; i < 16; ++i) acc[i] = 0.f;
#pragma unroll
        for (int ks = 0; ks < 8; ++ks) acc = MFMA32(af[ks], bfr[cc][ks], acc);
#pragma unroll
        for (int i = 0; i < 16; ++i) {
            const int tt = 32 * tb + crow(i, h);
            const size_t tok = (size_t)nc * 128 + tt;
            const float u = gelu_t(__uint_as_float(((unsigned)ur[i]) << 16));
            const float o = u * (acc[i] + br[i]);
            mix[tok * DM + 1536 + g * 128 + c] = (bf16)(pk2(o, 0.f) & 0xffffu);
        }
    }
}

constexpr int KT_BYTES = 16384, VT_BYTES = 16384;
constexpr int ABUF = KT_BYTES + VT_BYTES;
constexpr float LOG2E = 1.4426950408889634f;

__device__ __forceinline__ void tile_dma(LAS unsigned char* slot, const bf16* proj, const bf16* vt, int kcol, int hh, int kbase, int wave, int lane) {
#pragma unroll
    for (int i = 0; i < 2; ++i) { const int c = i * 8 + wave, row = 4 * c + (lane >> 4), g = (lane & 15) ^ (row & 15);
        __builtin_amdgcn_global_load_lds((const unsigned*)(proj + (size_t)(kbase + row) * INW + kcol + g * 8), (LAS unsigned*)(slot + c * 1024), 16, 0, 0); }
#pragma unroll
    for (int i = 0; i < 2; ++i) { const int c = i * 8 + wave, row = 8 * c + (lane >> 3), g = (lane & 7) ^ ((row >> 1) & 7);
        __builtin_amdgcn_global_load_lds((const unsigned*)(vt + ((size_t)hh * 128 + row) * SEQ + kbase + g * 8), (LAS unsigned*)(slot + KT_BYTES + c * 1024), 16, 0, 0); }
}

#define TOP3_INSERT(v, n) do { if ((v) > v0 || ((v) == v0 && (n) < i0)) { v2 = v1; i2 = i1; v1 = v0; i1 = i0; v0 = (v); i0 = (n); } \
    else if ((v) > v1 || ((v) == v1 && (n) < i1)) { v2 = v1; i2 = i1; v1 = (v); i1 = (n); } \
    else if ((v) > v2 || ((v) == v2 && (n) < i2)) { v2 = (v); i2 = (n); } } while (0)
__device__ __forceinline__ unsigned moba_gate(const Params& p, int h, int own, const bf16x8 (&qf)[8], int lane) {
    const int r = lane & 31, hf = lane >> 5;
    unsigned selmask = 0u;
    if (own > 0) {
        f32x16 gt;
#pragma unroll
        for (int i = 0; i < 16; ++i) gt[i] = 0.f;
        const float* kmg = (const float*)(p.ws + WS_KM) + ((size_t)h * 32 + r) * 128 + 8 * hf;
#pragma unroll
        for (int ks = 0; ks < 8; ++ks) {
            const f32x4 a0 = *(const f32x4*)(kmg + 16 * ks), a1 = *(const f32x4*)(kmg + 16 * ks + 4);
            u32x4 hi; hi.x = pk2(a0.x, a0.y); hi.y = pk2(a0.z, a0.w); hi.z = pk2(a1.x, a1.y); hi.w = pk2(a1.z, a1.w);
            u32x4 lo; lo.x = pk2(a0.x - bf_lo(hi.x), a0.y - bf_hi(hi.x)); lo.y = pk2(a0.z - bf_lo(hi.y), a0.w - bf_hi(hi.y));
            lo.z = pk2(a1.x - bf_lo(hi.z), a1.y - bf_hi(hi.z)); lo.w = pk2(a1.z - bf_lo(hi.w), a1.w - bf_hi(hi.w));
            gt = MFMA32(__builtin_bit_cast(bf16x8, hi), qf[ks], gt);
            gt = MFMA32(__builtin_bit_cast(bf16x8, lo), qf[ks], gt);
        }
        float v0 = -INFINITY, v1 = -INFINITY, v2 = -INFINITY; int i0 = 64, i1 = 64, i2 = 64;
#pragma unroll
        for (int i = 0; i < 16; ++i) { const int n = crow(i, hf); if (n < own) TOP3_INSERT(gt[i], n); }
        const float pv0 = shx(v0, 32, lane), pv1 = shx(v1, 32, lane), pv2 = shx(v2, 32, lane);
        const int pi0 = shxi(i0, 32, lane), pi1 = shxi(i1, 32, lane), pi2 = shxi(i2, 32, lane);
        if (pi0 < 64) TOP3_INSERT(pv0, pi0);
        if (pi1 < 64) TOP3_INSERT(pv1, pi1);
        if (pi2 < 64) TOP3_INSERT(pv2, pi2);
        if (i0 < 64) selmask |= 1u << i0;
        if (i1 < 64) selmask |= 1u << i1;
        if (i2 < 64) selmask |= 1u << i2;
    }
    return selmask;
}
__device__ __forceinline__ void sel_item(const Params& p, int item) {
    const int tid = tid_opaque(), lane = tid & 63, wave = tid >> 6, r = lane & 31, hf = lane >> 5;
    const int h = item >> 5, qb = item & 31, q = qb * 256 + 32 * wave + r;
    const bf16* proj = (const bf16*)(p.ws + WS_PROJ);
    bf16x8 qf[8];
#pragma unroll
    for (int ks = 0; ks < 8; ++ks) qf[ks] = *(const bf16x8*)(proj + (size_t)q * INW + C_MQ + h * 128 + 16 * ks + 8 * hf);
    const unsigned mask = moba_gate(p, h, qb, qf, lane);
    if (hf == 0) ((unsigned*)(p.ws + WS_SEL))[(size_t)h * SEQ + q] = mask;
}
template <int MODE>
__device__ __forceinline__ void attn_unit(const Params& p, int layer, int h, int qb, LAS unsigned char* lds, int gq, bool gactive, int gj, int gtile0) {
    constexpr int NKS = MODE == 1 ? 4 : 8;
    const int tid = tid_opaque(), lane = tid & 63, wave = __builtin_amdgcn_readfirstlane(tid >> 6), r = lane & 31, hf = lane >> 5;
    const int grp = wave >> 2;
    const bf16* proj = (const bf16*)(p.ws + WS_PROJ);
    const bf16* vt = (const bf16*)(p.ws + WS_VT);
    bf16* mix = (bf16*)(p.ws + WS_MIX);
    int wrow0, ntiles, qcol, kcol, kc0, hh, tile0; float scale;
    if (MODE != 1) { wrow0 = MODE == 0 ? qb * 256 + 32 * wave : (1 << 20); tile0 = MODE == 0 ? 4 * qb : gtile0; ntiles = 4; qcol = C_MQ + h * 128; kcol = C_MK + h * 128; kc0 = 0; hh = h; scale = 0.08838834764831845f * LOG2E; }
    else { tile0 = 0; wrow0 = qb * 128 + 32 * (wave & 3); ntiles = 2 * (qb + 1); qcol = C_DQ + h * 128 + grp * 64; kcol = C_DK + h * 128; kc0 = grp * 64; hh = 6 + h; scale = 0.125f * LOG2E; }
    const LAS unsigned short* glist = (const LAS unsigned short*)(lds + 102400);
    int q;
    if (MODE == 2) { const int idx = gq + 32 * wave + r; q = glist[idx < gj ? idx : 0]; } else q = wrow0 + r;
    bf16x8 qf[NKS];
#pragma unroll
    for (int ks = 0; ks < NKS; ++ks) qf[ks] = *(const bf16x8*)(proj + (size_t)q * INW + qcol + 16 * ks + 8 * hf);
    f32x16 o[4];
#pragma unroll
    for (int d = 0; d < 4; ++d)
#pragma unroll
        for (int i = 0; i < 16; ++i) o[d][i] = 0.f;
    float m = -1e30f, l = 0.f;
    bf16x8 pf[4];
#pragma unroll
    for (int k = 0; k < 4; ++k) pf[k] = (bf16x8){0, 0, 0, 0, 0, 0, 0, 0};
    bool prev_on = false;
    tile_dma(lds, proj, vt, kcol, hh, tile0 * 64, wave, lane);
    const unsigned ck = (unsigned)(r * 256 + 16 * ((r & 15) ^ hf));
    const unsigned cv = (unsigned)(KT_BYTES + r * 128 + 16 * (((r >> 1) & 7) ^ hf));
    asm volatile("s_waitcnt vmcnt(0)" ::: "memory");
    __syncthreads();
#define ATTN_BACK(vbuf) do { _Pragma("unroll") for (int k4 = 0; k4 < 4; ++k4) { bf16x8 vf_[4]; \
        _Pragma("unroll") for (int d = 0; d < 4; ++d) { \
            const unsigned x_ = ((vbuf) + cv) ^ (unsigned)(32 * k4); \
            vf_[d] = *(const LAS bf16x8*)(lds + x_ + 4096 * d); } \
        __builtin_amdgcn_sched_barrier(0); \
        _Pragma("unroll") for (int d = 0; d < 4; ++d) o[d] = MFMA32(vf_[d], pf[k4], o[d]); \
        __builtin_amdgcn_sched_barrier(0); } } while (0)
    const bool defer = (MODE == 1) && (grp == 1);
    int slot = 0;
    for (int t = 0; t < ntiles; ++t) {
        const int kbase = (tile0 + t) * 64;
        const unsigned buf = (unsigned)(slot * ABUF);
        const unsigned bufp = (unsigned)((slot == 0 ? 2 : slot - 1) * ABUF);
        const int nslot = slot == 2 ? 0 : slot + 1;
        if (t + 1 < ntiles) tile_dma(lds + nslot * ABUF, proj, vt, kcol, hh, kbase + 64, wave, lane);
        if (defer && prev_on) ATTN_BACK(bufp);
        const bool lane_on = true;
        const bool wave_on = (MODE == 2) || (kbase <= wrow0 + 31);
        if (wave_on) {
            f32x16 s[2];
#pragma unroll
            for (int b = 0; b < 2; ++b) {
#pragma unroll
                for (int i = 0; i < 16; ++i) s[b][i] = 0.f;
#pragma unroll
                for (int k0 = 0; k0 < NKS; k0 += 4) {
                    bf16x8 kf[4];
#pragma unroll
                    for (int ks = 0; ks < 4; ++ks) kf[ks] = *(const LAS bf16x8*)(lds + ((buf + 8192u * b + ck) ^ (unsigned)(2 * kc0 + 32 * (k0 + ks))));
                    __builtin_amdgcn_sched_barrier(0);
#pragma unroll
                    for (int ks = 0; ks < 4; ++ks) s[b] = MFMA32(kf[ks], qf[k0 + ks], s[b]);
                    __builtin_amdgcn_sched_barrier(0);
                }
            }
            const bool diag = (MODE != 2) && (kbase + 63 > wrow0);
            float mx = -INFINITY;
            bool lane_off = false;
            if (diag) {
                asm volatile("" ::: "memory");
#pragma unroll
                for (int b = 0; b < 2; ++b)
#pragma unroll
                    for (int i = 0; i < 16; ++i) {
                        const int key = kbase + 32 * b + crow(i, hf);
                        const bool ok = lane_on && (key <= q);
                        s[b][i] = ok ? s[b][i] : -INFINITY;
                        mx = fmaxf(mx, s[b][i]);
                    }
            } else {
#pragma unroll
                for (int b = 0; b < 2; ++b)
#pragma unroll
                    for (int i = 0; i < 16; ++i) mx = fmaxf(mx, s[b][i]);
            }
            mx = fmaxf(mx, shx32(mx, lane));
            const float mn = fmaxf(m, mx);
            const float alpha = __builtin_amdgcn_exp2f((m - mn) * scale);
            const float mns = lane_off ? INFINITY : mn * scale;
            float ls = 0.f;
#pragma unroll
            for (int b = 0; b < 2; ++b)
#pragma unroll
                for (int i = 0; i < 16; ++i) { const float pv = __builtin_amdgcn_exp2f(s[b][i] * scale - mns); s[b][i] = pv; ls += pv; }
            l = l * alpha + ls;
            __builtin_amdgcn_sched_barrier(0);
            if (__builtin_amdgcn_ballot_w64(mn != m) != 0ull) {
#pragma unroll
                for (int d = 0; d < 4; ++d)
#pragma unroll
                    for (int i = 0; i < 16; ++i) o[d][i] *= alpha;
            }
            m = mn;
#pragma unroll
            for (int b = 0; b < 2; ++b)
#pragma unroll
                for (int ss = 0; ss < 2; ++ss) {
                    u32x4 pu;
                    pu.x = pk2(s[b][8 * ss + 0], s[b][8 * ss + 1]); pu.y = pk2(s[b][8 * ss + 2], s[b][8 * ss + 3]);
                    pu.z = pk2(s[b][8 * ss + 4], s[b][8 * ss + 5]); pu.w = pk2(s[b][8 * ss + 6], s[b][8 * ss + 7]);
                    pf[2 * b + ss] = __builtin_bit_cast(bf16x8, pu);
                }
            if (!defer) ATTN_BACK(buf);
        }
        prev_on = wave_on;
        slot = nslot;
        asm volatile("s_waitcnt vmcnt(0)" ::: "memory");
        __syncthreads();
    }
    if (defer && prev_on) { const unsigned bufp = (unsigned)((slot == 0 ? 2 : slot - 1) * ABUF); ATTN_BACK(bufp); }
#undef ATTN_BACK
    const float lt = l + shx(l, 32, lane);
    const float inv = 1.f / lt;
    if (MODE != 1) {
        int q2 = q, jj = 3; bool act = true;
        if (MODE == 2) {
            const int t2 = tid_opaque(), idx = gq + 32 * (t2 >> 6) + (t2 & 31); act = idx < gj; q2 = glist[act ? idx : 0];
            jj = __builtin_popcount(((const unsigned*)(p.ws + WS_SEL))[(size_t)h * SEQ + q2] & ((1u << (gtile0 >> 2)) - 1u)); }
        if (act) {
            unsigned* rec = (unsigned*)(p.ws + WS_PART) + (((size_t)h * SEQ + q2) * 4 + jj) * 68;
            if (hf == 0) { rec[0] = __float_as_uint(m * scale); rec[1] = __float_as_uint(lt); }
#pragma unroll
            for (int d = 0; d < 4; ++d)
#pragma unroll
                for (int g4 = 0; g4 < 4; ++g4) {
                    u32x2 w; w.x = pk2(o[d][4 * g4] * inv, o[d][4 * g4 + 1] * inv); w.y = pk2(o[d][4 * g4 + 2] * inv, o[d][4 * g4 + 3] * inv);
                    *(u32x2*)(rec + 4 + 16 * d + 4 * g4 + 2 * hf) = w;
                }
        }
    } else {
        __syncthreads();
        LAS float* ex = (LAS float*)lds;
        const int wi = wave & 3;
        if (wave >= 4) {
#pragma unroll
            for (int d = 0; d < 4; ++d)
#pragma unroll
                for (int i = 0; i < 16; ++i) ex[(wi * 64 + d * 16 + i) * 64 + lane] = o[d][i] * inv;
        }
        __syncthreads();
        if (wave < 4) {
            int ly = layer; asm volatile("" : "+s"(ly));
            float c08 = 0.8f, c06 = 0.6f; asm volatile("" : "+s"(c08), "+s"(c06));
            const float lin = c08 - c06 * __expf(-0.3f * (float)ly);
            const float* lp = p.diff_lambda + (size_t)ly * 256;
            const float la = wave_sum(lp[lane] * lp[64 + lane], lane), lb = wave_sum(lp[128 + lane] * lp[192 + lane], lane);
            const float lamv = __expf(la) - __expf(lb) + lin, oml = 1.f - lin;
            float ss = 0.f;
#pragma unroll
            for (int d = 0; d < 4; ++d) {
#pragma unroll
                for (int i = 0; i < 16; ++i) { const float v = o[d][i] * inv - lamv * ex[(wi * 64 + d * 16 + i) * 64 + lane]; o[d][i] = v; ss += v * v; }
                __builtin_amdgcn_sched_barrier(0);
            }
            ss += shx(ss, 32, lane);
            const float rs = rsqrtf(ss * (1.f / 128.f) + EPS) * oml;
            const float* sg = p.subln_g + (size_t)layer * 128;
#pragma unroll
            for (int d = 0; d < 4; ++d)
#pragma unroll
                for (int g4 = 0; g4 < 4; ++g4) {
                    const int dv = 32 * d + 8 * g4 + 4 * hf;
                    const f32x4 gg = *(const f32x4*)(sg + dv);
                    u32x2 w; w.x = pk2(o[d][4 * g4] * rs * gg.x, o[d][4 * g4 + 1] * rs * gg.y); w.y = pk2(o[d][4 * g4 + 2] * rs * gg.z, o[d][4 * g4 + 3] * rs * gg.w);
                    *(u32x2*)(mix + (size_t)q * DM + 768 + h * 128 + dv) = w;
                }
        }
        __syncthreads();
    }
}

__device__ __forceinline__ void gathered_unit(const Params& p, int layer, int h, int v, LAS unsigned char* lds) {
    const int tid = tid_opaque(), lane = tid & 63, wave = tid >> 6, r = lane & 31;
    int n, C; gat_decode(v, n, C);
    const int bs = (n + 1 > 8 * C) ? n + 1 : 8 * C, q0 = bs * 256, q1 = (8 * C + 8) * 256;
    LAS unsigned short* list = (LAS unsigned short*)(lds + 102400);
    LAS int* cnt = (LAS int*)(lds + LDS_MISC + 12);
    const unsigned* sel = (const unsigned*)(p.ws + WS_SEL) + (size_t)h * SEQ;
    if (tid == 0) *cnt = 0;
    __syncthreads();
    for (int q = q0 + tid; q < q1; q += NTHR)
        if ((sel[q] >> n) & 1u) { const int s = __hip_atomic_fetch_add(cnt, 1, __ATOMIC_RELAXED, __HIP_MEMORY_SCOPE_WORKGROUP); list[s] = (unsigned short)q; }
    __syncthreads();
    const int count = *(volatile LAS int*)cnt;
    for (int g0 = 0; g0 < count; g0 += 256) {
        attn_unit<2>(p, layer, h, 0, lds, g0, true, count, 4 * n);
        __syncthreads();
    }
}
__device__ __forceinline__ void phase_attn(const Params& p, int layer, LAS unsigned char* lds) {
    const int tid = tid_opaque();
    volatile LAS int* misc = (volatile LAS int*)(lds + LDS_MISC);
    unsigned* ctr = (unsigned*)(p.ws + WS_CTL) + layer;
    const int* order = (const int*)(p.ws + WS_ORDER);
    for (;;) {
        if (tid == 0) misc[0] = (int)atomicAdd(ctr, 1u);
        __syncthreads();
        const int idx = misc[0];
        __syncthreads();
        if (idx >= NU_ALL) break;
        const int u = order[idx];
        if (u < U_GAT) attn_unit<0>(p, layer, u >> 5, u & 31, lds, 0, true, 3, 0);
        else if (u < U_DIF) gathered_unit(p, layer, (u - U_GAT) / 76, (u - U_GAT) % 76, lds);
        else if (u < U_SGU) { const int w = u - U_DIF; attn_unit<1>(p, layer, w >> 6, w & 63, lds, 0, true, 0, 0); }
        else sgu_item(p, layer, u - U_SGU);
    }
}
__device__ __forceinline__ void phase_merge(const Params& p) {
    const int tid = tid_opaque(), lane = tid & 63, wave = tid >> 6;
    const int gw = blockIdx.x * NWAVES + wave, NGW = gridDim.x * NWAVES;
    bf16* mix = (bf16*)(p.ws + WS_MIX);
    for (int it = gw; it < 6 * SEQ; it += NGW) {
        const int h = it / SEQ, q = it % SEQ, cnt = (q >> 8) < 3 ? (q >> 8) : 3;
        const unsigned* rec = (const unsigned*)(p.ws + WS_PART) + ((size_t)h * SEQ + q) * 4 * 68;
        float mj[4], lj[4]; unsigned ow[4];
#pragma unroll
        for (int j = 0; j < 4; ++j) { const bool ok = (j == 3) || (j < cnt);
            mj[j] = ok ? __uint_as_float(rec[j * 68]) : -INFINITY; lj[j] = ok ? __uint_as_float(rec[j * 68 + 1]) : 0.f; ow[j] = ok ? rec[j * 68 + 4 + lane] : 0u; }
        const float M = fmaxf(fmaxf(mj[0], mj[1]), fmaxf(mj[2], mj[3]));
        float W = 0.f, a0 = 0.f, a1 = 0.f;
#pragma unroll
        for (int j = 0; j < 4; ++j) { const float w = lj[j] * __builtin_amdgcn_exp2f(mj[j] - M); W += w; a0 += w * bf_lo(ow[j]); a1 += w * bf_hi(ow[j]); }
        const float iw = 1.f / W;
        ((unsigned*)(mix + (size_t)q * DM + h * 128))[lane] = pk2(a0 * iw, a1 * iw);
    }
}

#define XB_TMO      128
#define XB_XCNT(j)  (256  + 64 * (j))
#define XB_XSUB(j)  (1280 + 64 * (j))
#define XB_XGEN(j)  (2304 + 64 * (j))
#define XB_TOP      3328
#define XB_TOPGEN   3392
#define XCD_BAR_WORDS 3456
#define XB_SPIN_CAP (1u << 18)

__device__ __forceinline__ unsigned xb_ld(unsigned* p)              { return __hip_atomic_load(p, __ATOMIC_RELAXED, __HIP_MEMORY_SCOPE_AGENT); }
__device__ __forceinline__ unsigned xb_add(unsigned* p, unsigned v) { return __hip_atomic_fetch_add(p, v, __ATOMIC_RELAXED, __HIP_MEMORY_SCOPE_AGENT); }
__device__ __forceinline__ unsigned xb_xcc_id() { return (unsigned)__builtin_amdgcn_s_getreg((3 << 11) | 20) & 0xFu; }
#define XB_SPIN(cond, bar) do { unsigned _sp = 0; while (cond) { __builtin_amdgcn_s_sleep(1); \
    if ((++_sp & 255u) == 0u) { if (xb_ld(&(bar)[XB_TMO])) break; if (_sp > XB_SPIN_CAP) { atomicAdd(&(bar)[XB_TMO], 1u); break; } } } } while (0)

struct XcdBarrier {
    unsigned* bar; unsigned x;
    volatile LAS unsigned* st;
};

__device__ __forceinline__ XcdBarrier xcd_barrier_post(unsigned* bar, volatile LAS unsigned* st) {
    XcdBarrier b; b.bar = bar; b.x = xb_xcc_id(); b.st = st;
    if (threadIdx.x == 0) (void)xb_add(&bar[XB_XCNT(b.x)], 1u);
    return b;
}
__device__ __forceinline__ void xcd_barrier_complete(unsigned* bar, unsigned x, unsigned& nloc, unsigned& nx) {
    const unsigned G = gridDim.x * gridDim.y * gridDim.z;
    unsigned sum, cnt, mine, sp = 0u;
    for (;;) {
        sum = 0u; cnt = 0u; mine = 0u;
#pragma unroll
        for (unsigned j = 0; j < 16; ++j) { const unsigned c = xb_ld(&bar[XB_XCNT(j)]); sum += c; cnt += (c > 0u) ? 1u : 0u; mine = (j == x) ? c : mine; }
        if (sum == G) break;
        __builtin_amdgcn_s_sleep(1);
        if ((++sp & 255u) == 0u) { if (xb_ld(&bar[XB_TMO])) break; if (sp > XB_SPIN_CAP) { atomicAdd(&bar[XB_TMO], 1u); break; } }
    }
    nloc = mine > 0u ? mine : 1u; nx = cnt > 0u ? cnt : 1u;
}

__device__ __forceinline__ void xcd_barrier(const XcdBarrier& b) {
    asm volatile("s_waitcnt vmcnt(0)" ::: "memory");
    __syncthreads();
    if (threadIdx.x == 0) {
        unsigned* bar = b.bar;
        __builtin_amdgcn_s_waitcnt(0);
        unsigned nloc = b.st[0], nx = b.st[1];
        if (nloc == 0u) { xcd_barrier_complete(bar, b.x, nloc, nx); b.st[0] = nloc; b.st[1] = nx; }
        const unsigned old = xb_add(&bar[XB_XSUB(b.x)], 1u);
        const unsigned gen = old / nloc;
        if (old + 1u == (gen + 1u) * nloc) {
            __builtin_amdgcn_fence(__ATOMIC_RELEASE, "agent");
            asm volatile("s_waitcnt vmcnt(0)" ::: "memory");
            const unsigned og = xb_add(&bar[XB_TOP], 1u);
            const unsigned tg = og / nx;
            if (og + 1u == (tg + 1u) * nx) xb_add(&bar[XB_TOPGEN], 1u);
            else XB_SPIN(xb_ld(&bar[XB_TOPGEN]) == tg, bar);
            __builtin_amdgcn_fence(__ATOMIC_ACQUIRE, "agent");
            xb_add(&bar[XB_XGEN(b.x)], 1u);
            asm volatile("s_waitcnt vmcnt(0)" ::: "memory");
        } else {
            XB_SPIN(xb_ld(&bar[XB_XGEN(b.x)]) == gen, bar);
            __builtin_amdgcn_fence(__ATOMIC_ACQUIRE, "agent");
            asm volatile("s_waitcnt vmcnt(0)" ::: "memory");
        }
    }
    __syncthreads();
}


__global__ void __launch_bounds__(NTHR, 2) trunk_fwd(Params p) {
    extern __shared__ __attribute__((aligned(16))) unsigned char lds_raw[];
    LAS unsigned char* lds = (LAS unsigned char*)lds_raw;
    cg::grid_group grid = cg::this_grid();
    const int G = gridDim.x, bid = blockIdx.x;
    unsigned char* ws = p.ws;
    bf16* H = (bf16*)(ws + WS_H); bf16* PROJ = (bf16*)(ws + WS_PROJ); bf16* MIX = (bf16*)(ws + WS_MIX); bf16* HID = (bf16*)(ws + WS_HID);

    volatile LAS unsigned* xst = (volatile LAS unsigned*)(lds + LDS_MISC + 64);
    if (threadIdx.x < 4) xst[threadIdx.x] = 0u;
    if (bid == 0) { unsigned* bw = (unsigned*)(ws + WS_BAR); for (int i = threadIdx.x; i < XCD_BAR_WORDS; i += NTHR) bw[i] = 0u; }
    phase_weights(p, lds);
    float* SS = (float*)(ws + WS_SS);
    phase_x0(p.x, H, SS);
    grid.sync();
    const XcdBarrier xb = xcd_barrier_post((unsigned*)(ws + WS_BAR), xst);
#define GRID_BAR() xcd_barrier(xb)
    for (int layer = 0; layer < DEPTH; ++layer) {
        {
            pg8::Gemm g{H, (const bf16*)(ws + WS_WIN) + (size_t)layer * INW * DM, SEQ, INW, DM}; pg8::StaticOrder S; S.init(SEQ, INW, G, bid);
            pg8::EpiBf16<0> E{PROJ, INW, SS + (size_t)(2 * layer) * SEQ * 32, 1.f / DM, (const LAS float*)(lds + 131072)};
            pg8::gemm_phase(lds, g, S, E);
        }
        GRID_BAR();
        for (int u = bid; u < 32 * 40; u += G) post_unit(p, layer, u, lds);
        GRID_BAR();
        for (int it = bid; it < 192; it += G) sel_item(p, it);
        GRID_BAR();
        phase_attn(p, layer, lds);
        GRID_BAR();
        phase_merge(p);
        GRID_BAR();
        {
            pg8::Gemm g{MIX, (const bf16*)(ws + WS_WOUT) + (size_t)layer * DM * DM, SEQ, DM, DM}; pg8::StaticOrder S; S.init(SEQ, DM, G, bid);
            pg8::EpiResid E{H, SS + (size_t)(2 * layer + 1) * SEQ * 32, DM};
            pg8::gemm_phase(lds, g, S, E);
        }
        GRID_BAR();
        {
            pg8::Gemm g{H, (const bf16*)(ws + WS_W1) + (size_t)layer * DFF * DM, SEQ, DFF, DM}; pg8::StaticOrder S; S.init(SEQ, DFF, G, bid);
            pg8::EpiBf16<1> E{HID, DFF, SS + (size_t)(2 * layer + 1) * SEQ * 32, 1.f / DM, (const LAS float*)(lds + 131072)};
            pg8::gemm_phase(lds, g, S, E);
        }
        GRID_BAR();
        {
            pg8::Gemm g{HID, (const bf16*)(ws + WS_W2) + (size_t)layer * DM * DFF, SEQ, DM, DFF}; pg8::StaticOrder S; S.init(SEQ, DM, G, bid);
            pg8::EpiResid E{H, SS + (size_t)(2 * layer + 2) * SEQ * 32, DM};
            pg8::gemm_phase(lds, g, S, E);
        }
        GRID_BAR();
    }
    phase_norm_f32(H, p.final_g, SS + (size_t)8 * SEQ * 32, p.out);
}

extern "C" void kernel_launch(void* const* d_in, const int* in_sizes, int n_in, void* d_out, int out_size, void* d_ws, size_t ws_size, hipStream_t stream) {
    static int grid_blocks = 0;
    if (grid_blocks == 0) {
        if (n_in != 14 || ws_size < WS_END) { fprintf(stderr, "kernel_launch: unexpected inputs (n_in %d, ws %zu, need %zu)\n", n_in, ws_size, (size_t)WS_END); grid_blocks = -1; return; }
        int dev = 0, cus = 0, per_cu = 0;
        hipGetDevice(&dev);
        hipDeviceGetAttribute(&cus, hipDeviceAttributeMultiprocessorCount, dev);
        hipFuncSetAttribute((const void*)trunk_fwd, hipFuncAttributeMaxDynamicSharedMemorySize, LDS_BYTES);
        hipOccupancyMaxActiveBlocksPerMultiprocessor(&per_cu, (const void*)trunk_fwd, NTHR, LDS_BYTES);
        if (per_cu < 1) per_cu = 1;
        grid_blocks = cus * per_cu;
        (void)hipGetLastError();
    }
    if (grid_blocks < 0) return;
    Params p{};
    p.x = (const float*)d_in[0]; p.attn_g = (const float*)d_in[1]; p.w_in = (const float*)d_in[2]; p.diff_lambda = (const float*)d_in[3]; p.subln_g = (const float*)d_in[4];
    p.sgu_ln_g = (const float*)d_in[5]; p.sgu_ln_b = (const float*)d_in[6]; p.sgu_w = (const float*)d_in[7]; p.sgu_b = (const float*)d_in[8]; p.w_out = (const float*)d_in[9];
    p.mlp_g = (const float*)d_in[10]; p.w1 = (const float*)d_in[11]; p.w2 = (const float*)d_in[12]; p.final_g = (const float*)d_in[13];
    p.out = (float*)d_out; p.ws = (unsigned char*)d_ws;
    void* args[] = {&p};
    hipError_t e = hipLaunchCooperativeKernel((const void*)trunk_fwd, dim3(grid_blocks), dim3(NTHR), args, LDS_BYTES, stream);
    if (e != hipSuccess) fprintf(stderr, "cooperative launch failed: %s (grid %d)\n", hipGetErrorString(e), grid_blocks);
}
```
